# Optimizing an MI355X kernel written in HIP

```python
import math
import jax, jax.numpy as jnp
from jax import lax
import numpy as np

D_MODEL = 1024
BATCH = 8
SEQ = 2048
DEPTH = 1
DEC_BATCH = 128
DEC_SEQ = 1
PAST_LEN = 2048
PAGE_SIZE = 128

MIX_WIDTH = D_MODEL
FOX_HEADS = 8
FOX_HEAD_DIM = 64
FOX_WIDTH = FOX_HEADS * FOX_HEAD_DIM
GDN_HEADS = 4
GDN_HEAD_DIM = 128
GDN_WIDTH = GDN_HEADS * GDN_HEAD_DIM
GDN_CONV = 4
GDN_CHUNK = 64
FFN_DIM = 2816
FFN_CONV = 3
Q_BLOCK = 128
EPS = 1e-6
NEG_BIG = -1e30
FORGET_BIAS_INIT = 2.0
IN_SECTIONS = (FOX_WIDTH, FOX_WIDTH, FOX_WIDTH, FOX_HEADS,
               GDN_WIDTH, GDN_WIDTH, GDN_WIDTH, GDN_HEADS, GDN_HEADS, GDN_WIDTH)
IN_WIDTH = sum(IN_SECTIONS)
SPLIT_POINTS = tuple(sum(IN_SECTIONS[:i + 1]) for i in range(len(IN_SECTIONS) - 1))
GDN_QKV_SPLIT = (GDN_WIDTH, 2 * GDN_WIDTH)

kernel_name = 'fox_gdn_parallel_heads_convffn_step'


def rms_norm(x, g):
    xf = x.astype(jnp.float32)
    y = xf * lax.rsqrt(jnp.mean(xf * xf, axis=-1, keepdims=True) + EPS)
    return (y * g.astype(jnp.float32)).astype(x.dtype)


def l2_normalize(x):
    xf = x.astype(jnp.float32)
    return xf * lax.rsqrt(jnp.sum(xf * xf, axis=-1, keepdims=True) + EPS)


def gather_pages(pool, page_table):
    pages = pool[page_table]
    b, n_pages = page_table.shape
    return pages.reshape((b, n_pages * pool.shape[1]) + pool.shape[2:])


def causal_depthwise_conv(x, ctx, w, b=None):
    width = w.shape[0]
    t = x.shape[1]
    xc = jnp.concatenate([ctx.astype(x.dtype), x], axis=1)
    y = xc[:, 0:t] * w[0]
    for i in range(1, width):
        y = y + xc[:, i:i + t] * w[i]
    if b is not None:
        y = y + b
    return y, xc[:, -(width - 1):]


def fox_attention(q, k, v, cq, ck, q_pos, k_pos):
    b, tq, h, dh = q.shape
    blk = min(Q_BLOCK, tq)
    n_blk = -(-tq // blk)
    pad = n_blk * blk - tq
    q = jnp.pad(q, ((0, 0), (0, pad), (0, 0), (0, 0)))
    cq = jnp.pad(cq, ((0, 0), (0, pad), (0, 0)))
    q_pos = jnp.pad(q_pos, (0, pad), mode='edge')
    qb = q.reshape(b, n_blk, blk, h, dh).transpose(1, 0, 2, 3, 4)
    cqb = cq.reshape(b, n_blk, blk, h).transpose(1, 0, 3, 2)
    pb = q_pos.reshape(n_blk, blk)
    ck_t = jnp.transpose(ck, (0, 2, 1))
    scale = dh ** -0.5

    def one_block(args):
        q_blk, cq_blk, p_blk = args
        s = jnp.einsum('bqhd,bkhd->bhqk', q_blk, k,
                       preferred_element_type=jnp.float32) * scale
        s = s + (cq_blk[..., :, None] - ck_t[:, :, None, :])
        mask = k_pos[None, :] <= p_blk[:, None]
        s = jnp.where(mask, s, NEG_BIG)
        p = jax.nn.softmax(s, axis=-1)
        return jnp.einsum('bhqk,bkhd->bqhd', p.astype(v.dtype), v)

    out = lax.map(one_block, (qb, cqb, pb))
    return out.transpose(1, 0, 2, 3, 4).reshape(b, n_blk * blk, h, dh)[:, :tq]


def gated_delta_chunked(q, k, v, g, beta, s0):
    b, t, h, dk = q.shape
    dv = v.shape[-1]
    c = min(GDN_CHUNK, t)
    n = -(-t // c)
    pad = n * c - t
    f32 = jnp.float32
    q = q.astype(f32) * (dk ** -0.5)
    k = k.astype(f32)
    v = v.astype(f32)
    pad4 = ((0, 0), (0, pad), (0, 0), (0, 0))
    pad3 = ((0, 0), (0, pad), (0, 0))
    q, k, v = jnp.pad(q, pad4), jnp.pad(k, pad4), jnp.pad(v, pad4)
    g, beta = jnp.pad(g, pad3), jnp.pad(beta, pad3)

    def chunks(x):
        return x.reshape(b, n, c, h, x.shape[-1]).transpose(0, 3, 1, 2, 4)

    qc, kc, vc = chunks(q), chunks(k), chunks(v)
    gc = g.reshape(b, n, c, h).transpose(0, 3, 1, 2)
    bc = beta.reshape(b, n, c, h).transpose(0, 3, 1, 2)
    gcum = jnp.cumsum(gc, axis=-1)
    diff = gcum[..., :, None] - gcum[..., None, :]
    lower = jnp.tril(jnp.ones((c, c), dtype=bool))
    strict = jnp.tril(jnp.ones((c, c), dtype=bool), -1)
    decay = jnp.where(lower, jnp.exp(jnp.where(lower, diff, 0.0)), 0.0)
    kk = jnp.einsum('bhnid,bhnjd->bhnij', kc, kc)
    a_mat = jnp.where(strict, bc[..., :, None] * kk * decay, 0.0)
    lhs = a_mat + jnp.eye(c, dtype=f32)
    rhs = jnp.concatenate([vc * bc[..., None], kc * (bc * jnp.exp(gcum))[..., None]], axis=-1)
    sol = lax.linalg.triangular_solve(lhs, rhs, left_side=True, lower=True, unit_diagonal=True)
    u, w = sol[..., :dv], sol[..., dv:]
    qk = jnp.einsum('bhnid,bhnjd->bhnij', qc, kc) * decay
    q_dec = qc * jnp.exp(gcum)[..., None]
    k_dec = kc * jnp.exp(gcum[..., -1:] - gcum)[..., None]
    g_last = jnp.exp(gcum[..., -1])

    def step(s, xs):
        u_i, w_i, qk_i, qd_i, kd_i, gl_i = xs
        v_new = u_i - jnp.einsum('bhcd,bhde->bhce', w_i, s)
        o = jnp.einsum('bhcd,bhde->bhce', qd_i, s) + jnp.einsum('bhij,bhje->bhie', qk_i, v_new)
        s = s * gl_i[..., None, None] + jnp.einsum('bhcd,bhce->bhde', kd_i, v_new)
        return s, o

    xs = tuple(jnp.moveaxis(x, 2, 0) for x in (u, w, qk, q_dec, k_dec, g_last))
    s_final, o = lax.scan(step, s0.astype(f32), xs)
    o = o.transpose(1, 0, 3, 2, 4).reshape(b, n * c, h, dv)[:, :t]
    return o, s_final.astype(s0.dtype)


def decoder_layer(x, past_k, past_v, past_lf, s0, gdn_ctx, ffn_ctx,
                  norm_mix, w_in, b_forget, gdn_a_log, gdn_dt_bias, w_gdn_conv,
                  gdn_out_norm, w_out, norm_ffn, w_up, w_ffn_conv, b_ffn_conv, w_down):
    b, t, _ = x.shape
    p_len = past_k.shape[1]
    f32 = jnp.float32
    h = rms_norm(x, norm_mix)
    proj = h @ w_in
    fq, fk, fv, ff, gq, gk, gv, ga, gb, gz = jnp.split(proj, SPLIT_POINTS, axis=-1)

    fq = fq.reshape(b, t, FOX_HEADS, FOX_HEAD_DIM)
    fk = fk.reshape(b, t, FOX_HEADS, FOX_HEAD_DIM)
    fv = fv.reshape(b, t, FOX_HEADS, FOX_HEAD_DIM)
    lf = jax.nn.log_sigmoid(ff.astype(f32) + b_forget.astype(f32))
    k_all = jnp.concatenate([past_k.astype(fk.dtype), fk], axis=1)
    v_all = jnp.concatenate([past_v.astype(fv.dtype), fv], axis=1)
    cum = jnp.cumsum(jnp.concatenate([past_lf.astype(f32), lf], axis=1), axis=1)
    pos = jnp.arange(p_len + t)
    fox_out = fox_attention(fq, k_all, v_all, cum[:, p_len:], cum, pos[p_len:], pos)

    qkv = jnp.concatenate([gq, gk, gv], axis=-1)
    qkv_c, new_gdn_ctx = causal_depthwise_conv(qkv, gdn_ctx, w_gdn_conv)
    qkv_c = jax.nn.silu(qkv_c)
    cq, ck, cv = jnp.split(qkv_c, GDN_QKV_SPLIT, axis=-1)
    cq = l2_normalize(cq.reshape(b, t, GDN_HEADS, GDN_HEAD_DIM))
    ck = l2_normalize(ck.reshape(b, t, GDN_HEADS, GDN_HEAD_DIM))
    cv = cv.reshape(b, t, GDN_HEADS, GDN_HEAD_DIM)
    beta = jax.nn.sigmoid(gb.astype(f32))
    g = -jnp.exp(gdn_a_log.astype(f32)) * jax.nn.softplus(ga.astype(f32) + gdn_dt_bias.astype(f32))
    o, new_s = gated_delta_chunked(cq, ck, cv, g, beta, s0)
    o = rms_norm(o, gdn_out_norm) * jax.nn.silu(gz.reshape(b, t, GDN_HEADS, GDN_HEAD_DIM).astype(f32))

    mix = jnp.concatenate([fox_out.reshape(b, t, FOX_WIDTH),
                           o.reshape(b, t, GDN_WIDTH).astype(x.dtype)], axis=-1)
    x = x + mix @ w_out

    h2 = rms_norm(x, norm_ffn)
    gate, up = jnp.split(h2 @ w_up, 2, axis=-1)
    gate_c, new_ffn_ctx = causal_depthwise_conv(gate, ffn_ctx, w_ffn_conv, b_ffn_conv)
    x = x + (jax.nn.silu(gate_c) * up) @ w_down
    return x, (fk, fv, lf, new_s, new_gdn_ctx, new_ffn_ctx)


def setup_inputs(seed: int = 0) -> dict:
    key = jax.random.key(seed)
    ks = jax.random.split(key, 24)
    f32 = jnp.float32
    n_pages = PAST_LEN // PAGE_SIZE
    n_pool = (5 * DEC_BATCH * n_pages) // 4

    def nrm(k, shape, scale):
        return jax.random.normal(k, shape, f32) * scale

    x_prompt = nrm(ks[0], (BATCH, SEQ, D_MODEL), 1.0)
    x_sample = nrm(ks[1], (DEC_BATCH, DEC_SEQ, D_MODEL), 1.0)
    cache_k = nrm(ks[2], (DEPTH, n_pool, PAGE_SIZE, FOX_HEADS, FOX_HEAD_DIM), 1.0)
    cache_v = nrm(ks[3], (DEPTH, n_pool, PAGE_SIZE, FOX_HEADS, FOX_HEAD_DIM), 1.0)
    cache_logf = jax.nn.log_sigmoid(FORGET_BIAS_INIT + nrm(ks[4], (DEPTH, n_pool, PAGE_SIZE, FOX_HEADS), 1.0))
    state_gdn = nrm(ks[5], (DEPTH, DEC_BATCH, GDN_HEADS, GDN_HEAD_DIM, GDN_HEAD_DIM), GDN_HEAD_DIM ** -0.5)
    state_gdn_conv = nrm(ks[6], (DEPTH, DEC_BATCH, GDN_CONV - 1, 3 * GDN_WIDTH), 1.0)
    state_ffn_conv = nrm(ks[7], (DEPTH, DEC_BATCH, FFN_CONV - 1, FFN_DIM), 1.0)
    page_table = jax.random.permutation(ks[8], n_pool)[: DEC_BATCH * n_pages]
    page_table = page_table.reshape(DEC_BATCH, n_pages).astype(jnp.int32)

    norm_mix = 1.0 + nrm(ks[9], (DEPTH, D_MODEL), 0.02)
    w_in = nrm(ks[10], (DEPTH, D_MODEL, IN_WIDTH), D_MODEL ** -0.5)
    b_forget = FORGET_BIAS_INIT + nrm(ks[11], (DEPTH, FOX_HEADS), 0.5)
    gdn_a_log = jnp.log(jax.random.uniform(ks[12], (DEPTH, GDN_HEADS), f32, 1.0, 16.0))
    dt = jnp.exp(jax.random.uniform(ks[13], (DEPTH, GDN_HEADS), f32, math.log(1e-3), math.log(1e-1)))
    gdn_dt_bias = dt + jnp.log(-jnp.expm1(-dt))
    w_gdn_conv = nrm(ks[14], (DEPTH, GDN_CONV, 3 * GDN_WIDTH), GDN_CONV ** -0.5)
    gdn_out_norm = 1.0 + nrm(ks[15], (DEPTH, GDN_HEAD_DIM), 0.02)
    w_out = nrm(ks[16], (DEPTH, MIX_WIDTH, D_MODEL), MIX_WIDTH ** -0.5)
    norm_ffn = 1.0 + nrm(ks[17], (DEPTH, D_MODEL), 0.02)
    w_up = nrm(ks[18], (DEPTH, D_MODEL, 2 * FFN_DIM), D_MODEL ** -0.5)
    w_ffn_conv = nrm(ks[19], (DEPTH, FFN_CONV, FFN_DIM), FFN_CONV ** -0.5)
    b_ffn_conv = nrm(ks[20], (DEPTH, FFN_DIM), 0.02)
    w_down = nrm(ks[21], (DEPTH, FFN_DIM, D_MODEL), FFN_DIM ** -0.5)
    norm_final = 1.0 + nrm(ks[22], (D_MODEL,), 0.02)
    return {
        'x_prompt': x_prompt, 'x_sample': x_sample,
        'cache_k': cache_k, 'cache_v': cache_v, 'cache_logf': cache_logf,
        'state_gdn': state_gdn, 'state_gdn_conv': state_gdn_conv, 'state_ffn_conv': state_ffn_conv,
        'page_table': page_table,
        'norm_mix': norm_mix, 'w_in': w_in, 'b_forget': b_forget,
        'gdn_a_log': gdn_a_log, 'gdn_dt_bias': gdn_dt_bias, 'w_gdn_conv': w_gdn_conv,
        'gdn_out_norm': gdn_out_norm, 'w_out': w_out, 'norm_ffn': norm_ffn,
        'w_up': w_up, 'w_ffn_conv': w_ffn_conv, 'b_ffn_conv': b_ffn_conv,
        'w_down': w_down, 'norm_final': norm_final,
    }


def reference(x_prompt, x_sample, cache_k, cache_v, cache_logf, state_gdn, state_gdn_conv,
              state_ffn_conv, page_table, norm_mix, w_in, b_forget, gdn_a_log, gdn_dt_bias,
              w_gdn_conv, gdn_out_norm, w_out, norm_ffn, w_up, w_ffn_conv, b_ffn_conv,
              w_down, norm_final):
    yp, ys = x_prompt, x_sample
    bp = x_prompt.shape[0]
    new_p, new_s = [], []
    for layer in range(DEPTH):
        params = (norm_mix[layer], w_in[layer], b_forget[layer], gdn_a_log[layer],
                  gdn_dt_bias[layer], w_gdn_conv[layer], gdn_out_norm[layer], w_out[layer],
                  norm_ffn[layer], w_up[layer], w_ffn_conv[layer], b_ffn_conv[layer], w_down[layer])
        yp, st_p = decoder_layer(
            yp,
            jnp.zeros((bp, 0, FOX_HEADS, FOX_HEAD_DIM), yp.dtype),
            jnp.zeros((bp, 0, FOX_HEADS, FOX_HEAD_DIM), yp.dtype),
            jnp.zeros((bp, 0, FOX_HEADS), jnp.float32),
            jnp.zeros((bp, GDN_HEADS, GDN_HEAD_DIM, GDN_HEAD_DIM), jnp.float32),
            jnp.zeros((bp, GDN_CONV - 1, 3 * GDN_WIDTH), yp.dtype),
            jnp.zeros((bp, FFN_CONV - 1, FFN_DIM), yp.dtype),
            *params)
        ys, st_s = decoder_layer(
            ys,
            gather_pages(cache_k[layer], page_table),
            gather_pages(cache_v[layer], page_table),
            gather_pages(cache_logf[layer], page_table),
            state_gdn[layer], state_gdn_conv[layer], state_ffn_conv[layer],
            *params)
        new_p.append(st_p)
        new_s.append(st_s)
    y_prompt = rms_norm(yp, norm_final)
    y_sample = rms_norm(ys, norm_final)
    k_p, v_p, lf_p, s_p, gc_p, fc_p = [jnp.stack(t, axis=0) for t in zip(*new_p)]
    k_s, v_s, lf_s, s_s, gc_s, fc_s = [jnp.stack(t, axis=0) for t in zip(*new_s)]
    return (y_prompt, y_sample, k_p, v_p, lf_p, s_p, gc_p, fc_p, k_s, v_s, lf_s, s_s, gc_s, fc_s)
```

```cpp
#include <hip/hip_runtime.h>
#include <cstdio>
#include <cstdint>
namespace pg8 {
#define PG8_LAS __attribute__((address_space(3)))
typedef unsigned short bf16_t;
typedef short bf16x8 __attribute__((ext_vector_type(8)));
typedef float f32x4 __attribute__((ext_vector_type(4)));
typedef unsigned u32x4 __attribute__((ext_vector_type(4)));
constexpr int BM = 256, BK = 64, HALF = 128, HTB = HALF * BK * 2  , STAGE_BYTES = 8 * HTB, NXCD = 8, WGM = 8;

__host__ __device__ __forceinline__ int lds_byte(int r, int c) { const int st = (r >> 4) * 2 + (c >> 5), rr = r & 15, cc = c & 31, ob = rr * 64 + cc * 2; return st * 1024 + (ob ^ (((ob >> 9) & 1) << 5)); }
__host__ __device__ __forceinline__ void stage_rc(int b, int& R, int& C) { const int st = b / 1024, sb = b % 1024, swz = sb ^ (((sb >> 9) & 1) << 5); R = (st >> 1) * 16 + swz / 64; C = (st & 1) * 32 + (swz % 64) / 2; }
__host__ __device__ __forceinline__ int perm32(int rho) { const int n = rho >> 4, i = rho & 15; return 8 * (i >> 2) + 4 * n + (i & 3); }

struct Unit { int pm, pn; };
struct Gemm { const bf16_t* A; const bf16_t* Bt; int M, N, K; };

struct StaticOrder {
    int nM, nN, nwg, G, c;
    __host__ __device__ void init(int M, int N, int G_, int c_) { nM = M / BM; nN = N / BM; nwg = nM * nN; G = G_; c = c_; }
    __host__ __device__ bool next(int i, Unit& u) const {
        const long L = (long)i * G + c; if (L >= nwg) return false;
        int wgid = (int)L; { const int q = nwg / NXCD, r = nwg % NXCD, xcd = wgid % NXCD, off = wgid / NXCD; wgid = (xcd < r ? xcd * (q + 1) : r * (q + 1) + (xcd - r) * q) + off; }
        const int nig = WGM * nN, gid = wgid / nig, fm = gid * WGM, gsz = (nM - fm) < WGM ? (nM - fm) : WGM;
        u.pm = fm + ((wgid % nig) % gsz); u.pn = (wgid % nig) / gsz; return true;
    }
    __device__ __forceinline__ void a_ready(const Unit&) const {}
    __device__ __forceinline__ void done(const Unit&) const {}
};

__device__ __forceinline__ unsigned cvt_pk_bf16(float lo, float hi) { unsigned r; asm volatile("v_cvt_pk_bf16_f32 %0, %1, %2" : "=v"(r) : "v"(lo), "v"(hi)); return r; }
template <class Epi, class Sched, bool ALIGN_EPI = false, bool SP2 = false>
__device__ __forceinline__ void gemm_phase(PG8_LAS unsigned char* lds, const Gemm g, const Sched& S, const Epi& E) {
    const int tid = threadIdx.x, wid = __builtin_amdgcn_readfirstlane(tid >> 6), lane = tid & 63, wr = wid >> 2, wc = wid & 3, fr = lane & 15, fq = lane >> 4;
    const int K = g.K, nt = K / BK;
    unsigned voffA[2], voffB[2];
#pragma unroll
    for (int i = 0; i < 2; ++i) { int R, C; stage_rc(tid * 16 + i * 8192, R, C); const int Rb = Epi::PERM ? ((R & ~31) + perm32(R & 31)) : R;
        voffA[i] = (unsigned)(R * K + C) * 2u; voffB[i] = (unsigned)(Rb * K + C) * 2u; }
    const size_t kstep = (size_t)(BK * 2);
    const size_t hstep = (size_t)HALF * K * 2;
    const size_t tstep = 2 * hstep;
    const unsigned ldsw = (unsigned)wid * 1024u;
    const int aoff = lds_byte(wr * 64 + fr, fq * 8), boff = lds_byte(wc * 32 + fr, fq * 8);
#define PG8_SA(b, h) (((b) * 2 + (h)) * HTB)
#define PG8_SB(b, h) ((4 + (b) * 2 + (h)) * HTB)
#define PG8_STAGE(bufoff, gbase, voff) do { _Pragma("unroll") for (int _i = 0; _i < 2; ++_i) \
        __builtin_amdgcn_global_load_lds((const unsigned*)((const char*)(gbase) + (voff)[_i]), (PG8_LAS unsigned*)(lds + (bufoff) + ldsw + _i * 8192), 16, 0, 0); } while (0)
#define PG8_LDA(dst, b, h) do { _Pragma("unroll") for (int m = 0; m < 4; ++m) _Pragma("unroll") for (int k = 0; k < 2; ++k) dst[m][k] = *(const PG8_LAS bf16x8*)(lds + PG8_SA(b, h) + aoff + m * 2048 + k * 1024); } while (0)
#define PG8_LDB(dst, b, h) do { _Pragma("unroll") for (int n = 0; n < 2; ++n) _Pragma("unroll") for (int k = 0; k < 2; ++k) dst[n][k] = *(const PG8_LAS bf16x8*)(lds + PG8_SB(b, h) + boff + n * 2048 + k * 1024); } while (0)
#define PG8_MMA(ai, bj, At, Bt) do { __builtin_amdgcn_s_setprio(1); _Pragma("unroll") for (int m = 0; m < 4; ++m) _Pragma("unroll") for (int n = 0; n < 2; ++n) _Pragma("unroll") for (int k = 0; k < 2; ++k) \
        acc[ai][bj][m][n] = __builtin_amdgcn_mfma_f32_16x16x32_bf16(Bt[n][k], At[m][k], acc[ai][bj][m][n], 0, 0, 0); __builtin_amdgcn_s_setprio(0); } while (0)
#define PG8_WAIT_V(n) asm volatile("s_waitcnt vmcnt(" #n ")" ::: "memory")
#define PG8_WAIT_L(n) asm volatile("s_waitcnt lgkmcnt(" #n ")" ::: "memory")
#define PG8_BAR __builtin_amdgcn_s_barrier()
#define PG8_SCHED __builtin_amdgcn_sched_barrier(0)
    Unit cur, nxt; int ui = 0;
    if (!S.next(0, cur)) return;
    f32x4 acc[2][2][4][2];
#pragma unroll
    for (int a = 0; a < 2; ++a)
#pragma unroll
        for (int b = 0; b < 2; ++b)
#pragma unroll
            for (int m = 0; m < 4; ++m)
#pragma unroll
                for (int n = 0; n < 2; ++n) acc[a][b][m][n] = (f32x4){0.f, 0.f, 0.f, 0.f};
    bf16x8 At[4][2], B0[2][2], B1[2][2];
    const char* cA = (const char*)g.A + (size_t)cur.pm * tstep; const char* cB = (const char*)g.Bt + (size_t)cur.pn * tstep;
    S.a_ready(cur);
    if constexpr (SP2) {
        PG8_STAGE(PG8_SB(0, 0), cB, voffB); PG8_STAGE(PG8_SB(0, 1), cB + hstep, voffB); PG8_STAGE(PG8_SA(0, 0), cA, voffA); PG8_STAGE(PG8_SA(0, 1), cA + hstep, voffA);
        if (wr == 1) PG8_BAR;
        PG8_WAIT_V(2); PG8_BAR;
        PG8_STAGE(PG8_SB(1, 0), cB + kstep, voffB); PG8_STAGE(PG8_SA(1, 0), cA + kstep, voffA); PG8_STAGE(PG8_SB(1, 1), cB + hstep + kstep, voffB);
        PG8_WAIT_V(6); PG8_BAR;
    } else {
        PG8_STAGE(PG8_SB(0, 0), cB, voffB); PG8_STAGE(PG8_SA(0, 0), cA, voffA); PG8_STAGE(PG8_SB(0, 1), cB + hstep, voffB); PG8_STAGE(PG8_SA(0, 1), cA + hstep, voffA);
        if (wr == 1) PG8_BAR;
        PG8_WAIT_V(4); PG8_BAR;
        PG8_STAGE(PG8_SB(1, 0), cB + kstep, voffB); PG8_STAGE(PG8_SA(1, 0), cA + kstep, voffA); PG8_STAGE(PG8_SB(1, 1), cB + hstep + kstep, voffB);
        PG8_WAIT_V(6); PG8_BAR;
    }
    for (;;) {
        const bool has_next = S.next(ui + 1, nxt);
        const char* nA = has_next ? (const char*)g.A + (size_t)nxt.pm * tstep : cA; const char* nB = has_next ? (const char*)g.Bt + (size_t)nxt.pn * tstep : cB;
        for (int t = 0; t < nt; t += 2) {
            const bool last = (t == nt - 2);
            const char* a1 = cA + (size_t)(t + 1) * kstep;
            const char* a2 = last ? nA : cA + (size_t)(t + 2) * kstep; const char* b2 = last ? nB : cB + (size_t)(t + 2) * kstep;
            const char* a3 = a2 + kstep; const char* b3 = b2 + kstep;
            if (last && has_next) S.a_ready(nxt);
            if constexpr (SP2) {
            PG8_LDB(B0, 0, 0); PG8_LDB(B1, 0, 1); PG8_SCHED; PG8_LDA(At, 0, 0); PG8_STAGE(PG8_SA(1, 1), a1 + hstep, voffA);
            PG8_WAIT_V(8); PG8_WAIT_L(0); PG8_BAR; PG8_MMA(0, 0, At, B0); PG8_MMA(0, 1, At, B1); PG8_BAR; PG8_SCHED;
            PG8_LDA(At, 0, 1); PG8_STAGE(PG8_SB(0, 0), b2, voffB); PG8_STAGE(PG8_SB(0, 1), b2 + hstep, voffB); PG8_STAGE(PG8_SA(0, 0), a2, voffA);
            PG8_WAIT_V(8); PG8_WAIT_L(0); PG8_BAR; PG8_MMA(1, 0, At, B0); PG8_MMA(1, 1, At, B1); PG8_BAR; PG8_SCHED;
            PG8_LDB(B0, 1, 0); PG8_LDB(B1, 1, 1); PG8_SCHED; PG8_LDA(At, 1, 0); PG8_STAGE(PG8_SA(0, 1), a2 + hstep, voffA);
            PG8_WAIT_V(8); PG8_WAIT_L(0); PG8_BAR; PG8_MMA(0, 0, At, B0); PG8_MMA(0, 1, At, B1); PG8_BAR; PG8_SCHED;
            PG8_LDA(At, 1, 1); PG8_STAGE(PG8_SB(1, 0), b3, voffB); PG8_STAGE(PG8_SB(1, 1), b3 + hstep, voffB); PG8_STAGE(PG8_SA(1, 0), a3, voffA);
            PG8_WAIT_V(8); PG8_WAIT_L(0); PG8_BAR; PG8_MMA(1, 0, At, B0); PG8_MMA(1, 1, At, B1); PG8_BAR; PG8_SCHED;
            } else {
            PG8_LDB(B0, 0, 0); PG8_SCHED; PG8_LDA(At, 0, 0); PG8_STAGE(PG8_SA(1, 1), a1 + hstep, voffA);
            PG8_WAIT_L(8); PG8_BAR; PG8_WAIT_L(0); PG8_MMA(0, 0, At, B0); PG8_BAR; PG8_SCHED;
            PG8_LDB(B1, 0, 1); PG8_STAGE(PG8_SB(0, 0), b2, voffB);
            PG8_BAR; PG8_WAIT_L(0); PG8_MMA(0, 1, At, B1); PG8_BAR;
            PG8_LDA(At, 0, 1); PG8_STAGE(PG8_SA(0, 0), a2, voffA);
            PG8_BAR; PG8_WAIT_L(0); PG8_MMA(1, 0, At, B0); PG8_BAR; PG8_SCHED;
            PG8_STAGE(PG8_SB(0, 1), b2 + hstep, voffB);
            PG8_WAIT_V(6); PG8_BAR; PG8_MMA(1, 1, At, B1); PG8_BAR;
            PG8_LDB(B0, 1, 0); PG8_SCHED; PG8_LDA(At, 1, 0); PG8_STAGE(PG8_SA(0, 1), a2 + hstep, voffA);
            PG8_WAIT_L(8); PG8_BAR; PG8_WAIT_L(0); PG8_MMA(0, 0, At, B0); PG8_BAR; PG8_SCHED;
            PG8_LDB(B1, 1, 1); PG8_STAGE(PG8_SB(1, 0), b3, voffB);
            PG8_BAR; PG8_WAIT_L(0); PG8_MMA(0, 1, At, B1); PG8_BAR;
            PG8_LDA(At, 1, 1); PG8_STAGE(PG8_SA(1, 0), a3, voffA);
            PG8_BAR; PG8_WAIT_L(0); PG8_MMA(1, 0, At, B0); PG8_BAR; PG8_SCHED;
            PG8_STAGE(PG8_SB(1, 1), b3 + hstep, voffB);
            PG8_WAIT_V(6); PG8_BAR; PG8_MMA(1, 1, At, B1); PG8_BAR;
            }
        }
        if constexpr (ALIGN_EPI) { if (wr == 0) PG8_BAR; }
        if constexpr (!Epi::AFTER_DRAIN) { E(acc, cur, wr, wc, fr, fq); S.done(cur); }
        if (!has_next) break;
#pragma unroll
        for (int a = 0; a < 2; ++a)
#pragma unroll
            for (int b = 0; b < 2; ++b)
#pragma unroll
                for (int m = 0; m < 4; ++m)
#pragma unroll
                    for (int n = 0; n < 2; ++n) acc[a][b][m][n] = (f32x4){0.f, 0.f, 0.f, 0.f};
        cur = nxt; cA = nA; cB = nB; ++ui;
        if constexpr (ALIGN_EPI) { if (wr == 1) PG8_BAR; }
    }
    PG8_WAIT_V(0);
    if constexpr (!ALIGN_EPI) { if (wr == 0) PG8_BAR; }
    PG8_BAR;
    if constexpr (Epi::AFTER_DRAIN) { E.fused(acc, cur, wr, wc, fr, fq, lds, wid, lane); S.done(cur); }
#undef PG8_SA
#undef PG8_SB
#undef PG8_STAGE
#undef PG8_LDA
#undef PG8_LDB
#undef PG8_MMA
#undef PG8_WAIT_V
#undef PG8_WAIT_L
#undef PG8_BAR
#undef PG8_SCHED
}
}
#include <hip/hip_bf16.h>
#include <cmath>
namespace attn_body {
using bf16=__hip_bfloat16;
using bf16x8=__attribute__((ext_vector_type(8)))short;
using s16x4=__attribute__((ext_vector_type(4)))short;
using f32x16=__attribute__((ext_vector_type(16)))float;
using u32x4=__attribute__((ext_vector_type(4)))unsigned;
constexpr int BATCH=8,NHEAD=8,SEQ=2048,D=64,DM=NHEAD*D,OPITCH=1024;
constexpr int NW=8,QBLK=32,QB=QBLK*NW,KVBLK=64,NQB=SEQ/QB;
constexpr int ATTN_PITCH=DM, ATTN_UNIT_ROWS=QB;
__device__ __forceinline__ int crow(int r,int hi){return (r&3)+8*(r>>2)+4*hi;}
#define SBAR() __builtin_amdgcn_sched_barrier(0)
__device__ __forceinline__ void cmask(f32x16&p0,f32x16&p1,int jb,int qrel,int hi){
  const float NEG=-INFINITY; int dq=qrel-64*jb-4*hi; asm volatile("":"+v"(dq));
  #pragma unroll
  for(int r=0;r<16;++r){const int c=(r&3)+8*(r>>2); if(c>dq)p0[r]=NEG; if(c+32>dq)p1[r]=NEG;}
}

constexpr int NSLOT=3, SLOTB=8192;
constexpr int LDS_K=0, LDS_V=NSLOT*SLOTB, LDS_WS=2*NSLOT*SLOTB, LDS_OST=LDS_WS+NW*64*4, LDS_BYTES=LDS_OST+NW*4096;
constexpr float C2=0.125f*1.4426950408889634f;
__device__ __forceinline__ void glds16(const void*gbase,unsigned voff,unsigned lds_dst){unsigned keep;
  asm volatile("s_mov_b32 %0, m0\n\ts_mov_b32 m0, %3\n\ts_nop 0\n\tglobal_load_lds_dwordx4 %1, %2\n\ts_mov_b32 m0, %0":"=&s"(keep):"v"(voff),"s"(gbase),"s"(lds_dst):"memory");}
__device__ __forceinline__ float max3f(float a,float b,float c){float r;asm("v_max3_f32 %0, %1, %2, %3":"=v"(r):"v"(a),"v"(b),"v"(c));return r;}
__device__ __forceinline__ float max2f(float a,float b){float r;asm("v_max_f32_e32 %0, %1, %2":"=v"(r):"v"(a),"v"(b));return r;}
__device__ __forceinline__ float fadd_s(float a,float b){float r;asm("v_add_f32_e32 %0, %1, %2":"=v"(r):"v"(a),"v"(b));return r;}
__device__ __forceinline__ float fsub_s(float a,float b){float r;asm("v_sub_f32_e32 %0, %1, %2":"=v"(r):"v"(a),"v"(b));return r;}
typedef float f32x2_t __attribute__((ext_vector_type(2))); typedef __bf16 bf16x2_t __attribute__((ext_vector_type(2)));
__device__ __forceinline__ unsigned cvtpk_s(float lo,float hi){f32x2_t v={lo,hi};bf16x2_t b=__builtin_convertvector(v,bf16x2_t);return __builtin_bit_cast(unsigned,b);}
#define WAIT_BAR(N) asm volatile("s_waitcnt vmcnt(" #N ") lgkmcnt(0)\n\ts_barrier":::"memory")

__device__ __forceinline__ void qkt(f32x16&p0,f32x16&p1,const char*Kslot,const bf16x8*qr,int r32,int hi){
  const char*kb=Kslot+hi*1024+r32*16;
  #pragma unroll
  for(int d0=0;d0<4;++d0){
    const bf16x8 b0=*reinterpret_cast<const bf16x8*>(kb+d0*2048);
    const bf16x8 b1=*reinterpret_cast<const bf16x8*>(kb+d0*2048+512);
    if(d0==0){p0=__builtin_amdgcn_mfma_f32_32x32x16_bf16(b0,qr[0],f32x16{},0,0,0);p1=__builtin_amdgcn_mfma_f32_32x32x16_bf16(b1,qr[0],f32x16{},0,0,0);}
    else{p0=__builtin_amdgcn_mfma_f32_32x32x16_bf16(b0,qr[d0],p0,0,0,0);p1=__builtin_amdgcn_mfma_f32_32x32x16_bf16(b1,qr[d0],p1,0,0,0);}}
}
typedef __attribute__((address_space(3))) const char* lds_cptr;
typedef short v4i16_t __attribute__((ext_vector_type(4)));
__device__ __forceinline__ void kload8(bf16x8*kf,lds_cptr kp){
  kf[0]=*(const __attribute__((address_space(3))) bf16x8*)(kp);      kf[1]=*(const __attribute__((address_space(3))) bf16x8*)(kp+512);
  kf[2]=*(const __attribute__((address_space(3))) bf16x8*)(kp+2048); kf[3]=*(const __attribute__((address_space(3))) bf16x8*)(kp+2560);
  kf[4]=*(const __attribute__((address_space(3))) bf16x8*)(kp+4096); kf[5]=*(const __attribute__((address_space(3))) bf16x8*)(kp+4608);
  kf[6]=*(const __attribute__((address_space(3))) bf16x8*)(kp+6144); kf[7]=*(const __attribute__((address_space(3))) bf16x8*)(kp+6656);
}
__device__ __forceinline__ void kload2(bf16x8*kf,lds_cptr kp,int j){ kf[2*j]=*(const __attribute__((address_space(3))) bf16x8*)(kp+j*2048); kf[2*j+1]=*(const __attribute__((address_space(3))) bf16x8*)(kp+j*2048+512); }
__device__ __forceinline__ s16x4 vtr(lds_cptr p){ return __builtin_bit_cast(s16x4,__builtin_amdgcn_ds_read_tr16_b64_v4i16((__attribute__((address_space(3))) v4i16_t*)p)); }
__device__ __forceinline__ float rowmax(const f32x16&p0,const f32x16&p1){
  float a=max3f(p0[0],p0[1],p1[0]),b=max3f(p0[2],p0[3],p1[1]);a=max3f(a,p1[2],p1[3]);
  #pragma unroll
  for(int r=4;r<16;r+=4){a=max3f(a,p0[r],p0[r+1]);b=max3f(b,p0[r+2],p0[r+3]);a=max3f(a,p1[r],p1[r+1]);b=max3f(b,p1[r+2],p1[r+3]);}
  const float m=max2f(a,b);
  auto rr=__builtin_amdgcn_permlane32_swap(__float_as_uint(m),__float_as_uint(m),false,false);
  return max2f(__uint_as_float(rr[0]),__uint_as_float(rr[1]));
}
__device__ __forceinline__ void pv(f32x16*o,int vb,bf16x8 pa0,bf16x8 pa1,bf16x8 pa2,bf16x8 pa3){
  #pragma unroll
  for(int d0=0;d0<2;++d0){s16x4 lo[4],hi[4];
    #pragma unroll
    for(int ks=0;ks<4;++ks){
      asm volatile("ds_read_b64_tr_b16 %0,%1 offset:%c2":"=&v"(lo[ks]):"v"(vb),"i"(d0*4096+ks*1024):"memory");
      asm volatile("ds_read_b64_tr_b16 %0,%1 offset:%c2":"=&v"(hi[ks]):"v"(vb),"i"(d0*4096+ks*1024+512):"memory");}
    asm volatile("s_waitcnt lgkmcnt(0)":::"memory");SBAR();
    #define PK(k) (bf16x8){lo[k][0],lo[k][1],lo[k][2],lo[k][3],hi[k][0],hi[k][1],hi[k][2],hi[k][3]}
    o[d0]=__builtin_amdgcn_mfma_f32_32x32x16_bf16(pa0,PK(0),o[d0],0,0,0);
    o[d0]=__builtin_amdgcn_mfma_f32_32x32x16_bf16(pa1,PK(1),o[d0],0,0,0);
    o[d0]=__builtin_amdgcn_mfma_f32_32x32x16_bf16(pa2,PK(2),o[d0],0,0,0);
    o[d0]=__builtin_amdgcn_mfma_f32_32x32x16_bf16(pa3,PK(3),o[d0],0,0,0);
    #undef PK
  }
}

#ifndef ATTN_STORE16
#define ATTN_STORE16(p,v) (*(u32x4*)(p)=(v))
#endif
__device__ __forceinline__ unsigned bf_rne(float f){unsigned u=__float_as_uint(f);return (u+0x7fffu+((u>>16)&1u))>>16;}
__device__ __forceinline__ void split3(float x,unsigned&h,unsigned&m,unsigned&l){h=bf_rne(x);float r=x-__uint_as_float(h<<16);m=bf_rne(r);r-=__uint_as_float(m<<16);l=bf_rne(r);}
__device__ __forceinline__ bf16x8 make_qa(float mhat,int hi){unsigned h,m,l;split3(mhat,h,m,l);u32x4 w;w.x=0x3F803F80u;w.y=0x3F80u|(h<<16);w.z=m|(l<<16);w.w=0u;if(hi){w.x=0u;w.y=0u;w.z=0u;}return __builtin_bit_cast(bf16x8,w);}
template<int THRL> __device__ __forceinline__ void attn_unit(int b,int h,int qb,const bf16*Q,const bf16*__restrict__ K,const bf16*__restrict__ V,bf16*O,char*shm,__attribute__((address_space(3))) const char* biasF){
  const int tid=threadIdx.x,lane=tid&63,r32=lane&31,hi=lane>>5; const int wid=__builtin_amdgcn_readfirstlane(tid>>6);
  const long rowbase=(long)b*SEQ; const int q0=qb*QB;
  const bf16*Qw=Q+(rowbase+q0+wid*QBLK)*DM+h*D;
  const bf16*Kh=K+rowbase*DM+h*D,*Vh=V+rowbase*DM+h*D;
  const unsigned lds0=(unsigned)(uintptr_t)shm;
  float*wsf=(float*)(shm+LDS_WS)+wid*64;
  const unsigned ksrc=(unsigned)(lane*DM+wid*8)*2u;
  const unsigned vsrc=(unsigned)((16*(wid&3)+(lane>>2))*DM+(wid>>2)*32+(lane&3)*8)*2u;
  const unsigned kdst=lds0+LDS_K+wid*1024, vdst=lds0+LDS_V+wid*1024;
  #define DMA_K(t,slot) glds16(Kh+(long)(NT-1-(t))*KVBLK*DM,ksrc,(unsigned)__builtin_amdgcn_readfirstlane(kdst+(slot)))
  #define DMA_V(t,slot) glds16(Vh+(long)(NT-1-(t))*KVBLK*DM,vsrc,(unsigned)__builtin_amdgcn_readfirstlane(vdst+(slot)))
  const int vb0=(int)(lds0+LDS_V)+((lane>>4)&1)*32+(lane&3)*8+(4*hi+((lane&15)>>2))*64;
  const char*Kbase=shm+LDS_K; bf16x8 kf[8];
  const lds_cptr shm3=(lds_cptr)shm; const lds_cptr kp0=shm3+LDS_K+hi*1024+r32*16; const lds_cptr vp0=shm3+LDS_V+((lane>>4)&1)*32+(lane&3)*8+(4*hi+((lane&15)>>2))*64;
  const int NT=(q0+QB)/KVBLK;
  DMA_K(0,0);DMA_V(0,0);DMA_K(1,SLOTB);
  bf16x8 qr[4];
  #pragma unroll
  for(int d0=0;d0<4;++d0)qr[d0]=*reinterpret_cast<const bf16x8*>(&Qw[(long)r32*DM+d0*16+hi*8]);
  const int qrel=wid*QBLK+r32;
  float mhat; { const u32x4 bw=*(const __attribute__((address_space(3))) u32x4*)(biasF+(q0+qrel)*16); mhat=(__uint_as_float(bw.x<<16)+__uint_as_float(bw.x&0xffff0000u))+__uint_as_float(bw.y<<16); }
  float l_reg=0.f;f32x16 o[2];o[0]=f32x16{};o[1]=f32x16{};bf16x8 qa=make_qa(mhat,hi);
  #define KAUG(tp,half) (*(const __attribute__((address_space(3))) bf16x8*)(biasF+(64*(tp)+32*(half)+r32)*16))
  #define CMASK(P0,P1,t) do{int jb_=3-(t); if(jb_>=0)cmask(P0,P1,jb_,qrel,hi);}while(0)
  bool resc=false;
  #define START(P0,P1) do{ const float rm=rowmax(P0,P1); resc=false; \
    if(__any(rm>(float)THRL)){ const float dl=max2f(rm,0.f); mhat=fadd_s(mhat,dl); \
      _Pragma("unroll") for(int r=0;r<16;++r){P0[r]=fsub_s(P0[r],dl);P1[r]=fsub_s(P1[r],dl);} \
      qa=make_qa(mhat,hi); } \
    _Pragma("unroll") for(int r=0;r<16;++r)P0[r]=__builtin_amdgcn_exp2f(P0[r]); }while(0)
  #define RESC() do{ if(resc){ asm volatile("s_waitcnt lgkmcnt(0)":::"memory"); \
      _Pragma("unroll") for(int d_=0;d_<2;++d_) _Pragma("unroll") for(int r=0;r<16;++r)o[d_][r]*=wsf[crow(r,hi)]; } }while(0)
  f32x16 pA0,pA1,pB0,pB1;
  int sl_prev=0,sl_cur=0,sl_next=SLOTB;
  #define ROT() do{sl_prev=sl_cur;sl_cur=sl_next;sl_next=(sl_next==(NSLOT-1)*SLOTB)?0:sl_next+SLOTB;}while(0)
  DMA_K(2,2*SLOTB);
  WAIT_BAR(3);
  qkt(pA0,pA1,Kbase,qr,r32,hi);{const bf16x8 ka0_=KAUG(NT-1,0),ka1_=KAUG(NT-1,1);pA0=__builtin_amdgcn_mfma_f32_32x32x16_bf16(ka0_,qa,pA0,0,0,0);pA1=__builtin_amdgcn_mfma_f32_32x32x16_bf16(ka1_,qa,pA1,0,0,0);}asm volatile("s_nop 15\n\ts_nop 7":"+v"(pA0),"+v"(pA1));CMASK(pA0,pA1,0);
  START(pA0,pA1);
  _Pragma("unroll") for(int r=0;r<16;++r)pA1[r]=__builtin_amdgcn_exp2f(pA1[r]);
  WAIT_BAR(0);
  DMA_K(3,0);DMA_V(1,SLOTB);
  ROT();
  kload8(kf,kp0+sl_cur);
  WAIT_BAR(2);
  s16x4 vlo[8],vhi[8]; u32x4 pw0,pw1,pw2,pw3;
  #define PKW(P,B) cvtpk_s(P[B],P[B+1])
  #define PAF(k) __builtin_bit_cast(bf16x8,pw##k)
  #define VFR(i) (bf16x8){vlo[i][0],vlo[i][1],vlo[i][2],vlo[i][3],vhi[i][0],vhi[i][1],vhi[i][2],vhi[i][3]}
  #define PIN(x) asm volatile("":"+v"(x))
  #define MX3(a,b,c) __builtin_fmaxf(__builtin_fmaxf((a),(b)),(c))
  #define GAPA(MF,A0,A1,A2,A3,W0,W1,PW) do{ MF; sacc+=A0; sacc+=A1; sacc+=A2; sacc+=A3; PIN(sacc); W0; W1; PIN(PW); SBAR(); }while(0)
  #define EX(v) __builtin_amdgcn_exp2f(v)
  #define GAPB(MF,X,B) do{ MF; X[B]=EX(X[B]); X[B+1]=EX(X[B+1]); X[B+2]=EX(X[B+2]); X[B+3]=EX(X[B+3]); PIN(X); SBAR(); }while(0)
  #define VRD(i) do{ vlo[i]=vtr(vp_+(((i)>>2)*4096+((i)&3)*1024)); vhi[i]=vtr(vp_+(((i)>>2)*4096+((i)&3)*1024+512)); }while(0)
  #define KRD(G,j) do{ if(G){ kload2(kf,kp0+sl_next,j); SBAR(); } }while(0)
  #define STEP(C0,C1,P0,P1,t,GK,GV,GL) do{ SBAR(); \
    const lds_cptr vp_=vp0+sl_prev; \
    VRD(0); SBAR(); float sacc=(P0[0]+P0[1]); \
    GAPA(C0=__builtin_amdgcn_mfma_f32_32x32x16_bf16(kf[0],qr[0],f32x16{},0,0,0), P0[2],P0[3],P0[4],P0[5],     pw0[0]=PKW(P0,0), pw0[1]=PKW(P0,2), pw0); \
    VRD(4); SBAR(); GAPA(C1=__builtin_amdgcn_mfma_f32_32x32x16_bf16(kf[1],qr[0],f32x16{},0,0,0), P0[6],P0[7],P0[8],P0[9],     pw0[2]=PKW(P0,4), pw0[3]=PKW(P0,6), pw0); \
    VRD(1); SBAR(); GAPA(C0=__builtin_amdgcn_mfma_f32_32x32x16_bf16(kf[2],qr[1],C0,0,0,0),   P0[10],P0[11],P0[12],P0[13], pw1[0]=PKW(P0,8), pw1[1]=PKW(P0,10), pw1); \
    VRD(5); SBAR(); GAPA(C1=__builtin_amdgcn_mfma_f32_32x32x16_bf16(kf[3],qr[1],C1,0,0,0),   P0[14],P0[15],P1[0],P1[1],   pw1[2]=PKW(P0,12),pw1[3]=PKW(P0,14), pw1); \
    VRD(2); SBAR(); GAPA(C0=__builtin_amdgcn_mfma_f32_32x32x16_bf16(kf[4],qr[2],C0,0,0,0),   P1[2],P1[3],P1[4],P1[5],     pw2[0]=PKW(P1,0), pw2[1]=PKW(P1,2), pw2); \
    VRD(6); SBAR(); GAPA(C1=__builtin_amdgcn_mfma_f32_32x32x16_bf16(kf[5],qr[2],C1,0,0,0),   P1[6],P1[7],P1[8],P1[9],     pw2[2]=PKW(P1,4), pw2[3]=PKW(P1,6), pw2); \
    VRD(3); const bf16x8 ka0_=KAUG(NT-1-(t),0); SBAR(); GAPA(C0=__builtin_amdgcn_mfma_f32_32x32x16_bf16(kf[6],qr[3],C0,0,0,0),   P1[10],P1[11],P1[12],P1[13], pw3[0]=PKW(P1,8), pw3[1]=PKW(P1,10), pw3); \
    VRD(7); const bf16x8 ka1_=KAUG(NT-1-(t),1); SBAR(); GAPA(C1=__builtin_amdgcn_mfma_f32_32x32x16_bf16(kf[7],qr[3],C1,0,0,0),   P1[14],P1[15],0.f,0.f,       pw3[2]=PKW(P1,12),pw3[3]=PKW(P1,14), pw3); \
    C0=__builtin_amdgcn_mfma_f32_32x32x16_bf16(ka0_,qa,C0,0,0,0); SBAR(); C1=__builtin_amdgcn_mfma_f32_32x32x16_bf16(ka1_,qa,C1,0,0,0); SBAR(); \
    l_reg+=sacc; \
    if(GK){DMA_K((t)+3,sl_cur);} if(GV){DMA_V((t)+1,sl_next);} \
    CMASK(C0,C1,t); \
    { float a=MX3(C0[0],C0[1],C1[0]),b=MX3(C0[2],C0[3],C1[1]); a=MX3(a,C1[2],C1[3]); \
      _Pragma("unroll") for(int r=4;r<16;r+=4){a=MX3(a,C0[r],C0[r+1]);b=MX3(b,C0[r+2],C0[r+3]);a=MX3(a,C1[r],C1[r+1]);b=MX3(b,C1[r+2],C1[r+3]);} \
      float rm=__builtin_fmaxf(a,b); { auto rr=__builtin_amdgcn_permlane32_swap(__float_as_uint(rm),__float_as_uint(rm),false,false); rm=__builtin_fmaxf(__uint_as_float(rr[0]),__uint_as_float(rr[1])); } \
      resc=false; \
      if(__builtin_expect(__any(rm>(float)THRL),0)){ const float dl=__builtin_fmaxf(rm,0.f); mhat+=dl; \
        _Pragma("unroll") for(int r=0;r<16;++r){C0[r]-=dl;C1[r]-=dl;} \
        qa=make_qa(mhat,hi); \
        const float f=__builtin_amdgcn_exp2f(-dl); l_reg*=f; if(hi==0)wsf[r32]=f; resc=true; } } \
    SBAR(); \
    GAPB(o[0]=__builtin_amdgcn_mfma_f32_32x32x16_bf16(PAF(0),VFR(0),o[0],0,0,0), C0,0); \
    GAPB(o[1]=__builtin_amdgcn_mfma_f32_32x32x16_bf16(PAF(0),VFR(4),o[1],0,0,0), C0,4); \
    KRD(GL,0); GAPB(o[0]=__builtin_amdgcn_mfma_f32_32x32x16_bf16(PAF(1),VFR(1),o[0],0,0,0), C0,8); \
    KRD(GL,1); GAPB(o[1]=__builtin_amdgcn_mfma_f32_32x32x16_bf16(PAF(1),VFR(5),o[1],0,0,0), C0,12); \
    KRD(GL,2); GAPB(o[0]=__builtin_amdgcn_mfma_f32_32x32x16_bf16(PAF(2),VFR(2),o[0],0,0,0), C1,0); \
    KRD(GL,3); GAPB(o[1]=__builtin_amdgcn_mfma_f32_32x32x16_bf16(PAF(2),VFR(6),o[1],0,0,0), C1,4); \
    GAPB(o[0]=__builtin_amdgcn_mfma_f32_32x32x16_bf16(PAF(3),VFR(3),o[0],0,0,0), C1,8); \
    GAPB(o[1]=__builtin_amdgcn_mfma_f32_32x32x16_bf16(PAF(3),VFR(7),o[1],0,0,0), C1,12); \
    }while(0)
  int t=1;
  #define ENDW(tt) do{ if((tt)+3<NT){WAIT_BAR(2);} else if((tt)+2<NT){WAIT_BAR(1);} else {WAIT_BAR(0);} }while(0)
  for(;t+1<NT;t+=2){
    STEP(pB0,pB1,pA0,pA1,t,(t+3<NT),(t+1<NT),(t+1<NT));       ENDW(t);   RESC(); ROT();
    STEP(pA0,pA1,pB0,pB1,t+1,(t+4<NT),(t+2<NT),(t+2<NT));     ENDW(t+1); RESC(); ROT();
  }
  STEP(pB0,pB1,pA0,pA1,NT-1,false,false,false); RESC();
  { float sacc=pB0[0]+pB0[1]; _Pragma("unroll") for(int r=2;r<16;++r)sacc+=pB0[r]; _Pragma("unroll") for(int r=0;r<16;++r)sacc+=pB1[r]; l_reg+=sacc;
    pw0=(u32x4){PKW(pB0,0),PKW(pB0,2),PKW(pB0,4),PKW(pB0,6)};pw1=(u32x4){PKW(pB0,8),PKW(pB0,10),PKW(pB0,12),PKW(pB0,14)};pw2=(u32x4){PKW(pB1,0),PKW(pB1,2),PKW(pB1,4),PKW(pB1,6)};pw3=(u32x4){PKW(pB1,8),PKW(pB1,10),PKW(pB1,12),PKW(pB1,14)};
    SBAR(); pv(o,vb0+sl_cur,PAF(0),PAF(1),PAF(2),PAF(3)); }
  #undef PKW
  #undef PAF
  #undef VFR
  #undef PIN
  #undef MX3
  #undef GAPA
  #undef GAPB
  #undef EX
  #undef VRD
  #undef KRD
  #undef STEP
  #undef ENDW
  {auto rr=__builtin_amdgcn_permlane32_swap(__float_as_uint(l_reg),__float_as_uint(l_reg),false,false);l_reg=__uint_as_float(rr[0])+__uint_as_float(rr[1]);}
  if(hi==0)wsf[32+r32]=l_reg;asm volatile("s_waitcnt lgkmcnt(0)":::"memory");
  float rli[16];
  #pragma unroll
  for(int r=0;r<16;++r)rli[r]=__builtin_amdgcn_rcpf(wsf[32+crow(r,hi)]);
  bf16*Ow=O+(rowbase+q0+wid*QBLK)*OPITCH+h*D;
  { bf16*stg=(bf16*)(shm+LDS_OST)+wid*2048;
    #pragma unroll
    for(int r=0;r<16;++r){const int orow=crow(r,hi);
      #pragma unroll
      for(int d0=0;d0<2;++d0)stg[orow*64+d0*32+r32]=__float2bfloat16(o[d0][r]*rli[r]);}
    asm volatile("s_waitcnt lgkmcnt(0)":::"memory");
    #pragma unroll
    for(int i=0;i<4;++i){const int row=i*8+(lane>>3),ch=lane&7; const u32x4 v=*(const u32x4*)(stg+row*64+ch*8); ATTN_STORE16(Ow+(long)row*OPITCH+ch*8,v);} }
  asm volatile("s_waitcnt lgkmcnt(0)\n\ts_barrier":::"memory");
  #undef DMA_K
  #undef DMA_V
  #undef CMASK
  #undef KAUG
  #undef START
  #undef RESC
  #undef ROT
}
constexpr int ATTN_LDS_BYTES=LDS_BYTES;
struct AttnTensors { const bf16* Q; const bf16* K; const bf16* V; bf16* O; };
struct AttnUnit { int bh; int qb; };
#undef SBAR
#undef WAIT_BAR
}
#define GAS __attribute__((address_space(1)))
#define LAS __attribute__((address_space(3)))
typedef unsigned short bf16;
typedef unsigned v4u __attribute__((ext_vector_type(4)));
typedef float f32x4 __attribute__((ext_vector_type(4)));
typedef short bf16x8 __attribute__((ext_vector_type(8)));
typedef GAS unsigned gu32;
typedef GAS unsigned long long gu64;
#define RLX_AGENT __ATOMIC_RELAXED, __HIP_MEMORY_SCOPE_AGENT
#define LDS_WAIT() asm volatile("s_waitcnt lgkmcnt(0)" ::: "memory")
#define VM_WAIT() asm volatile("s_waitcnt vmcnt(0)" ::: "memory")
__device__ __forceinline__ unsigned long long rt() { return __builtin_amdgcn_s_memrealtime(); }
__device__ __forceinline__ unsigned f2bf(float f) { unsigned u = __builtin_bit_cast(unsigned, f); return (u + 0x7fffu + ((u >> 16) & 1u)) >> 16; }
__device__ __forceinline__ unsigned pk2(float lo, float hi) { return f2bf(lo) | (f2bf(hi) << 16); }

#define XB_TMO      128
#define XB_XCNT(j)  (256  + 64 * (j))
#define XB_XSUB(j)  (1280 + 64 * (j))
#define XB_XGEN(j)  (2304 + 64 * (j))
#define XB_TOP      3328
#define XB_TOPGEN   3392
#define XCD_BAR_WORDS 3456
#define XB_SPIN_CAP (1u << 18)

__device__ __forceinline__ unsigned xb_ld(unsigned* p)              { return __hip_atomic_load(p, __ATOMIC_RELAXED, __HIP_MEMORY_SCOPE_AGENT); }
__device__ __forceinline__ unsigned xb_add(unsigned* p, unsigned v) { return __hip_atomic_fetch_add(p, v, __ATOMIC_RELAXED, __HIP_MEMORY_SCOPE_AGENT); }
__device__ __forceinline__ unsigned xb_xcc_id() { return (unsigned)__builtin_amdgcn_s_getreg((3 << 11) | 20) & 0xFu; }
#define XB_SPIN(cond, bar) do { unsigned _sp = 0; while (cond) { __builtin_amdgcn_s_sleep(1); \
    if ((++_sp & 255u) == 0u) { if (xb_ld(&(bar)[XB_TMO])) break; if (_sp > XB_SPIN_CAP) { atomicAdd(&(bar)[XB_TMO], 1u); break; } } } } while (0)

struct XcdBarrier {
    unsigned* bar; unsigned x;
    volatile LAS unsigned* st;
};

__device__ __forceinline__ XcdBarrier xcd_barrier_post(unsigned* bar, volatile LAS unsigned* st) {
    XcdBarrier b; b.bar = bar; b.x = xb_xcc_id(); b.st = st;
    if (threadIdx.x == 0) (void)xb_add(&bar[XB_XCNT(b.x)], 1u);
    return b;
}
__device__ __forceinline__ void xcd_barrier_complete(unsigned* bar, unsigned x, unsigned& nloc, unsigned& nx) {
    const unsigned G = gridDim.x * gridDim.y * gridDim.z;
    unsigned sum, cnt, mine, sp = 0u;
    for (;;) {
        sum = 0u; cnt = 0u; mine = 0u;
#pragma unroll
        for (unsigned j = 0; j < 16; ++j) { const unsigned c = xb_ld(&bar[XB_XCNT(j)]); sum += c; cnt += (c > 0u) ? 1u : 0u; mine = (j == x) ? c : mine; }
        if (sum == G) break;
        __builtin_amdgcn_s_sleep(1);
        if ((++sp & 255u) == 0u) { if (xb_ld(&bar[XB_TMO])) break; if (sp > XB_SPIN_CAP) { atomicAdd(&bar[XB_TMO], 1u); break; } }
    }
    nloc = mine > 0u ? mine : 1u; nx = cnt > 0u ? cnt : 1u;
}

__device__ __forceinline__ void xcd_barrier(const XcdBarrier& b) {
    asm volatile("s_waitcnt vmcnt(0)" ::: "memory");
    __syncthreads();
    if (threadIdx.x == 0) {
        unsigned* bar = b.bar;
        __builtin_amdgcn_s_waitcnt(0);
        unsigned nloc = b.st[0], nx = b.st[1];
        if (nloc == 0u) { xcd_barrier_complete(bar, b.x, nloc, nx); b.st[0] = nloc; b.st[1] = nx; }
        const unsigned old = xb_add(&bar[XB_XSUB(b.x)], 1u);
        const unsigned gen = old / nloc;
        if (old + 1u == (gen + 1u) * nloc) {
            __builtin_amdgcn_fence(__ATOMIC_RELEASE, "agent");
            asm volatile("s_waitcnt vmcnt(0)" ::: "memory");
            const unsigned og = xb_add(&bar[XB_TOP], 1u);
            const unsigned tg = og / nx;
            if (og + 1u == (tg + 1u) * nx) xb_add(&bar[XB_TOPGEN], 1u);
            else XB_SPIN(xb_ld(&bar[XB_TOPGEN]) == tg, bar);
            __builtin_amdgcn_fence(__ATOMIC_ACQUIRE, "agent");
            xb_add(&bar[XB_XGEN(b.x)], 1u);
            asm volatile("s_waitcnt vmcnt(0)" ::: "memory");
        } else {
            XB_SPIN(xb_ld(&bar[XB_XGEN(b.x)]) == gen, bar);
            __builtin_amdgcn_fence(__ATOMIC_ACQUIRE, "agent");
            asm volatile("s_waitcnt vmcnt(0)" ::: "memory");
        }
    }
    __syncthreads();
}


constexpr int NWAVES = 8, NTHR = NWAVES * 64;
constexpr int DMODEL = 1024, NB = 8, SEQ = 2048, MP = NB * SEQ, DB = 128, MT = MP + DB, MPAD = 16640;
constexpr int FH = 8, FD = 64, FW = 512, GH = 4, GD = 128, GW = 512, FFN = 2816;
constexpr int NIN = 3840, NUP = 2 * FFN, NGQKV = 3 * GW;
constexpr int NPAGES = 16, PAGE = 128;
constexpr float EPS = 1e-6f, LOG2E = 1.4426950408889634f, QSCALE = 0.08838834764831845f;
constexpr int NCHUNK = 32, NCH_TOT = NB * GH * NCHUNK;
constexpr size_t OUT_YP = 0, OUT_YS = OUT_YP + (size_t)MP * DMODEL, OUT_KP = OUT_YS + (size_t)DB * DMODEL, OUT_VP = OUT_KP + (size_t)MP * FW,
    OUT_LFP = OUT_VP + (size_t)MP * FW, OUT_GSP = OUT_LFP + (size_t)MP * FH, OUT_GCP = OUT_GSP + (size_t)NB * GH * GD * GD, OUT_FCP = OUT_GCP + (size_t)NB * 3 * NGQKV,
    OUT_KS = OUT_FCP + (size_t)NB * 2 * FFN, OUT_VS = OUT_KS + (size_t)DB * FW, OUT_LFS = OUT_VS + (size_t)DB * FW, OUT_GSS = OUT_LFS + (size_t)DB * FH,
    OUT_GCS = OUT_GSS + (size_t)DB * GH * GD * GD, OUT_FCS = OUT_GCS + (size_t)DB * 3 * NGQKV, OUT_END = OUT_FCS + (size_t)DB * 2 * FFN;
static_assert(OUT_END == 44254208, "output size");
constexpr size_t MiB = 1u << 20;
constexpr size_t WS_CTL = 0, CTL_ZERO_BYTES = 1 * MiB;
constexpr size_t WS_WIN = 2 * MiB, WS_WOUT = 10 * MiB, WS_WUP = 12 * MiB, WS_WDN = 23 * MiB, WS_GATE = 29 * MiB, WS_PT = 31 * MiB, WS_DPART = 32 * MiB;
constexpr size_t WS_XN = 40 * MiB, WS_QB = 73 * MiB, WS_KB = 90 * MiB, WS_VB = 107 * MiB, WS_GQKV = 124 * MiB, WS_GZ = 173 * MiB, WS_MIX = 190 * MiB;
constexpr size_t WS_X1 = 223 * MiB, WS_GU = 288 * MiB, WS_ACT = 467 * MiB, WS_X2 = 557 * MiB, WS_GDN = 622 * MiB, WS_GL = 694 * MiB, WS_END = 695 * MiB;
constexpr size_t GDN_CH_BYTES = 73728;
static_assert(WS_GDN + (size_t)NCH_TOT * GDN_CH_BYTES <= WS_GL, "gdn chunk buffers");
static_assert(WS_GU + (size_t)MPAD * NUP * 2 <= WS_ACT && WS_ACT + (size_t)MPAD * FFN * 2 <= WS_X2 && WS_X2 + (size_t)MPAD * DMODEL * 4 <= WS_GDN, "ws map");
constexpr int CW_BAR = 4096;
constexpr int RING_OFF = 0, RING_BYTES = 131072, LDSCTL_OFF = RING_BYTES, MISC_OFF = LDSCTL_OFF + 320, LDS_BYTES = 147456;
constexpr int BIAS_OFF = 86016, WTOT_OFF = BIAS_OFF + 32768;
static_assert(attn_body::ATTN_LDS_BYTES <= BIAS_OFF && WTOT_OFF + 64 <= RING_BYTES, "attention LDS");
constexpr int NPH = 10;

typedef float f32x2v __attribute__((ext_vector_type(2)));
__device__ __forceinline__ float bf2f(unsigned short u) { return __uint_as_float((unsigned)u << 16); }
__device__ __forceinline__ float bflo(unsigned u) { return __uint_as_float(u << 16); }
__device__ __forceinline__ float bfhi(unsigned u) { return __uint_as_float(u & 0xffff0000u); }
__device__ __forceinline__ float wave_sum(float v) {
#pragma unroll
    for (int o = 1; o < 64; o <<= 1) v += __shfl_xor(v, o);
    return v;
}
__device__ __forceinline__ float sigmoidf_(float x) { return 1.f / (1.f + __expf(-x)); }
__device__ __forceinline__ float siluf_(float x) { return x / (1.f + __expf(-x)); }
__device__ __forceinline__ float softplusf_(float x) { return fmaxf(x, 0.f) + log1pf(expf(-fabsf(x))); }

struct EpiInProj {
    static constexpr bool PERM = true, AFTER_DRAIN = false;
    bf16 *QB, *KB, *VB, *GQKV, *GZ; float* GATE; float* out; const float *b_forget, *a_log, *dt_bias;
    __device__ __forceinline__ void operator()(const pg8::f32x4 (&acc)[2][2][4][2], const pg8::Unit& u, int wr, int wc, int fr, int fq) const {
        const int pn = u.pn;
#pragma unroll
        for (int ai = 0; ai < 2; ++ai)
#pragma unroll
            for (int m = 0; m < 4; ++m) {
                const int row = u.pm * 256 + ai * 128 + wr * 64 + m * 16 + fr;
#pragma unroll
                for (int bj = 0; bj < 2; ++bj) {
                    const int col8 = bj * 128 + wc * 32 + 8 * fq;
                    const pg8::f32x4 v0 = acc[ai][bj][m][0], v1 = acc[ai][bj][m][1];
                    if (pn < 2) {
                        const float s = attn_body::C2; v4u w; w.x = pg8::cvt_pk_bf16(v0[0] * s, v0[1] * s); w.y = pg8::cvt_pk_bf16(v0[2] * s, v0[3] * s); w.z = pg8::cvt_pk_bf16(v1[0] * s, v1[1] * s); w.w = pg8::cvt_pk_bf16(v1[2] * s, v1[3] * s);
                        *(v4u*)(QB + (size_t)row * FW + pn * 256 + col8) = w;
                    } else if (pn < 6) {
                        const int isv = pn >= 4, c = (pn - (isv ? 4 : 2)) * 256 + col8;
                        v4u w; w.x = pg8::cvt_pk_bf16(v0[0], v0[1]); w.y = pg8::cvt_pk_bf16(v0[2], v0[3]); w.z = pg8::cvt_pk_bf16(v1[0], v1[1]); w.w = pg8::cvt_pk_bf16(v1[2], v1[3]);
                        *(v4u*)((isv ? VB : KB) + (size_t)row * FW + c) = w;
                        if (row < MT) { float* o = out + (row < MP ? (isv ? OUT_VP : OUT_KP) + (size_t)row * FW : (isv ? OUT_VS : OUT_KS) + (size_t)(row - MP) * FW) + c;
                            *(pg8::f32x4*)o = v0; *(pg8::f32x4*)(o + 4) = v1; }
                    } else if (pn < 12) {
                        const int c = (pn - 6) * 256 + col8;
                        v4u w; w.x = pg8::cvt_pk_bf16(v0[0], v0[1]); w.y = pg8::cvt_pk_bf16(v0[2], v0[3]); w.z = pg8::cvt_pk_bf16(v1[0], v1[1]); w.w = pg8::cvt_pk_bf16(v1[2], v1[3]);
                        *(v4u*)(GQKV + (size_t)row * NGQKV + c) = w;
                        if (row < MP) { const int t = row & (SEQ - 1), b = row >> 11;
                            if (t >= SEQ - 3) { float* o = out + OUT_GCP + (size_t)(b * 3 + (t - (SEQ - 3))) * NGQKV + c; *(pg8::f32x4*)o = v0; *(pg8::f32x4*)(o + 4) = v1; } }
                        else if (row < MT) { float* o = out + OUT_GCS + (size_t)((row - MP) * 3 + 2) * NGQKV + c; *(pg8::f32x4*)o = v0; *(pg8::f32x4*)(o + 4) = v1; }
                    } else if (pn < 14) {
                        v4u w; w.x = pg8::cvt_pk_bf16(v0[0], v0[1]); w.y = pg8::cvt_pk_bf16(v0[2], v0[3]); w.z = pg8::cvt_pk_bf16(v1[0], v1[1]); w.w = pg8::cvt_pk_bf16(v1[2], v1[3]);
                        *(v4u*)(GZ + (size_t)row * GW + (pn - 12) * 256 + col8) = w;
                    } else {
                        if (col8 == 0) {
                            float lf[8];
#pragma unroll
                            for (int j = 0; j < 8; ++j) { const float x = (j < 4 ? v0[j] : v1[j - 4]) + b_forget[j]; lf[j] = -softplusf_(-x); }
                            float* g = GATE + (size_t)row * 16; *(pg8::f32x4*)g = (pg8::f32x4){lf[0], lf[1], lf[2], lf[3]}; *(pg8::f32x4*)(g + 4) = (pg8::f32x4){lf[4], lf[5], lf[6], lf[7]};
                            if (row < MT) { float* o = out + (row < MP ? OUT_LFP + (size_t)row * FH : OUT_LFS + (size_t)(row - MP) * FH);
                                *(pg8::f32x4*)o = (pg8::f32x4){lf[0], lf[1], lf[2], lf[3]}; *(pg8::f32x4*)(o + 4) = (pg8::f32x4){lf[4], lf[5], lf[6], lf[7]}; }
                        } else if (col8 == 8) {
                            float gg[4], be[4];
#pragma unroll
                            for (int j = 0; j < 4; ++j) { gg[j] = -expf(a_log[j]) * softplusf_(v0[j] + dt_bias[j]); be[j] = 1.f / (1.f + expf(-v1[j])); }
                            float* g = GATE + (size_t)row * 16 + 8; *(pg8::f32x4*)g = (pg8::f32x4){gg[0], gg[1], gg[2], gg[3]}; *(pg8::f32x4*)(g + 4) = (pg8::f32x4){be[0], be[1], be[2], be[3]};
                        }
                    }
                }
            }
    }
};
struct EpiResid {
    static constexpr bool PERM = true, AFTER_DRAIN = false;
    const float* basep; const float* bases; float* dst;
    __device__ __forceinline__ void operator()(const pg8::f32x4 (&acc)[2][2][4][2], const pg8::Unit& u, int wr, int wc, int fr, int fq) const {
#pragma unroll
        for (int ai = 0; ai < 2; ++ai)
#pragma unroll
            for (int m = 0; m < 4; ++m) {
                const int row = u.pm * 256 + ai * 128 + wr * 64 + m * 16 + fr;
                if (row < MT) {
                    const float* src = row < MP ? basep + (size_t)row * DMODEL : bases + (size_t)(row - MP) * DMODEL;
#pragma unroll
                    for (int bj = 0; bj < 2; ++bj) { const int c = u.pn * 256 + bj * 128 + wc * 32 + 8 * fq;
                        const pg8::f32x4 r0 = *(const pg8::f32x4*)(src + c), r1 = *(const pg8::f32x4*)(src + c + 4);
                        *(pg8::f32x4*)(dst + (size_t)row * DMODEL + c) = r0 + acc[ai][bj][m][0]; *(pg8::f32x4*)(dst + (size_t)row * DMODEL + c + 4) = r1 + acc[ai][bj][m][1]; }
                }
            }
    }
};
struct EpiUp {
    static constexpr bool PERM = true, AFTER_DRAIN = false;
    bf16* GU; float* out;
    __device__ __forceinline__ void operator()(const pg8::f32x4 (&acc)[2][2][4][2], const pg8::Unit& u, int wr, int wc, int fr, int fq) const {
#pragma unroll
        for (int ai = 0; ai < 2; ++ai)
#pragma unroll
            for (int m = 0; m < 4; ++m) {
                const int row = u.pm * 256 + ai * 128 + wr * 64 + m * 16 + fr;
#pragma unroll
                for (int bj = 0; bj < 2; ++bj) { const int c = u.pn * 256 + bj * 128 + wc * 32 + 8 * fq;
                    const pg8::f32x4 v0 = acc[ai][bj][m][0], v1 = acc[ai][bj][m][1];
                    v4u w; w.x = pg8::cvt_pk_bf16(v0[0], v0[1]); w.y = pg8::cvt_pk_bf16(v0[2], v0[3]); w.z = pg8::cvt_pk_bf16(v1[0], v1[1]); w.w = pg8::cvt_pk_bf16(v1[2], v1[3]);
                    *(v4u*)(GU + (size_t)row * NUP + c) = w;
                    if (c < FFN) {
                        if (row < MP) { const int t = row & (SEQ - 1), b = row >> 11;
                            if (t >= SEQ - 2) { float* o = out + OUT_FCP + (size_t)(b * 2 + (t - (SEQ - 2))) * FFN + c; *(pg8::f32x4*)o = v0; *(pg8::f32x4*)(o + 4) = v1; } }
                        else if (row < MT) { float* o = out + OUT_FCS + (size_t)((row - MP) * 2 + 1) * FFN + c; *(pg8::f32x4*)o = v0; *(pg8::f32x4*)(o + 4) = v1; }
                    }
                }
            }
    }
};
struct EpiResid2 {
    static constexpr bool PERM = true, AFTER_DRAIN = false;
    const float* base; float* dst;
    __device__ __forceinline__ void operator()(const pg8::f32x4 (&acc)[2][2][4][2], const pg8::Unit& u, int wr, int wc, int fr, int fq) const {
#pragma unroll
        for (int ai = 0; ai < 2; ++ai)
#pragma unroll
            for (int m = 0; m < 4; ++m) {
                const int row = u.pm * 256 + ai * 128 + wr * 64 + m * 16 + fr;
                if (row < MT) {
#pragma unroll
                    for (int bj = 0; bj < 2; ++bj) { const size_t off = (size_t)row * DMODEL + u.pn * 256 + bj * 128 + wc * 32 + 8 * fq;
                        const pg8::f32x4 r0 = *(const pg8::f32x4*)(base + off), r1 = *(const pg8::f32x4*)(base + off + 4);
                        *(pg8::f32x4*)(dst + off) = r0 + acc[ai][bj][m][0]; *(pg8::f32x4*)(dst + off + 4) = r1 + acc[ai][bj][m][1]; }
                }
            }
    }
};

template <class SMap>
__device__ __forceinline__ void transpose_item(const float* W, int K, int Nsrc, bf16* WT, LAS float* scr, int kb, int nb, int lane, SMap smap) {
    const int k0 = 64 * kb, n0 = 32 * nb; const int ns = smap(n0 + (lane & 31));
#pragma unroll 8
    for (int i = 0; i < 32; ++i) { const int kk = 2 * i + (lane >> 5); scr[kk * 33 + (lane & 31)] = ns >= 0 ? W[(size_t)(k0 + kk) * Nsrc + ns] : 0.f; }
    LDS_WAIT(); asm volatile("" ::: "memory");
    const int c = lane & 7;
#pragma unroll
    for (int j = 0; j < 4; ++j) { const int n = (lane >> 3) + 8 * j; const LAS float* s = scr + (8 * c) * 33 + n;
        v4u o; o.x = pk2(s[0 * 33], s[1 * 33]); o.y = pk2(s[2 * 33], s[3 * 33]); o.z = pk2(s[4 * 33], s[5 * 33]); o.w = pk2(s[6 * 33], s[7 * 33]);
        *(GAS v4u*)(WT + (size_t)(n0 + n) * K + k0 + 8 * c) = o; }
    LDS_WAIT(); asm volatile("" ::: "memory");
}
struct SMapIn { __device__ __forceinline__ int operator()(int nd) const { return nd < 1536 ? nd : nd < 3072 ? nd + 8 : nd < 3584 ? nd + 16 : nd < 3592 ? nd - 3584 + 1536 : nd < 3600 ? nd - 3592 + 3080 : -1; } };
struct SMapId { __device__ __forceinline__ int operator()(int nd) const { return nd; } };
__device__ __forceinline__ void rms_row_to_bf16(const float* xrow, const float* gain, bf16* orow, int lane) {
    const f32x4* xr = (const f32x4*)xrow + lane; const f32x4* gr = (const f32x4*)gain + lane;
    f32x4 v[4]; float s = 0.f;
#pragma unroll
    for (int j = 0; j < 4; ++j) { v[j] = xr[64 * j]; s += (v[j].x * v[j].x + v[j].y * v[j].y) + (v[j].z * v[j].z + v[j].w * v[j].w); }
    const float rs = rsqrtf(wave_sum(s) * (1.f / DMODEL) + EPS);
    unsigned long long* o8 = (unsigned long long*)orow + lane;
#pragma unroll
    for (int j = 0; j < 4; ++j) { const f32x4 g = gr[64 * j]; o8[64 * j] = (unsigned long long)pk2(v[j].x * rs * g.x, v[j].y * rs * g.y) | ((unsigned long long)pk2(v[j].z * rs * g.z, v[j].w * rs * g.w) << 32); }
}
__device__ __forceinline__ void rms_row_to_f32(const float* xrow, const float* gain, float* orow, int lane) {
    const f32x4* xr = (const f32x4*)xrow + lane; const f32x4* gr = (const f32x4*)gain + lane;
    f32x4 v[4]; float s = 0.f;
#pragma unroll
    for (int j = 0; j < 4; ++j) { v[j] = xr[64 * j]; s += (v[j].x * v[j].x + v[j].y * v[j].y) + (v[j].z * v[j].z + v[j].w * v[j].w); }
    const float rs = rsqrtf(wave_sum(s) * (1.f / DMODEL) + EPS);
#pragma unroll
    for (int j = 0; j < 4; ++j) { const f32x4 g = gr[64 * j]; ((f32x4*)orow + lane)[64 * j] = (f32x4){v[j].x * rs * g.x, v[j].y * rs * g.y, v[j].z * rs * g.z, v[j].w * rs * g.w}; }
}

struct Args { const float* in[23]; float* out; unsigned char* ws; int ph_lo, ph_hi; };
static_assert(sizeof(Args) == 25 * 8 + 8, "Args has no padding");

__device__ __forceinline__ void fox_bias_build(const float* GATE, int b, int h, int NK, LAS v4u* biasF, LAS float* wtot, int tid) {
    const int lane = tid & 63, wave = tid >> 6;
    float v[4]; float run = 0.f;
#pragma unroll
    for (int i = 0; i < 4; ++i) { const int s = 4 * tid + i; const float x = (s < NK) ? GATE[(size_t)(b * SEQ + s) * 16 + h] : 0.f; run += x; v[i] = run; }
    float incl = run;
#pragma unroll
    for (int o = 1; o < 64; o <<= 1) { const float y = __shfl_up(incl, o); if (lane >= o) incl += y; }
    if (lane == 63) wtot[wave] = incl;
    __syncthreads();
    float off = incl - run;
    for (int w = 0; w < wave; ++w) off += wtot[w];
    float tot = 0.f;
    for (int w = 0; w < NWAVES; ++w) tot += wtot[w];
#pragma unroll
    for (int i = 0; i < 4; ++i) { unsigned bh_, bm_, bl_; attn_body::split3((tot - (v[i] + off)) * LOG2E, bh_, bm_, bl_);
        biasF[4 * tid + i] = (v4u){bh_ | (bm_ << 16), bl_ | 0xBF800000u, 0xBF80BF80u, 0u}; }
    __syncthreads();
}

constexpr int PR_R = 0, PR_A = 65536, PR_KB = PR_A + 64 * 68 * 4, PR_QB = PR_KB + 64 * 136 * 2, PR_GC = PR_QB + 64 * 136 * 2, PR_BT = PR_GC + 256;
static_assert(PR_BT + 256 <= RING_BYTES, "prep LDS");
__device__ __forceinline__ void gdn_prep_unit(LAS unsigned char* lds, int ci, const bf16* GQKV, const float* GATE, const float* wconv, unsigned char* gdnbuf, float* GLb, int tid) {
    const int lane = tid & 63, wave = __builtin_amdgcn_readfirstlane(tid >> 6);
    const int bh = ci >> 5, n = ci & 31, b = bh >> 2, h = bh & 3;
    const int m0 = b * SEQ + n * 64;
    LAS float* R = (LAS float*)(lds + PR_R); LAS float* A = (LAS float*)(lds + PR_A); LAS bf16* Kb = (LAS bf16*)(lds + PR_KB); LAS bf16* Qb = (LAS bf16*)(lds + PR_QB);
    LAS float* gc = (LAS float*)(lds + PR_GC); LAS float* bt = (LAS float*)(lds + PR_BT);
    bf16* Ug = (bf16*)(gdnbuf + (size_t)ci * GDN_CH_BYTES); bf16* Wg = Ug + 8192; bf16* QDg = Ug + 16384; bf16* KDTg = Ug + 24576; bf16* QKg = Ug + 32768;
    if (wave == 0) {
        const float g = GATE[(size_t)(m0 + lane) * 16 + 8 + h], be = GATE[(size_t)(m0 + lane) * 16 + 12 + h];
        float incl = g;
#pragma unroll
        for (int o = 1; o < 64; o <<= 1) { const float y = __shfl_up(incl, o); if (lane >= o) incl += y; }
        gc[lane] = incl; bt[lane] = be;
        if (lane == 63) GLb[ci] = __expf(incl);
    }
    __syncthreads();
    {
        const int i = tid >> 3, sub = tid & 7, t = n * 64 + i;
        const float gci = gc[i], bti = bt[i], eg = __expf(gci), egl = __expf(gc[63] - gci);
#pragma unroll 1
        for (int sec = 0; sec < 3; ++sec) {
            const int cb = sec * GW + h * GD + sub * 16;
            float y[16];
#pragma unroll
            for (int c = 0; c < 16; ++c) y[c] = 0.f;
#pragma unroll
            for (int tap = 0; tap < 4; ++tap) {
                const int tt = t - 3 + tap;
                if (tt >= 0) {
                    const v4u x0 = *(const v4u*)(GQKV + (size_t)(b * SEQ + tt) * NGQKV + cb), x1 = *(const v4u*)(GQKV + (size_t)(b * SEQ + tt) * NGQKV + cb + 8);
                    const float* wp = wconv + tap * NGQKV + cb;
                    const f32x4 w0 = *(const f32x4*)wp, w1 = *(const f32x4*)(wp + 4), w2 = *(const f32x4*)(wp + 8), w3 = *(const f32x4*)(wp + 12);
                    y[0] += w0.x * bflo(x0.x); y[1] += w0.y * bfhi(x0.x); y[2] += w0.z * bflo(x0.y); y[3] += w0.w * bfhi(x0.y);
                    y[4] += w1.x * bflo(x0.z); y[5] += w1.y * bfhi(x0.z); y[6] += w1.z * bflo(x0.w); y[7] += w1.w * bfhi(x0.w);
                    y[8] += w2.x * bflo(x1.x); y[9] += w2.y * bfhi(x1.x); y[10] += w2.z * bflo(x1.y); y[11] += w2.w * bfhi(x1.y);
                    y[12] += w3.x * bflo(x1.z); y[13] += w3.y * bfhi(x1.z); y[14] += w3.z * bflo(x1.w); y[15] += w3.w * bfhi(x1.w);
                }
            }
            float ss = 0.f;
#pragma unroll
            for (int c = 0; c < 16; ++c) { y[c] = siluf_(y[c]); ss += y[c] * y[c]; }
            if (sec < 2) {
                ss += __shfl_xor(ss, 1); ss += __shfl_xor(ss, 2); ss += __shfl_xor(ss, 4);
                const float r = rsqrtf(ss + EPS) * (sec == 0 ? QSCALE : 1.f);
#pragma unroll
                for (int c = 0; c < 16; ++c) y[c] *= r;
            }
            if (sec == 0) {
                v4u a, bq, c0, c1;
                a.x = pk2(y[0], y[1]); a.y = pk2(y[2], y[3]); a.z = pk2(y[4], y[5]); a.w = pk2(y[6], y[7]); bq.x = pk2(y[8], y[9]); bq.y = pk2(y[10], y[11]); bq.z = pk2(y[12], y[13]); bq.w = pk2(y[14], y[15]);
                *(LAS v4u*)(Qb + i * 136 + sub * 16) = a; *(LAS v4u*)(Qb + i * 136 + sub * 16 + 8) = bq;
                c0.x = pk2(y[0] * eg, y[1] * eg); c0.y = pk2(y[2] * eg, y[3] * eg); c0.z = pk2(y[4] * eg, y[5] * eg); c0.w = pk2(y[6] * eg, y[7] * eg);
                c1.x = pk2(y[8] * eg, y[9] * eg); c1.y = pk2(y[10] * eg, y[11] * eg); c1.z = pk2(y[12] * eg, y[13] * eg); c1.w = pk2(y[14] * eg, y[15] * eg);
                *(v4u*)(QDg + i * 128 + sub * 16) = c0; *(v4u*)(QDg + i * 128 + sub * 16 + 8) = c1;
            } else if (sec == 1) {
                v4u a, bq;
                a.x = pk2(y[0], y[1]); a.y = pk2(y[2], y[3]); a.z = pk2(y[4], y[5]); a.w = pk2(y[6], y[7]); bq.x = pk2(y[8], y[9]); bq.y = pk2(y[10], y[11]); bq.z = pk2(y[12], y[13]); bq.w = pk2(y[14], y[15]);
                *(LAS v4u*)(Kb + i * 136 + sub * 16) = a; *(LAS v4u*)(Kb + i * 136 + sub * 16 + 8) = bq;
                const float wsc = bti * eg;
#pragma unroll
                for (int c = 0; c < 16; ++c) { R[i * 256 + 128 + sub * 16 + c] = y[c] * wsc; KDTg[(sub * 16 + c) * 64 + i] = (bf16)f2bf(y[c] * egl); }
            } else {
#pragma unroll
                for (int c = 0; c < 16; ++c) R[i * 256 + sub * 16 + c] = y[c] * bti;
            }
        }
    }
    __syncthreads();
    {
        const int mt = wave >> 1, q4 = lane >> 4, l15 = lane & 15;
#pragma unroll
        for (int e = 0; e < 2; ++e) {
            const int nt = 2 * (wave & 1) + e;
            f32x4 akk = (f32x4){0.f, 0.f, 0.f, 0.f}, aqk = (f32x4){0.f, 0.f, 0.f, 0.f};
            if (nt <= mt) {
#pragma unroll
                for (int ks = 0; ks < 4; ++ks) {
                    const bf16x8 ak = *(const LAS bf16x8*)(Kb + (16 * mt + l15) * 136 + 32 * ks + 8 * q4), aq = *(const LAS bf16x8*)(Qb + (16 * mt + l15) * 136 + 32 * ks + 8 * q4);
                    const bf16x8 bk = *(const LAS bf16x8*)(Kb + (16 * nt + l15) * 136 + 32 * ks + 8 * q4);
                    akk = __builtin_amdgcn_mfma_f32_16x16x32_bf16(ak, bk, akk, 0, 0, 0); aqk = __builtin_amdgcn_mfma_f32_16x16x32_bf16(aq, bk, aqk, 0, 0, 0);
                }
            }
            const int j = 16 * nt + l15; const float gj = gc[j];
#pragma unroll
            for (int r = 0; r < 4; ++r) { const int i = 16 * mt + 4 * q4 + r; const float dec = (j <= i) ? __expf(gc[i] - gj) : 0.f;
                A[i * 68 + j] = (j < i) ? bt[i] * akk[r] * dec : 0.f;
                QKg[i * 64 + j] = (bf16)f2bf(aqk[r] * dec); }
        }
    }
    __syncthreads();
    if (tid < 256) {
        const int c = tid;
        for (int i = 1; i < 64; ++i) {
            float a0 = R[i * 256 + c], a1 = 0.f;
            const int nj = (i + 3) >> 2;
            for (int j4 = 0; j4 < nj; ++j4) { const f32x4 a = *(const LAS f32x4*)(A + i * 68 + 4 * j4); const LAS float* rp = R + (4 * j4) * 256 + c;
                a0 -= a.x * rp[0]; a1 -= a.y * rp[256]; a0 -= a.z * rp[512]; a1 -= a.w * rp[768]; }
            R[i * 256 + c] = a0 + a1;
        }
    }
    __syncthreads();
    {
        const int i = tid >> 3, sub = tid & 7;
#pragma unroll
        for (int half = 0; half < 2; ++half) {
            const LAS float* rp = R + i * 256 + half * 128 + sub * 16; bf16* dst = (half ? Wg : Ug) + i * 128 + sub * 16;
            v4u a, bq; a.x = pk2(rp[0], rp[1]); a.y = pk2(rp[2], rp[3]); a.z = pk2(rp[4], rp[5]); a.w = pk2(rp[6], rp[7]); bq.x = pk2(rp[8], rp[9]); bq.y = pk2(rp[10], rp[11]); bq.z = pk2(rp[12], rp[13]); bq.w = pk2(rp[14], rp[15]);
            *(v4u*)dst = a; *(v4u*)(dst + 8) = bq;
        }
    }
    __syncthreads();
}

constexpr int SC_W = 0, SC_QD = 17408, SC_U = 34816, SC_KDT = 52224, SC_QK = 70656, SC_O = 79872;
static_assert(SC_O + 64 * 132 * 4 <= RING_BYTES, "scan LDS");
__device__ __forceinline__ bf16x8 pack8(const f32x4& a, const f32x4& b) {
    v4u w; w.x = pg8::cvt_pk_bf16(a[0], a[1]); w.y = pg8::cvt_pk_bf16(a[2], a[3]); w.z = pg8::cvt_pk_bf16(b[0], b[1]); w.w = pg8::cvt_pk_bf16(b[2], b[3]); return __builtin_bit_cast(bf16x8, w);
}
typedef unsigned v2u __attribute__((ext_vector_type(2)));
__device__ __forceinline__ bf16x8 afrag(const LAS bf16* rowp, int kbase, int q4) {
    const v2u lo = *(const LAS v2u*)(rowp + kbase + 4 * q4), hi = *(const LAS v2u*)(rowp + kbase + 16 + 4 * q4);
    v4u w; w.x = lo.x; w.y = lo.y; w.z = hi.x; w.w = hi.y; return __builtin_bit_cast(bf16x8, w);
}
__device__ __forceinline__ void gdn_scan_chain(LAS unsigned char* lds, int bh, const unsigned char* gdnbuf, const float* GLb, const bf16* GZ, const float* gnorm, bf16* MIX, float* out, int tid) {
    const int lane = tid & 63, wave = __builtin_amdgcn_readfirstlane(tid >> 6), q4 = lane >> 4, l15 = lane & 15;
    const int b = bh >> 2, h = bh & 3;
    LAS bf16* Wl = (LAS bf16*)(lds + SC_W); LAS bf16* QDl = (LAS bf16*)(lds + SC_QD); LAS bf16* Ul = (LAS bf16*)(lds + SC_U); LAS bf16* KDTl = (LAS bf16*)(lds + SC_KDT); LAS bf16* QKl = (LAS bf16*)(lds + SC_QK);
    LAS float* Ol = (LAS float*)(lds + SC_O);
    f32x4 S[8];
#pragma unroll
    for (int tt = 0; tt < 8; ++tt) S[tt] = (f32x4){0.f, 0.f, 0.f, 0.f};
    v4u rg[9];
#define SC_LOAD(nn) do { const unsigned char* cb_ = gdnbuf + (size_t)(bh * NCHUNK + (nn)) * GDN_CH_BYTES; \
        _Pragma("unroll") for (int k_ = 0; k_ < 9; ++k_) rg[k_] = *(const v4u*)(cb_ + (size_t)(k_ * NTHR + tid) * 16); } while (0)
    SC_LOAD(0);
#pragma unroll 1
    for (int n = 0; n < NCHUNK; ++n) {
        __syncthreads();
#pragma unroll
        for (int k = 0; k < 9; ++k) {
            const int p = k * NTHR + tid;
            if (k < 6) { const int pp = p & 1023, row = pp >> 4, c16 = pp & 15; LAS bf16* base = (k < 2) ? Ul : (k < 4) ? Wl : QDl; *(LAS v4u*)(base + row * 136 + c16 * 8) = rg[k]; }
            else if (k < 8) { const int pp = p - 3072, row = pp >> 3, c16 = pp & 7; *(LAS v4u*)(KDTl + row * 72 + c16 * 8) = rg[k]; }
            else { const int pp = p - 4096, row = pp >> 3, c16 = pp & 7; *(LAS v4u*)(QKl + row * 72 + c16 * 8) = rg[k]; }
        }
        const float gl = GLb[bh * NCHUNK + n];
        __syncthreads();
        if (n + 1 < NCHUNK) SC_LOAD(n + 1);
        bf16x8 Sb[4];
#pragma unroll
        for (int ks = 0; ks < 4; ++ks) Sb[ks] = pack8(S[2 * ks], S[2 * ks + 1]);
        f32x4 vn[4], oo[4];
#pragma unroll
        for (int mt = 0; mt < 4; ++mt) {
            f32x4 acc = (f32x4){0.f, 0.f, 0.f, 0.f}, ao = (f32x4){0.f, 0.f, 0.f, 0.f};
#pragma unroll
            for (int ks = 0; ks < 4; ++ks) {
                acc = __builtin_amdgcn_mfma_f32_16x16x32_bf16(afrag(Wl + (16 * mt + l15) * 136, 32 * ks, q4), Sb[ks], acc, 0, 0, 0);
                ao = __builtin_amdgcn_mfma_f32_16x16x32_bf16(afrag(QDl + (16 * mt + l15) * 136, 32 * ks, q4), Sb[ks], ao, 0, 0, 0);
            }
#pragma unroll
            for (int r = 0; r < 4; ++r) vn[mt][r] = bf2f(Ul[(16 * mt + 4 * q4 + r) * 136 + 16 * wave + l15]) - acc[r];
            oo[mt] = ao;
        }
        bf16x8 Vb[2];
        Vb[0] = pack8(vn[0], vn[1]); Vb[1] = pack8(vn[2], vn[3]);
#pragma unroll
        for (int mt = 0; mt < 4; ++mt) {
#pragma unroll
            for (int k2 = 0; k2 < 2; ++k2) oo[mt] = __builtin_amdgcn_mfma_f32_16x16x32_bf16(afrag(QKl + (16 * mt + l15) * 72, 32 * k2, q4), Vb[k2], oo[mt], 0, 0, 0);
#pragma unroll
            for (int r = 0; r < 4; ++r) Ol[(16 * mt + 4 * q4 + r) * 132 + 16 * wave + l15] = oo[mt][r];
        }
#pragma unroll
        for (int tt = 0; tt < 8; ++tt) {
            f32x4 acc = S[tt] * gl;
#pragma unroll
            for (int k2 = 0; k2 < 2; ++k2) acc = __builtin_amdgcn_mfma_f32_16x16x32_bf16(afrag(KDTl + (16 * tt + l15) * 72, 32 * k2, q4), Vb[k2], acc, 0, 0, 0);
            S[tt] = acc;
        }
        __syncthreads();
        {
            const int i = tid >> 3, sub = tid & 7; const size_t m = (size_t)b * SEQ + n * 64 + i;
            const LAS float* op = Ol + i * 132 + sub * 16; float y[16]; float ss = 0.f;
#pragma unroll
            for (int c = 0; c < 16; ++c) { y[c] = op[c]; ss += y[c] * y[c]; }
            ss += __shfl_xor(ss, 1); ss += __shfl_xor(ss, 2); ss += __shfl_xor(ss, 4);
            const float rs = rsqrtf(ss * (1.f / GD) + EPS);
            const v4u z0 = *(const v4u*)(GZ + m * GW + h * GD + sub * 16), z1 = *(const v4u*)(GZ + m * GW + h * GD + sub * 16 + 8);
            const unsigned zz[8] = {z0.x, z0.y, z0.z, z0.w, z1.x, z1.y, z1.z, z1.w};
            float r[16];
#pragma unroll
            for (int c = 0; c < 8; ++c) { r[2 * c] = y[2 * c] * rs * gnorm[sub * 16 + 2 * c] * siluf_(bflo(zz[c])); r[2 * c + 1] = y[2 * c + 1] * rs * gnorm[sub * 16 + 2 * c + 1] * siluf_(bfhi(zz[c])); }
            v4u a, bq; a.x = pk2(r[0], r[1]); a.y = pk2(r[2], r[3]); a.z = pk2(r[4], r[5]); a.w = pk2(r[6], r[7]); bq.x = pk2(r[8], r[9]); bq.y = pk2(r[10], r[11]); bq.z = pk2(r[12], r[13]); bq.w = pk2(r[14], r[15]);
            bf16* dst = MIX + m * DMODEL + FW + h * GD + sub * 16; *(v4u*)dst = a; *(v4u*)(dst + 8) = bq;
        }
    }
#undef SC_LOAD
    float* so = out + OUT_GSP + (size_t)bh * GD * GD;
#pragma unroll
    for (int tt = 0; tt < 8; ++tt)
#pragma unroll
        for (int r = 0; r < 4; ++r) so[(size_t)(16 * tt + 4 * q4 + r) * GD + 16 * wave + l15] = S[tt][r];
    __syncthreads();
}

__device__ __forceinline__ void gdn_sample_unit(LAS unsigned char* lds, int u, const float* state, const float* ctx, const float* wconv, const float* GATE, const bf16* GZ, const float* gnorm, bf16* MIX, float* out, int tid) {
    const int lane = tid & 63, wave = tid >> 6;
    const int b = u >> 2, h = u & 3; const size_t m = MP + b;
    LAS float* qkv = (LAS float*)lds;
    LAS float* red = qkv + 384;
    LAS float* part = qkv + 512;
    LAS float* ov = part + 1024;
    if (tid < 384) {
        const int sec = tid >> 7, c = tid & 127, col = sec * GW + h * GD + c;
        float y = 0.f;
#pragma unroll
        for (int tap = 0; tap < 3; ++tap) y += wconv[tap * NGQKV + col] * ctx[(size_t)(b * 3 + tap) * NGQKV + col];
        y += wconv[3 * NGQKV + col] * out[OUT_GCS + (size_t)(b * 3 + 2) * NGQKV + col];
        qkv[tid] = siluf_(y);
    }
    __syncthreads();
    if (wave < 2) { const float a = qkv[wave * 128 + lane], c2 = qkv[wave * 128 + 64 + lane]; const float ss = wave_sum(a * a + c2 * c2); if (lane == 0) red[wave] = rsqrtf(ss + EPS) * (wave == 0 ? QSCALE : 1.f); }
    __syncthreads();
    if (tid < 256) qkv[tid] *= red[tid >> 7];
    __syncthreads();
    if (wave == 0) { const float a = qkv[lane] * qkv[128 + lane] + qkv[64 + lane] * qkv[192 + lane]; const float s = wave_sum(a); if (lane == 0) red[2] = s; }
    const float g = GATE[m * 16 + 8 + h], beta = GATE[m * 16 + 12 + h], eg = __expf(g);
    const int c = tid & 127, part_i = tid >> 7;
    const float* sp = state + ((size_t)(b * GH + h) * GD + part_i * 32) * GD + c;
    float sv[32]; float pk = 0.f, pq = 0.f;
#pragma unroll
    for (int d = 0; d < 32; ++d) { sv[d] = sp[(size_t)d * GD]; pk += qkv[128 + part_i * 32 + d] * sv[d]; pq += qkv[part_i * 32 + d] * sv[d]; }
    part[part_i * 128 + c] = pk; part[512 + part_i * 128 + c] = pq;
    __syncthreads();
    const float kS = (part[c] + part[128 + c]) + (part[256 + c] + part[384 + c]), qS = (part[512 + c] + part[640 + c]) + (part[768 + c] + part[896 + c]);
    const float vnew = beta * (qkv[256 + c] - eg * kS), o = eg * qS + red[2] * vnew;
    float* so = out + OUT_GSS + ((size_t)(b * GH + h) * GD + part_i * 32) * GD + c;
#pragma unroll
    for (int d = 0; d < 32; ++d) so[(size_t)d * GD] = sv[d] * eg + qkv[128 + part_i * 32 + d] * vnew;
    if (part_i == 0) ov[c] = o;
    __syncthreads();
    if (wave == 0) { const float a = ov[lane], c2 = ov[64 + lane]; const float ss = wave_sum(a * a + c2 * c2); if (lane == 0) red[3] = rsqrtf(ss * (1.f / GD) + EPS); }
    __syncthreads();
    if (tid < 128) { const float z = bf2f(GZ[m * GW + h * GD + tid]); MIX[m * DMODEL + FW + h * GD + tid] = (bf16)f2bf(ov[tid] * red[3] * gnorm[tid] * siluf_(z)); }
    __syncthreads();
}

__device__ __forceinline__ void decode_unit(LAS unsigned char* lds, int u, const float* cache_k, const float* cache_v, const float* cache_lf, const int* page_table, const float* PT, const bf16* QB, float* DPART, int tid) {
    const int lane = tid & 63, wave = tid >> 6, b = u >> 4, p = u & 15;
    const int page = page_table[b * NPAGES + p];
    const float* Kp = cache_k + (size_t)page * (PAGE * FW); const float* Vp = cache_v + (size_t)page * (PAGE * FW); const float* LFp = cache_lf + (size_t)page * (PAGE * FH);
    LAS float* lfL = (LAS float*)lds;
    LAS float* cumL = lfL + 1024;
    LAS float* mL = cumL + 1024;
    LAS float* lL = mL + 64;
    LAS float* accL = lL + 64;
    lfL[tid] = LFp[tid]; lfL[tid + 512] = LFp[tid + 512];
    __syncthreads();
    if (wave == 0) {
        const int hh = lane & 7, seg = lane >> 3;
        float off = 0.f;
        for (int pp = 0; pp < p; ++pp) off += PT[(b * NPAGES + pp) * FH + hh];
        float run = 0.f; float loc[16];
#pragma unroll
        for (int i = 0; i < 16; ++i) { run += lfL[(seg * 16 + i) * 8 + hh]; loc[i] = run; }
        float incl = run;
#pragma unroll
        for (int o = 8; o < 64; o <<= 1) { const float y = __shfl_up(incl, o); if (lane >= o) incl += y; }
        const float base = off + incl - run;
#pragma unroll
        for (int i = 0; i < 16; ++i) cumL[(seg * 16 + i) * 8 + hh] = (base + loc[i]) * LOG2E;
    }
    __syncthreads();
    const int hh = lane >> 3, sub = lane & 7;
    float qf[8];
    { const v4u qq = *(const v4u*)(QB + (size_t)(MP + b) * FW + hh * FD + sub * 8);
      qf[0] = bflo(qq.x); qf[1] = bfhi(qq.x); qf[2] = bflo(qq.y); qf[3] = bfhi(qq.y); qf[4] = bflo(qq.z); qf[5] = bfhi(qq.z); qf[6] = bflo(qq.w); qf[7] = bfhi(qq.w); }
    float sc[16];
#pragma unroll
    for (int half = 0; half < 2; ++half) {
        f32x4 k0[8], k1[8];
#pragma unroll
        for (int i = 0; i < 8; ++i) { const float* kp = Kp + (size_t)(wave * 16 + half * 8 + i) * FW + lane * 8; k0[i] = __builtin_nontemporal_load((const f32x4*)kp); k1[i] = __builtin_nontemporal_load((const f32x4*)(kp + 4)); }
#pragma unroll
        for (int i = 0; i < 8; ++i) {
            float d = qf[0] * k0[i].x + qf[1] * k0[i].y + qf[2] * k0[i].z + qf[3] * k0[i].w + qf[4] * k1[i].x + qf[5] * k1[i].y + qf[6] * k1[i].z + qf[7] * k1[i].w;
            d += __shfl_xor(d, 1); d += __shfl_xor(d, 2); d += __shfl_xor(d, 4);
            sc[half * 8 + i] = d - cumL[(wave * 16 + half * 8 + i) * 8 + hh];
        }
    }
    float mw = sc[0];
#pragma unroll
    for (int i = 1; i < 16; ++i) mw = fmaxf(mw, sc[i]);
    float lw = 0.f;
#pragma unroll
    for (int i = 0; i < 16; ++i) { sc[i] = exp2f(sc[i] - mw); lw += sc[i]; }
    float acc[8];
#pragma unroll
    for (int j = 0; j < 8; ++j) acc[j] = 0.f;
#pragma unroll
    for (int half = 0; half < 2; ++half) {
        f32x4 v0[8], v1[8];
#pragma unroll
        for (int i = 0; i < 8; ++i) { const float* vp = Vp + (size_t)(wave * 16 + half * 8 + i) * FW + lane * 8; v0[i] = __builtin_nontemporal_load((const f32x4*)vp); v1[i] = __builtin_nontemporal_load((const f32x4*)(vp + 4)); }
#pragma unroll
        for (int i = 0; i < 8; ++i) { const float pp = sc[half * 8 + i];
            acc[0] += pp * v0[i].x; acc[1] += pp * v0[i].y; acc[2] += pp * v0[i].z; acc[3] += pp * v0[i].w; acc[4] += pp * v1[i].x; acc[5] += pp * v1[i].y; acc[6] += pp * v1[i].z; acc[7] += pp * v1[i].w; }
    }
    if (sub == 0) { mL[wave * 8 + hh] = mw; lL[wave * 8 + hh] = lw; }
    *(LAS f32x4*)(accL + wave * 512 + lane * 8) = (f32x4){acc[0], acc[1], acc[2], acc[3]}; *(LAS f32x4*)(accL + wave * 512 + lane * 8 + 4) = (f32x4){acc[4], acc[5], acc[6], acc[7]};
    __syncthreads();
    {
        const int h2 = tid >> 6, d = tid & 63;
        float M = mL[h2];
#pragma unroll
        for (int w = 1; w < 8; ++w) M = fmaxf(M, mL[w * 8 + h2]);
        float L = 0.f, O = 0.f;
#pragma unroll
        for (int w = 0; w < 8; ++w) { const float f = exp2f(mL[w * 8 + h2] - M); L += lL[w * 8 + h2] * f; O += accL[w * 512 + h2 * 64 + d] * f; }
        float* dp = DPART + (size_t)(u * FH + h2) * 66;
        dp[2 + d] = O; if (d == 0) { dp[0] = M; dp[1] = L; }
    }
    __syncthreads();
}
__device__ __forceinline__ void decode_combine(int b, const float* DPART, const float* PT, const float* GATE, const bf16* QB, const float* out, bf16* MIX, int tid) {
    const int h = tid >> 6, d = tid & 63; const size_t m = MP + b;
    float cum = GATE[m * 16 + h];
    for (int p = 0; p < NPAGES; ++p) cum += PT[(b * NPAGES + p) * FH + h];
    const float q = bf2f(QB[m * FW + h * FD + d]), kn = out[OUT_KS + (size_t)b * FW + h * FD + d], vnw = out[OUT_VS + (size_t)b * FW + h * FD + d];
    const float sn = wave_sum(q * kn) - cum * LOG2E;
    float M = sn;
    for (int p = 0; p < NPAGES; ++p) M = fmaxf(M, DPART[(size_t)((b * NPAGES + p) * FH + h) * 66]);
    const float fn = exp2f(sn - M); float L = fn, O = fn * vnw;
    for (int p = 0; p < NPAGES; ++p) { const float* dp = DPART + (size_t)((b * NPAGES + p) * FH + h) * 66; const float f = exp2f(dp[0] - M); L += dp[1] * f; O += dp[2 + d] * f; }
    MIX[m * DMODEL + h * FD + d] = (bf16)f2bf(O / L);
}

__global__ void __launch_bounds__(NTHR, 2) fwd(Args args) {
    extern __shared__ __attribute__((aligned(16))) unsigned char lds_raw[];
    LAS unsigned char* lds = (LAS unsigned char*)lds_raw;
    volatile LAS unsigned* MISC = (volatile LAS unsigned*)(lds + MISC_OFF);
    const int tid = threadIdx.x, lane = tid & 63, wave = __builtin_amdgcn_readfirstlane(tid >> 6);
    const int G = gridDim.x; const int bx = blockIdx.x; const int vcu = (G % 8 == 0) ? (bx % 8) * (G / 8) + bx / 8 : bx;
    unsigned char* ws = args.ws; float* out = args.out;
    gu32* ctl = (gu32*)(ws + WS_CTL);
    const float* x_prompt = args.in[0]; const float* x_sample = args.in[1]; const float* cache_k = args.in[2]; const float* cache_v = args.in[3]; const float* cache_lf = args.in[4];
    const float* state_gdn = args.in[5]; const float* state_gconv = args.in[6]; const float* state_fconv = args.in[7]; const int* page_table = (const int*)args.in[8];
    const float* norm_mix = args.in[9]; const float* w_in = args.in[10]; const float* b_forget = args.in[11]; const float* a_log = args.in[12]; const float* dt_bias = args.in[13];
    const float* w_gconv = args.in[14]; const float* gnorm = args.in[15]; const float* w_out = args.in[16]; const float* norm_ffn = args.in[17]; const float* w_up = args.in[18];
    const float* w_fconv = args.in[19]; const float* b_fconv = args.in[20]; const float* w_down = args.in[21]; const float* norm_final = args.in[22];
    bf16* WinT = (bf16*)(ws + WS_WIN); bf16* WoutT = (bf16*)(ws + WS_WOUT); bf16* WupT = (bf16*)(ws + WS_WUP); bf16* WdnT = (bf16*)(ws + WS_WDN);
    float* GATE = (float*)(ws + WS_GATE); float* PT = (float*)(ws + WS_PT); float* DPART = (float*)(ws + WS_DPART);
    bf16* XN = (bf16*)(ws + WS_XN); bf16* QB = (bf16*)(ws + WS_QB); bf16* KB = (bf16*)(ws + WS_KB); bf16* VB = (bf16*)(ws + WS_VB); bf16* GQKV = (bf16*)(ws + WS_GQKV); bf16* GZ = (bf16*)(ws + WS_GZ);
    bf16* MIX = (bf16*)(ws + WS_MIX); float* X1 = (float*)(ws + WS_X1); bf16* GU = (bf16*)(ws + WS_GU); bf16* ACT = (bf16*)(ws + WS_ACT); float* X2 = (float*)(ws + WS_X2);
    unsigned char* gdnbuf = ws + WS_GDN; float* GLb = (float*)(ws + WS_GL);

    for (int u = tid; u < (LDS_BYTES - LDSCTL_OFF) / 4; u += NTHR) ((LAS unsigned*)(lds + LDSCTL_OFF))[u] = 0u;
    __syncthreads();
    const int lo = args.ph_lo, hi = args.ph_hi;
    const bool one_launch = (hi - lo) > 1;
    XcdBarrier bar; bar.bar = (unsigned*)(ctl + CW_BAR); bar.x = 0; bar.st = nullptr;
    if (one_launch) bar = xcd_barrier_post((unsigned*)(ctl + CW_BAR), MISC + 8);
#ifdef ONLY_PH
#define IN(k) ((k) == ONLY_PH && lo <= (k) && (k) < hi)
#else
#define IN(k) (lo <= (k) && (k) < hi)
#endif
#define SEAM(k) do { if (IN(k) && IN((k) + 1)) xcd_barrier(bar); } while (0)
    const int gw = vcu * NWAVES + wave, NGW = G * NWAVES;

    if (IN(0)) {
        LAS float* scr = (LAS float*)(lds + RING_OFF + wave * 16384);
        constexpr int I_IN = 16 * (NIN / 32), I_OUT = 16 * 32, I_UP = 16 * (NUP / 32), I_DN = (FFN / 64) * 32, NITEMS = I_IN + I_OUT + I_UP + I_DN;
        for (int it = gw; it < NITEMS; it += NGW) {
            int r = it;
            if (r < I_IN) { transpose_item(w_in, DMODEL, 3600, WinT, scr, r / (NIN / 32), r % (NIN / 32), lane, SMapIn()); continue; } r -= I_IN;
            if (r < I_OUT) { transpose_item(w_out, DMODEL, DMODEL, WoutT, scr, r / 32, r % 32, lane, SMapId()); continue; } r -= I_OUT;
            if (r < I_UP) { transpose_item(w_up, DMODEL, NUP, WupT, scr, r / (NUP / 32), r % (NUP / 32), lane, SMapId()); continue; } r -= I_UP;
            transpose_item(w_down, FFN, DMODEL, WdnT, scr, r / 32, r % 32, lane, SMapId());
        }
        for (int m = gw; m < MPAD; m += NGW) {
            if (m < MT) rms_row_to_bf16(m < MP ? x_prompt + (size_t)m * DMODEL : x_sample + (size_t)(m - MP) * DMODEL, norm_mix, XN + (size_t)m * DMODEL, lane);
            else { unsigned long long* o8 = (unsigned long long*)(XN + (size_t)m * DMODEL) + lane;
#pragma unroll
                for (int j = 0; j < 4; ++j) o8[64 * j] = 0ull; }
        }
        { const int gt = vcu * NTHR + tid, NGT = G * NTHR;
          for (int e = gt; e < DB * 2 * NGQKV / 4; e += NGT) { const int bb = e / (2 * NGQKV / 4), r = e % (2 * NGQKV / 4);
              *((f32x4*)(out + OUT_GCS + (size_t)bb * 3 * NGQKV) + r) = *((const f32x4*)(state_gconv + (size_t)bb * 3 * NGQKV + NGQKV) + r); }
          for (int e = gt; e < DB * FFN / 4; e += NGT) { const int bb = e / (FFN / 4), r = e % (FFN / 4);
              *((f32x4*)(out + OUT_FCS + (size_t)bb * 2 * FFN) + r) = *((const f32x4*)(state_fconv + (size_t)bb * 2 * FFN + FFN) + r); } }
        for (int it = gw; it < DB * NPAGES; it += NGW) {
            const float* lp = cache_lf + (size_t)page_table[it] * (PAGE * FH);
            f32x4 s = (f32x4){0.f, 0.f, 0.f, 0.f};
#pragma unroll
            for (int j = 0; j < 4; ++j) s += *((const f32x4*)lp + lane + 64 * j);
#pragma unroll
            for (int o = 2; o < 64; o <<= 1) { s.x += __shfl_xor(s.x, o); s.y += __shfl_xor(s.y, o); s.z += __shfl_xor(s.z, o); s.w += __shfl_xor(s.w, o); }
            if (lane < 2) *((f32x4*)(PT + (size_t)it * FH) + lane) = s;
        }
        __syncthreads();
    }
    SEAM(0);
    if (IN(1)) {
        pg8::Gemm g{XN, WinT, MPAD, NIN, DMODEL}; pg8::StaticOrder S; S.init(MPAD, NIN, G, bx);
        EpiInProj E{QB, KB, VB, GQKV, GZ, GATE, out, b_forget, a_log, dt_bias};
        pg8::gemm_phase<EpiInProj, pg8::StaticOrder, true, true>(lds + RING_OFF, g, S, E);
    }
    SEAM(1);
    if (IN(2)) {
        LAS v4u* biasF = (LAS v4u*)(lds + BIAS_OFF); LAS float* wtot = (LAS float*)(lds + WTOT_OFF);
        for (int pu = vcu; pu < 256; pu += G) {
            const int bh = pu >> 2, s = pu & 3, b = bh >> 3, h = bh & 7;
#pragma unroll 1
            for (int i = 0; i < 2; ++i) {
                const int qb = i == 0 ? s : 7 - s;
                int tl = tid; asm volatile("" : "+v"(tl));
                fox_bias_build(GATE, b, h, (qb + 1) * 256, biasF, wtot, tl);
                attn_body::attn_unit<8>(b, h, qb, (const attn_body::bf16*)QB, (const attn_body::bf16*)KB, (const attn_body::bf16*)VB, (attn_body::bf16*)MIX, (char*)lds_raw + RING_OFF, (const LAS char*)biasF);
            }
        }
        __syncthreads();
        for (int ci = vcu; ci < NCH_TOT; ci += G) gdn_prep_unit(lds + RING_OFF, ci, GQKV, GATE, w_gconv, gdnbuf, GLb, tid);
        for (int u = vcu; u < DB * NPAGES; u += G) decode_unit(lds + RING_OFF, u, cache_k, cache_v, cache_lf, page_table, PT, QB, DPART, tid);
        for (int u = vcu; u < DB * GH; u += G) gdn_sample_unit(lds + RING_OFF, u, state_gdn, state_gconv, w_gconv, GATE, GZ, gnorm, MIX, out, tid);
    }
    SEAM(2);
    if (IN(3)) {
        for (int u = vcu; u < NB * GH + DB; u += G) {
            if (u < NB * GH) gdn_scan_chain(lds + RING_OFF, u, gdnbuf, GLb, GZ, gnorm, MIX, out, tid);
            else decode_combine(u - NB * GH, DPART, PT, GATE, QB, out, MIX, tid);
        }
        __syncthreads();
    }
    SEAM(3);
    if (IN(4)) {
        pg8::Gemm g{MIX, WoutT, MPAD, DMODEL, DMODEL}; pg8::StaticOrder S; S.init(MPAD, DMODEL, G, bx);
        EpiResid E{x_prompt, x_sample, X1};
        pg8::gemm_phase<EpiResid, pg8::StaticOrder, true, true>(lds + RING_OFF, g, S, E);
    }
    SEAM(4);
    if (IN(5)) {
        for (int m = gw; m < MT; m += NGW) rms_row_to_bf16(X1 + (size_t)m * DMODEL, norm_ffn, XN + (size_t)m * DMODEL, lane);
    }
    SEAM(5);
    if (IN(6)) {
        pg8::Gemm g{XN, WupT, MPAD, NUP, DMODEL}; pg8::StaticOrder S; S.init(MPAD, NUP, G, bx);
        EpiUp E{GU, out};
        pg8::gemm_phase<EpiUp, pg8::StaticOrder, true, true>(lds + RING_OFF, g, S, E);
    }
    SEAM(6);
    if (IN(7)) {
        for (int m = gw; m < MPAD; m += NGW) {
            bf16* arow = ACT + (size_t)m * FFN;
            if (m >= MT) { for (int c8 = lane; c8 < FFN / 8; c8 += 64) *(v4u*)(arow + c8 * 8) = (v4u){0u, 0u, 0u, 0u}; continue; }
            const int t = m < MP ? (m & (SEQ - 1)) : 2;
            for (int c8 = lane; c8 < FFN / 8; c8 += 64) {
                const int c = c8 * 8;
                float gm2[8], gm1[8], g0[8], up[8];
                { const v4u a = *(const v4u*)(GU + (size_t)m * NUP + c), ub = *(const v4u*)(GU + (size_t)m * NUP + FFN + c);
                  g0[0] = bflo(a.x); g0[1] = bfhi(a.x); g0[2] = bflo(a.y); g0[3] = bfhi(a.y); g0[4] = bflo(a.z); g0[5] = bfhi(a.z); g0[6] = bflo(a.w); g0[7] = bfhi(a.w);
                  up[0] = bflo(ub.x); up[1] = bfhi(ub.x); up[2] = bflo(ub.y); up[3] = bfhi(ub.y); up[4] = bflo(ub.z); up[5] = bfhi(ub.z); up[6] = bflo(ub.w); up[7] = bfhi(ub.w); }
                if (m < MP) {
                    if (t >= 1) { const v4u a = *(const v4u*)(GU + (size_t)(m - 1) * NUP + c); gm1[0] = bflo(a.x); gm1[1] = bfhi(a.x); gm1[2] = bflo(a.y); gm1[3] = bfhi(a.y); gm1[4] = bflo(a.z); gm1[5] = bfhi(a.z); gm1[6] = bflo(a.w); gm1[7] = bfhi(a.w); }
                    else {
#pragma unroll
                        for (int j = 0; j < 8; ++j) gm1[j] = 0.f; }
                    if (t >= 2) { const v4u a = *(const v4u*)(GU + (size_t)(m - 2) * NUP + c); gm2[0] = bflo(a.x); gm2[1] = bfhi(a.x); gm2[2] = bflo(a.y); gm2[3] = bfhi(a.y); gm2[4] = bflo(a.z); gm2[5] = bfhi(a.z); gm2[6] = bflo(a.w); gm2[7] = bfhi(a.w); }
                    else {
#pragma unroll
                        for (int j = 0; j < 8; ++j) gm2[j] = 0.f; }
                } else {
                    const float* cx = state_fconv + (size_t)(m - MP) * 2 * FFN + c;
#pragma unroll
                    for (int j = 0; j < 8; ++j) { gm2[j] = cx[j]; gm1[j] = cx[FFN + j]; }
                }
                float r[8];
#pragma unroll
                for (int j = 0; j < 8; ++j) { const float y = w_fconv[c + j] * gm2[j] + w_fconv[FFN + c + j] * gm1[j] + w_fconv[2 * FFN + c + j] * g0[j] + b_fconv[c + j]; r[j] = siluf_(y) * up[j]; }
                v4u o; o.x = pk2(r[0], r[1]); o.y = pk2(r[2], r[3]); o.z = pk2(r[4], r[5]); o.w = pk2(r[6], r[7]);
                *(v4u*)(arow + c) = o;
            }
        }
    }
    SEAM(7);
    if (IN(8)) {
        pg8::Gemm g{ACT, WdnT, MPAD, DMODEL, FFN}; pg8::StaticOrder S; S.init(MPAD, DMODEL, G, bx);
        EpiResid2 E{X1, X2};
        pg8::gemm_phase<EpiResid2, pg8::StaticOrder, true, true>(lds + RING_OFF, g, S, E);
    }
    SEAM(8);
    if (IN(9)) {
        for (int m = gw; m < MT; m += NGW) rms_row_to_f32(X2 + (size_t)m * DMODEL, norm_final, out + (m < MP ? OUT_YP + (size_t)m * DMODEL : OUT_YS + (size_t)(m - MP) * DMODEL), lane);
    }
#undef IN
#undef SEAM
}

#ifndef MK_ONE_LAUNCH
#define MK_ONE_LAUNCH 0
#endif
extern "C" void kernel_launch(void* const* d_in, const int* in_sizes, int n_in, void* d_out, int out_size, void* d_ws, size_t ws_size, hipStream_t stream) {
    static int grid = 0;
    if (grid == 0) {
        if (n_in != 23 || out_size != (int)OUT_END || ws_size < WS_END) { fprintf(stderr, "kernel_launch: unexpected sizes n_in %d out %d ws %zu\n", n_in, out_size, ws_size); grid = -1; return; }
        int dev = 0, cus = 0, per_cu = 0;
        if (hipGetDevice(&dev) != hipSuccess || hipDeviceGetAttribute(&cus, hipDeviceAttributeMultiprocessorCount, dev) != hipSuccess) { grid = -1; return; }
        if (hipFuncSetAttribute((const void*)fwd, hipFuncAttributeMaxDynamicSharedMemorySize, LDS_BYTES) != hipSuccess) { fprintf(stderr, "kernel_launch: hipFuncSetAttribute failed\n"); grid = -1; return; }
        if (hipOccupancyMaxActiveBlocksPerMultiprocessor(&per_cu, (const void*)fwd, NTHR, LDS_BYTES) != hipSuccess || per_cu < 1) { fprintf(stderr, "kernel_launch: occupancy query says %d\n", per_cu); }
        (void)hipGetLastError();
        grid = cus;
    }
    if (grid < 0) return;
    (void)hipMemsetAsync((char*)d_ws + WS_CTL, 0, CTL_ZERO_BYTES, stream);
    Args a{};
    for (int i = 0; i < 23; ++i) a.in[i] = (const float*)d_in[i];
    a.out = (float*)d_out; a.ws = (unsigned char*)d_ws;
#if MK_ONE_LAUNCH
    a.ph_lo = 0; a.ph_hi = NPH;
    hipLaunchKernelGGL(fwd, dim3(grid), dim3(NTHR), LDS_BYTES, stream, a);
#else
    for (int ph = 0; ph < NPH; ++ph) { a.ph_lo = ph; a.ph_hi = ph + 1; hipLaunchKernelGGL(fwd, dim3(grid), dim3(NTHR), LDS_BYTES, stream, a); }
#endif
}
```

```cpp
#include <hip/hip_runtime.h>
#include <cstdio>
#include <cstdint>
namespace pg8 {
#define PG8_LAS __attribute__((address_space(3)))
typedef unsigned short bf16_t;
typedef short bf16x8 __attribute__((ext_vector_type(8)));
typedef float f32x4 __attribute__((ext_vector_type(4)));
typedef unsigned u32x4 __attribute__((ext_vector_type(4)));
constexpr int BM = 256, BK = 64, HALF = 128, HTB = HALF * BK * 2  , STAGE_BYTES = 8 * HTB, NXCD = 8, WGM = 8;

__host__ __device__ __forceinline__ int lds_byte(int r, int c) { const int st = (r >> 4) * 2 + (c >> 5), rr = r & 15, cc = c & 31, ob = rr * 64 + cc * 2; return st * 1024 + (ob ^ (((ob >> 9) & 1) << 5)); }
__host__ __device__ __forceinline__ void stage_rc(int b, int& R, int& C) { const int st = b / 1024, sb = b % 1024, swz = sb ^ (((sb >> 9) & 1) << 5); R = (st >> 1) * 16 + swz / 64; C = (st & 1) * 32 + (swz % 64) / 2; }
__host__ __device__ __forceinline__ int perm32(int rho) { const int n = rho >> 4, i = rho & 15; return 8 * (i >> 2) + 4 * n + (i & 3); }

struct Unit { int pm, pn; };
struct Gemm { const bf16_t* A; const bf16_t* Bt; int M, N, K; };

struct StaticOrder {
    int nM, nN, nwg, G, c;
    __host__ __device__ __forceinline__ void init(int M, int N, int G_, int c_) { nM = M / BM; nN = N / BM; nwg = nM * nN; G = G_; c = c_; }
    __host__ __device__ __forceinline__ bool next(int i, Unit& u) const {
        const long L = (long)i * G + c; if (L >= nwg) return false;
        int wgid = (int)L; { const int q = nwg / NXCD, r = nwg % NXCD, xcd = wgid % NXCD, off = wgid / NXCD; wgid = (xcd < r ? xcd * (q + 1) : r * (q + 1) + (xcd - r) * q) + off; }
        const int nig = WGM * nN, gid = wgid / nig, fm = gid * WGM, gsz = (nM - fm) < WGM ? (nM - fm) : WGM;
        u.pm = fm + ((wgid % nig) % gsz); u.pn = (wgid % nig) / gsz; return true;
    }
    __device__ __forceinline__ void a_ready(const Unit&) const {}
    __device__ __forceinline__ void done(const Unit&) const {}
};

__device__ __forceinline__ unsigned cvt_pk_bf16(float lo, float hi) { unsigned r; asm volatile("v_cvt_pk_bf16_f32 %0, %1, %2" : "=v"(r) : "v"(lo), "v"(hi)); return r; }
template <class Epi, class Sched, bool ALIGN_EPI = false, bool SP2 = false>
__device__ __forceinline__ void gemm_phase(PG8_LAS unsigned char* lds, const Gemm g, const Sched& S, const Epi& E) {
    const int tid = threadIdx.x, wid = __builtin_amdgcn_readfirstlane(tid >> 6), lane = tid & 63, wr = wid >> 2, wc = wid & 3, fr = lane & 15, fq = lane >> 4;
    const int K = g.K, nt = K / BK;
    unsigned voffA[2], voffB[2];
#pragma unroll
    for (int i = 0; i < 2; ++i) { int R, C; stage_rc(tid * 16 + i * 8192, R, C); const int Rb = Epi::PERM ? ((R & ~31) + perm32(R & 31)) : R;
        voffA[i] = (unsigned)(R * K + C) * 2u; voffB[i] = (unsigned)(Rb * K + C) * 2u; }
    const size_t kstep = (size_t)(BK * 2);
    const size_t hstep = (size_t)HALF * K * 2;
    const size_t tstep = 2 * hstep;
    const unsigned ldsw = (unsigned)wid * 1024u;
    const int aoff = lds_byte(wr * 64 + fr, fq * 8), boff = lds_byte(wc * 32 + fr, fq * 8);
#define PG8_SA(b, h) (((b) * 2 + (h)) * HTB)
#define PG8_SB(b, h) ((4 + (b) * 2 + (h)) * HTB)
#define PG8_STAGE(bufoff, gbase, voff) do { _Pragma("unroll") for (int _i = 0; _i < 2; ++_i) \
        __builtin_amdgcn_global_load_lds((const unsigned*)((const char*)(gbase) + (voff)[_i]), (PG8_LAS unsigned*)(lds + (bufoff) + ldsw + _i * 8192), 16, 0, 0); } while (0)
#define PG8_LDA(dst, b, h) do { _Pragma("unroll") for (int m = 0; m < 4; ++m) _Pragma("unroll") for (int k = 0; k < 2; ++k) dst[m][k] = *(const PG8_LAS bf16x8*)(lds + PG8_SA(b, h) + aoff + m * 2048 + k * 1024); } while (0)
#define PG8_LDB(dst, b, h) do { _Pragma("unroll") for (int n = 0; n < 2; ++n) _Pragma("unroll") for (int k = 0; k < 2; ++k) dst[n][k] = *(const PG8_LAS bf16x8*)(lds + PG8_SB(b, h) + boff + n * 2048 + k * 1024); } while (0)
#define PG8_MMA(ai, bj, At, Bt) do { __builtin_amdgcn_s_setprio(1); _Pragma("unroll") for (int m = 0; m < 4; ++m) _Pragma("unroll") for (int n = 0; n < 2; ++n) _Pragma("unroll") for (int k = 0; k < 2; ++k) \
        acc[ai][bj][m][n] = __builtin_amdgcn_mfma_f32_16x16x32_bf16(Bt[n][k], At[m][k], acc[ai][bj][m][n], 0, 0, 0); __builtin_amdgcn_s_setprio(0); } while (0)
#define PG8_WAIT_V(n) asm volatile("s_waitcnt vmcnt(" #n ")" ::: "memory")
#define PG8_WAIT_L(n) asm volatile("s_waitcnt lgkmcnt(" #n ")" ::: "memory")
#define PG8_BAR __builtin_amdgcn_s_barrier()
#define PG8_SCHED __builtin_amdgcn_sched_barrier(0)
    Unit cur, nxt; int ui = 0;
    if (!S.next(0, cur)) return;
    f32x4 acc[2][2][4][2];
#pragma unroll
    for (int a = 0; a < 2; ++a)
#pragma unroll
        for (int b = 0; b < 2; ++b)
#pragma unroll
            for (int m = 0; m < 4; ++m)
#pragma unroll
                for (int n = 0; n < 2; ++n) acc[a][b][m][n] = (f32x4){0.f, 0.f, 0.f, 0.f};
    bf16x8 At[4][2], B0[2][2], B1[2][2];
    const char* cA = (const char*)g.A + (size_t)cur.pm * tstep; const char* cB = (const char*)g.Bt + (size_t)cur.pn * tstep;
    S.a_ready(cur);
    if constexpr (SP2) {
        PG8_STAGE(PG8_SB(0, 0), cB, voffB); PG8_STAGE(PG8_SB(0, 1), cB + hstep, voffB); PG8_STAGE(PG8_SA(0, 0), cA, voffA); PG8_STAGE(PG8_SA(0, 1), cA + hstep, voffA);
        if (wr == 1) PG8_BAR;
        PG8_WAIT_V(2); PG8_BAR;
        PG8_STAGE(PG8_SB(1, 0), cB + kstep, voffB); PG8_STAGE(PG8_SA(1, 0), cA + kstep, voffA); PG8_STAGE(PG8_SB(1, 1), cB + hstep + kstep, voffB);
        PG8_WAIT_V(6); PG8_BAR;
    } else {
        PG8_STAGE(PG8_SB(0, 0), cB, voffB); PG8_STAGE(PG8_SA(0, 0), cA, voffA); PG8_STAGE(PG8_SB(0, 1), cB + hstep, voffB); PG8_STAGE(PG8_SA(0, 1), cA + hstep, voffA);
        if (wr == 1) PG8_BAR;
        PG8_WAIT_V(4); PG8_BAR;
        PG8_STAGE(PG8_SB(1, 0), cB + kstep, voffB); PG8_STAGE(PG8_SA(1, 0), cA + kstep, voffA); PG8_STAGE(PG8_SB(1, 1), cB + hstep + kstep, voffB);
        PG8_WAIT_V(6); PG8_BAR;
    }
    for (;;) {
        const bool has_next = S.next(ui + 1, nxt);
        const char* nA = has_next ? (const char*)g.A + (size_t)nxt.pm * tstep : cA; const char* nB = has_next ? (const char*)g.Bt + (size_t)nxt.pn * tstep : cB;
        for (int t = 0; t < nt; t += 2) {
            const bool last = (t == nt - 2);
            const char* a1 = cA + (size_t)(t + 1) * kstep;
            const char* a2 = last ? nA : cA + (size_t)(t + 2) * kstep; const char* b2 = last ? nB : cB + (size_t)(t + 2) * kstep;
            const char* a3 = a2 + kstep; const char* b3 = b2 + kstep;
            if (last && has_next) S.a_ready(nxt);
            if constexpr (SP2) {
            PG8_LDB(B0, 0, 0); PG8_LDB(B1, 0, 1); PG8_SCHED; PG8_LDA(At, 0, 0); PG8_STAGE(PG8_SA(1, 1), a1 + hstep, voffA);
            PG8_WAIT_V(8); PG8_WAIT_L(0); PG8_BAR; PG8_MMA(0, 0, At, B0); PG8_MMA(0, 1, At, B1); PG8_BAR; PG8_SCHED;
            PG8_LDA(At, 0, 1); PG8_STAGE(PG8_SB(0, 0), b2, voffB); PG8_STAGE(PG8_SB(0, 1), b2 + hstep, voffB); PG8_STAGE(PG8_SA(0, 0), a2, voffA);
            PG8_WAIT_V(8); PG8_WAIT_L(0); PG8_BAR; PG8_MMA(1, 0, At, B0); PG8_MMA(1, 1, At, B1); PG8_BAR; PG8_SCHED;
            PG8_LDB(B0, 1, 0); PG8_LDB(B1, 1, 1); PG8_SCHED; PG8_LDA(At, 1, 0); PG8_STAGE(PG8_SA(0, 1), a2 + hstep, voffA);
            PG8_WAIT_V(8); PG8_WAIT_L(0); PG8_BAR; PG8_MMA(0, 0, At, B0); PG8_MMA(0, 1, At, B1); PG8_BAR; PG8_SCHED;
            PG8_LDA(At, 1, 1); PG8_STAGE(PG8_SB(1, 0), b3, voffB); PG8_STAGE(PG8_SB(1, 1), b3 + hstep, voffB); PG8_STAGE(PG8_SA(1, 0), a3, voffA);
            PG8_WAIT_V(8); PG8_WAIT_L(0); PG8_BAR; PG8_MMA(1, 0, At, B0); PG8_MMA(1, 1, At, B1); PG8_BAR; PG8_SCHED;
            } else {
            PG8_LDB(B0, 0, 0); PG8_SCHED; PG8_LDA(At, 0, 0); PG8_STAGE(PG8_SA(1, 1), a1 + hstep, voffA);
            PG8_WAIT_L(8); PG8_BAR; PG8_WAIT_L(0); PG8_MMA(0, 0, At, B0); PG8_BAR; PG8_SCHED;
            PG8_LDB(B1, 0, 1); PG8_STAGE(PG8_SB(0, 0), b2, voffB);
            PG8_BAR; PG8_WAIT_L(0); PG8_MMA(0, 1, At, B1); PG8_BAR;
            PG8_LDA(At, 0, 1); PG8_STAGE(PG8_SA(0, 0), a2, voffA);
            PG8_BAR; PG8_WAIT_L(0); PG8_MMA(1, 0, At, B0); PG8_BAR; PG8_SCHED;
            PG8_STAGE(PG8_SB(0, 1), b2 + hstep, voffB);
            PG8_WAIT_V(6); PG8_BAR; PG8_MMA(1, 1, At, B1); PG8_BAR;
            PG8_LDB(B0, 1, 0); PG8_SCHED; PG8_LDA(At, 1, 0); PG8_STAGE(PG8_SA(0, 1), a2 + hstep, voffA);
            PG8_WAIT_L(8); PG8_BAR; PG8_WAIT_L(0); PG8_MMA(0, 0, At, B0); PG8_BAR; PG8_SCHED;
            PG8_LDB(B1, 1, 1); PG8_STAGE(PG8_SB(1, 0), b3, voffB);
            PG8_BAR; PG8_WAIT_L(0); PG8_MMA(0, 1, At, B1); PG8_BAR;
            PG8_LDA(At, 1, 1); PG8_STAGE(PG8_SA(1, 0), a3, voffA);
            PG8_BAR; PG8_WAIT_L(0); PG8_MMA(1, 0, At, B0); PG8_BAR; PG8_SCHED;
            PG8_STAGE(PG8_SB(1, 1), b3 + hstep, voffB);
            PG8_WAIT_V(6); PG8_BAR; PG8_MMA(1, 1, At, B1); PG8_BAR;
            }
        }
        if constexpr (ALIGN_EPI) { if (wr == 0) PG8_BAR; }
        if constexpr (!Epi::AFTER_DRAIN) { E(acc, cur, wr, wc, fr, fq); S.done(cur); }
        if (!has_next) break;
#pragma unroll
        for (int a = 0; a < 2; ++a)
#pragma unroll
            for (int b = 0; b < 2; ++b)
#pragma unroll
                for (int m = 0; m < 4; ++m)
#pragma unroll
                    for (int n = 0; n < 2; ++n) acc[a][b][m][n] = (f32x4){0.f, 0.f, 0.f, 0.f};
        cur = nxt; cA = nA; cB = nB; ++ui;
        if constexpr (ALIGN_EPI) { if (wr == 1) PG8_BAR; }
    }
    PG8_WAIT_V(0);
    if constexpr (!ALIGN_EPI) { if (wr == 0) PG8_BAR; }
    PG8_BAR;
    if constexpr (Epi::AFTER_DRAIN) { E.fused(acc, cur, wr, wc, fr, fq, lds, wid, lane); S.done(cur); }
#undef PG8_SA
#undef PG8_SB
#undef PG8_STAGE
#undef PG8_LDA
#undef PG8_LDB
#undef PG8_MMA
#undef PG8_WAIT_V
#undef PG8_WAIT_L
#undef PG8_BAR
#undef PG8_SCHED
}
}
#include <hip/hip_bf16.h>
#include <cmath>
namespace attn_body {
using bf16=__hip_bfloat16;
using bf16x8=__attribute__((ext_vector_type(8)))short;
using s16x4=__attribute__((ext_vector_type(4)))short;
using f32x16=__attribute__((ext_vector_type(16)))float;
using u32x4=__attribute__((ext_vector_type(4)))unsigned;
constexpr int BATCH=8,NHEAD=8,SEQ=2048,D=64,DM=NHEAD*D,OPITCH=1024;
constexpr int NW=8,QBLK=32,QB=QBLK*NW,KVBLK=64,NQB=SEQ/QB;
constexpr int ATTN_PITCH=DM, ATTN_UNIT_ROWS=QB;
__device__ __forceinline__ int crow(int r,int hi){return (r&3)+8*(r>>2)+4*hi;}
#define SBAR() __builtin_amdgcn_sched_barrier(0)
__device__ __forceinline__ void cmask(f32x16&p0,f32x16&p1,int jb,int qrel,int hi){
  const float NEG=-INFINITY; int dq=qrel-64*jb-4*hi; asm volatile("":"+v"(dq));
  #pragma unroll
  for(int r=0;r<16;++r){const int c=(r&3)+8*(r>>2); if(c>dq)p0[r]=NEG; if(c+32>dq)p1[r]=NEG;}
}

constexpr int NSLOT=3, SLOTB=8192;
constexpr int LDS_K=0, LDS_V=NSLOT*SLOTB, LDS_WS=2*NSLOT*SLOTB, LDS_OST=LDS_WS+NW*64*4, LDS_BYTES=LDS_OST+NW*4096;
constexpr float C2=0.125f*1.4426950408889634f;
__device__ __forceinline__ void glds16(const void*gbase,unsigned voff,unsigned lds_dst){unsigned keep;
  asm volatile("s_mov_b32 %0, m0\n\ts_mov_b32 m0, %3\n\ts_nop 0\n\tglobal_load_lds_dwordx4 %1, %2\n\ts_mov_b32 m0, %0":"=&s"(keep):"v"(voff),"s"(gbase),"s"(lds_dst):"memory");}
__device__ __forceinline__ float max3f(float a,float b,float c){float r;asm("v_max3_f32 %0, %1, %2, %3":"=v"(r):"v"(a),"v"(b),"v"(c));return r;}
__device__ __forceinline__ float max2f(float a,float b){float r;asm("v_max_f32_e32 %0, %1, %2":"=v"(r):"v"(a),"v"(b));return r;}
__device__ __forceinline__ float fadd_s(float a,float b){float r;asm("v_add_f32_e32 %0, %1, %2":"=v"(r):"v"(a),"v"(b));return r;}
__device__ __forceinline__ float fsub_s(float a,float b){float r;asm("v_sub_f32_e32 %0, %1, %2":"=v"(r):"v"(a),"v"(b));return r;}
typedef float f32x2_t __attribute__((ext_vector_type(2))); typedef __bf16 bf16x2_t __attribute__((ext_vector_type(2)));
__device__ __forceinline__ unsigned cvtpk_s(float lo,float hi){f32x2_t v={lo,hi};bf16x2_t b=__builtin_convertvector(v,bf16x2_t);return __builtin_bit_cast(unsigned,b);}
#define WAIT_BAR(N) asm volatile("s_waitcnt vmcnt(" #N ") lgkmcnt(0)\n\ts_barrier":::"memory")

__device__ __forceinline__ void qkt(f32x16&p0,f32x16&p1,const char*Kslot,const bf16x8*qr,int r32,int hi){
  const char*kb=Kslot+hi*1024+r32*16;
  #pragma unroll
  for(int d0=0;d0<4;++d0){
    const bf16x8 b0=*reinterpret_cast<const bf16x8*>(kb+d0*2048);
    const bf16x8 b1=*reinterpret_cast<const bf16x8*>(kb+d0*2048+512);
    if(d0==0){p0=__builtin_amdgcn_mfma_f32_32x32x16_bf16(b0,qr[0],f32x16{},0,0,0);p1=__builtin_amdgcn_mfma_f32_32x32x16_bf16(b1,qr[0],f32x16{},0,0,0);}
    else{p0=__builtin_amdgcn_mfma_f32_32x32x16_bf16(b0,qr[d0],p0,0,0,0);p1=__builtin_amdgcn_mfma_f32_32x32x16_bf16(b1,qr[d0],p1,0,0,0);}}
}
typedef __attribute__((address_space(3))) const char* lds_cptr;
typedef short v4i16_t __attribute__((ext_vector_type(4)));
__device__ __forceinline__ void kload8(bf16x8*kf,lds_cptr kp){
  kf[0]=*(const __attribute__((address_space(3))) bf16x8*)(kp);      kf[1]=*(const __attribute__((address_space(3))) bf16x8*)(kp+512);
  kf[2]=*(const __attribute__((address_space(3))) bf16x8*)(kp+2048); kf[3]=*(const __attribute__((address_space(3))) bf16x8*)(kp+2560);
  kf[4]=*(const __attribute__((address_space(3))) bf16x8*)(kp+4096); kf[5]=*(const __attribute__((address_space(3))) bf16x8*)(kp+4608);
  kf[6]=*(const __attribute__((address_space(3))) bf16x8*)(kp+6144); kf[7]=*(const __attribute__((address_space(3))) bf16x8*)(kp+6656);
}
__device__ __forceinline__ void kload2(bf16x8*kf,lds_cptr kp,int j){ kf[2*j]=*(const __attribute__((address_space(3))) bf16x8*)(kp+j*2048); kf[2*j+1]=*(const __attribute__((address_space(3))) bf16x8*)(kp+j*2048+512); }
__device__ __forceinline__ s16x4 vtr(lds_cptr p){ return __builtin_bit_cast(s16x4,__builtin_amdgcn_ds_read_tr16_b64_v4i16((__attribute__((address_space(3))) v4i16_t*)p)); }
__device__ __forceinline__ float rowmax(const f32x16&p0,const f32x16&p1){
  float a=max3f(p0[0],p0[1],p1[0]),b=max3f(p0[2],p0[3],p1[1]);a=max3f(a,p1[2],p1[3]);
  #pragma unroll
  for(int r=4;r<16;r+=4){a=max3f(a,p0[r],p0[r+1]);b=max3f(b,p0[r+2],p0[r+3]);a=max3f(a,p1[r],p1[r+1]);b=max3f(b,p1[r+2],p1[r+3]);}
  const float m=max2f(a,b);
  auto rr=__builtin_amdgcn_permlane32_swap(__float_as_uint(m),__float_as_uint(m),false,false);
  return max2f(__uint_as_float(rr[0]),__uint_as_float(rr[1]));
}
__device__ __forceinline__ void pv(f32x16*o,int vb,bf16x8 pa0,bf16x8 pa1,bf16x8 pa2,bf16x8 pa3){
  #pragma unroll
  for(int d0=0;d0<2;++d0){s16x4 lo[4],hi[4];
    #pragma unroll
    for(int ks=0;ks<4;++ks){
      asm volatile("ds_read_b64_tr_b16 %0,%1 offset:%c2":"=&v"(lo[ks]):"v"(vb),"i"(d0*4096+ks*1024):"memory");
      asm volatile("ds_read_b64_tr_b16 %0,%1 offset:%c2":"=&v"(hi[ks]):"v"(vb),"i"(d0*4096+ks*1024+512):"memory");}
    asm volatile("s_waitcnt lgkmcnt(0)":::"memory");SBAR();
    #define PK(k) (bf16x8){lo[k][0],lo[k][1],lo[k][2],lo[k][3],hi[k][0],hi[k][1],hi[k][2],hi[k][3]}
    o[d0]=__builtin_amdgcn_mfma_f32_32x32x16_bf16(pa0,PK(0),o[d0],0,0,0);
    o[d0]=__builtin_amdgcn_mfma_f32_32x32x16_bf16(pa1,PK(1),o[d0],0,0,0);
    o[d0]=__builtin_amdgcn_mfma_f32_32x32x16_bf16(pa2,PK(2),o[d0],0,0,0);
    o[d0]=__builtin_amdgcn_mfma_f32_32x32x16_bf16(pa3,PK(3),o[d0],0,0,0);
    #undef PK
  }
}

#ifndef ATTN_STORE16
#define ATTN_STORE16(p,v) (*(u32x4*)(p)=(v))
#endif
__device__ __forceinline__ unsigned bf_rne(float f){unsigned u=__float_as_uint(f);return (u+0x7fffu+((u>>16)&1u))>>16;}
__device__ __forceinline__ void split3(float x,unsigned&h,unsigned&m,unsigned&l){h=bf_rne(x);float r=x-__uint_as_float(h<<16);m=bf_rne(r);r-=__uint_as_float(m<<16);l=bf_rne(r);}
__device__ __forceinline__ bf16x8 make_qa(float mhat,int hi){unsigned h,m,l;split3(mhat,h,m,l);u32x4 w;w.x=0x3F803F80u;w.y=0x3F80u|(h<<16);w.z=m|(l<<16);w.w=0u;if(hi){w.x=0u;w.y=0u;w.z=0u;}return __builtin_bit_cast(bf16x8,w);}
template<int THRL> __device__ __forceinline__ void attn_unit(int b,int h,int qb,const bf16*Q,const bf16*__restrict__ K,const bf16*__restrict__ V,bf16*O,char*shm,__attribute__((address_space(3))) const char* biasF){
  const int tid=threadIdx.x,lane=tid&63,r32=lane&31,hi=lane>>5; const int wid=__builtin_amdgcn_readfirstlane(tid>>6);
  const long rowbase=(long)b*SEQ; const int q0=qb*QB;
  const bf16*Qw=Q+(rowbase+q0+wid*QBLK)*DM+h*D;
  const bf16*Kh=K+rowbase*DM+h*D,*Vh=V+rowbase*DM+h*D;
  const unsigned lds0=(unsigned)(uintptr_t)shm;
  float*wsf=(float*)(shm+LDS_WS)+wid*64;
  const unsigned ksrc=(unsigned)(lane*DM+wid*8)*2u;
  const unsigned vsrc=(unsigned)((16*(wid&3)+(lane>>2))*DM+(wid>>2)*32+(lane&3)*8)*2u;
  const unsigned kdst=lds0+LDS_K+wid*1024, vdst=lds0+LDS_V+wid*1024;
  #define DMA_K(t,slot) glds16(Kh+(long)(NT-1-(t))*KVBLK*DM,ksrc,(unsigned)__builtin_amdgcn_readfirstlane(kdst+(slot)))
  #define DMA_V(t,slot) glds16(Vh+(long)(NT-1-(t))*KVBLK*DM,vsrc,(unsigned)__builtin_amdgcn_readfirstlane(vdst+(slot)))
  const int vb0=(int)(lds0+LDS_V)+((lane>>4)&1)*32+(lane&3)*8+(4*hi+((lane&15)>>2))*64;
  const char*Kbase=shm+LDS_K; bf16x8 kf[8];
  const lds_cptr shm3=(lds_cptr)shm; const lds_cptr kp0=shm3+LDS_K+hi*1024+r32*16; const lds_cptr vp0=shm3+LDS_V+((lane>>4)&1)*32+(lane&3)*8+(4*hi+((lane&15)>>2))*64;
  const int NT=(q0+QB)/KVBLK;
  DMA_K(0,0);DMA_V(0,0);DMA_K(1,SLOTB);
  bf16x8 qr[4];
  #pragma unroll
  for(int d0=0;d0<4;++d0)qr[d0]=*reinterpret_cast<const bf16x8*>(&Qw[(long)r32*DM+d0*16+hi*8]);
  const int qrel=wid*QBLK+r32;
  float mhat; { const u32x4 bw=*(const __attribute__((address_space(3))) u32x4*)(biasF+(q0+qrel)*16); mhat=(__uint_as_float(bw.x<<16)+__uint_as_float(bw.x&0xffff0000u))+__uint_as_float(bw.y<<16); }
  float l_reg=0.f;f32x16 o[2];o[0]=f32x16{};o[1]=f32x16{};bf16x8 qa=make_qa(mhat,hi);
  #define KAUG(tp,half) (*(const __attribute__((address_space(3))) bf16x8*)(biasF+(64*(tp)+32*(half)+r32)*16))
  #define CMASK(P0,P1,t) do{int jb_=3-(t); if(jb_>=0)cmask(P0,P1,jb_,qrel,hi);}while(0)
  bool resc=false;
  #define START(P0,P1) do{ const float rm=rowmax(P0,P1); resc=false; \
    if(__any(rm>(float)THRL)){ const float dl=max2f(rm,0.f); mhat=fadd_s(mhat,dl); \
      _Pragma("unroll") for(int r=0;r<16;++r){P0[r]=fsub_s(P0[r],dl);P1[r]=fsub_s(P1[r],dl);} \
      qa=make_qa(mhat,hi); } \
    _Pragma("unroll") for(int r=0;r<16;++r)P0[r]=__builtin_amdgcn_exp2f(P0[r]); }while(0)
  #define RESC() do{ if(resc){ asm volatile("s_waitcnt lgkmcnt(0)":::"memory"); \
      _Pragma("unroll") for(int d_=0;d_<2;++d_) _Pragma("unroll") for(int r=0;r<16;++r)o[d_][r]*=wsf[crow(r,hi)]; } }while(0)
  f32x16 pA0,pA1,pB0,pB1;
  int sl_prev=0,sl_cur=0,sl_next=SLOTB;
  #define ROT() do{sl_prev=sl_cur;sl_cur=sl_next;sl_next=(sl_next==(NSLOT-1)*SLOTB)?0:sl_next+SLOTB;}while(0)
  DMA_K(2,2*SLOTB);
  WAIT_BAR(3);
  qkt(pA0,pA1,Kbase,qr,r32,hi);{const bf16x8 ka0_=KAUG(NT-1,0),ka1_=KAUG(NT-1,1);pA0=__builtin_amdgcn_mfma_f32_32x32x16_bf16(ka0_,qa,pA0,0,0,0);pA1=__builtin_amdgcn_mfma_f32_32x32x16_bf16(ka1_,qa,pA1,0,0,0);}asm volatile("s_nop 15\n\ts_nop 7":"+v"(pA0),"+v"(pA1));CMASK(pA0,pA1,0);
  START(pA0,pA1);
  _Pragma("unroll") for(int r=0;r<16;++r)pA1[r]=__builtin_amdgcn_exp2f(pA1[r]);
  WAIT_BAR(0);
  DMA_K(3,0);DMA_V(1,SLOTB);
  ROT();
  kload8(kf,kp0+sl_cur);
  WAIT_BAR(2);
  s16x4 vlo[8],vhi[8]; u32x4 pw0,pw1,pw2,pw3;
  #define PKW(P,B) cvtpk_s(P[B],P[B+1])
  #define PAF(k) __builtin_bit_cast(bf16x8,pw##k)
  #define VFR(i) (bf16x8){vlo[i][0],vlo[i][1],vlo[i][2],vlo[i][3],vhi[i][0],vhi[i][1],vhi[i][2],vhi[i][3]}
  #define PIN(x) asm volatile("":"+v"(x))
  #define MX3(a,b,c) __builtin_fmaxf(__builtin_fmaxf((a),(b)),(c))
  #define GAPA(MF,A0,A1,A2,A3,W0,W1,PW) do{ MF; sacc+=A0; sacc+=A1; sacc+=A2; sacc+=A3; PIN(sacc); W0; W1; PIN(PW); SBAR(); }while(0)
  #define EX(v) __builtin_amdgcn_exp2f(v)
  #define GAPB(MF,X,B) do{ MF; X[B]=EX(X[B]); X[B+1]=EX(X[B+1]); X[B+2]=EX(X[B+2]); X[B+3]=EX(X[B+3]); PIN(X); SBAR(); }while(0)
  #define VRD(i) do{ vlo[i]=vtr(vp_+(((i)>>2)*4096+((i)&3)*1024)); vhi[i]=vtr(vp_+(((i)>>2)*4096+((i)&3)*1024+512)); }while(0)
  #define KRD(G,j) do{ if(G){ kload2(kf,kp0+sl_next,j); SBAR(); } }while(0)
  #define STEP(C0,C1,P0,P1,t,GK,GV,GL) do{ SBAR(); \
    const lds_cptr vp_=vp0+sl_prev; \
    VRD(0); SBAR(); float sacc=(P0[0]+P0[1]); \
    GAPA(C0=__builtin_amdgcn_mfma_f32_32x32x16_bf16(kf[0],qr[0],f32x16{},0,0,0), P0[2],P0[3],P0[4],P0[5],     pw0[0]=PKW(P0,0), pw0[1]=PKW(P0,2), pw0); \
    VRD(4); SBAR(); GAPA(C1=__builtin_amdgcn_mfma_f32_32x32x16_bf16(kf[1],qr[0],f32x16{},0,0,0), P0[6],P0[7],P0[8],P0[9],     pw0[2]=PKW(P0,4), pw0[3]=PKW(P0,6), pw0); \
    VRD(1); SBAR(); GAPA(C0=__builtin_amdgcn_mfma_f32_32x32x16_bf16(kf[2],qr[1],C0,0,0,0),   P0[10],P0[11],P0[12],P0[13], pw1[0]=PKW(P0,8), pw1[1]=PKW(P0,10), pw1); \
    VRD(5); SBAR(); GAPA(C1=__builtin_amdgcn_mfma_f32_32x32x16_bf16(kf[3],qr[1],C1,0,0,0),   P0[14],P0[15],P1[0],P1[1],   pw1[2]=PKW(P0,12),pw1[3]=PKW(P0,14), pw1); \
    VRD(2); SBAR(); GAPA(C0=__builtin_amdgcn_mfma_f32_32x32x16_bf16(kf[4],qr[2],C0,0,0,0),   P1[2],P1[3],P1[4],P1[5],     pw2[0]=PKW(P1,0), pw2[1]=PKW(P1,2), pw2); \
    VRD(6); SBAR(); GAPA(C1=__builtin_amdgcn_mfma_f32_32x32x16_bf16(kf[5],qr[2],C1,0,0,0),   P1[6],P1[7],P1[8],P1[9],     pw2[2]=PKW(P1,4), pw2[3]=PKW(P1,6), pw2); \
    VRD(3); const bf16x8 ka0_=KAUG(NT-1-(t),0); SBAR(); GAPA(C0=__builtin_amdgcn_mfma_f32_32x32x16_bf16(kf[6],qr[3],C0,0,0,0),   P1[10],P1[11],P1[12],P1[13], pw3[0]=PKW(P1,8), pw3[1]=PKW(P1,10), pw3); \
    VRD(7); const bf16x8 ka1_=KAUG(NT-1-(t),1); SBAR(); GAPA(C1=__builtin_amdgcn_mfma_f32_32x32x16_bf16(kf[7],qr[3],C1,0,0,0),   P1[14],P1[15],0.f,0.f,       pw3[2]=PKW(P1,12),pw3[3]=PKW(P1,14), pw3); \
    C0=__builtin_amdgcn_mfma_f32_32x32x16_bf16(ka0_,qa,C0,0,0,0); SBAR(); C1=__builtin_amdgcn_mfma_f32_32x32x16_bf16(ka1_,qa,C1,0,0,0); SBAR(); \
    l_reg+=sacc; \
    if(GK){DMA_K((t)+3,sl_cur);} if(GV){DMA_V((t)+1,sl_next);} \
    CMASK(C0,C1,t); \
    { float a=MX3(C0[0],C0[1],C1[0]),b=MX3(C0[2],C0[3],C1[1]); a=MX3(a,C1[2],C1[3]); \
      _Pragma("unroll") for(int r=4;r<16;r+=4){a=MX3(a,C0[r],C0[r+1]);b=MX3(b,C0[r+2],C0[r+3]);a=MX3(a,C1[r],C1[r+1]);b=MX3(b,C1[r+2],C1[r+3]);} \
      float rm=__builtin_fmaxf(a,b); { auto rr=__builtin_amdgcn_permlane32_swap(__float_as_uint(rm),__float_as_uint(rm),false,false); rm=__builtin_fmaxf(__uint_as_float(rr[0]),__uint_as_float(rr[1])); } \
      resc=false; \
      if(__builtin_expect(__any(rm>(float)THRL),0)){ const float dl=__builtin_fmaxf(rm,0.f); mhat+=dl; \
        _Pragma("unroll") for(int r=0;r<16;++r){C0[r]-=dl;C1[r]-=dl;} \
        qa=make_qa(mhat,hi); \
        const float f=__builtin_amdgcn_exp2f(-dl); l_reg*=f; if(hi==0)wsf[r32]=f; resc=true; } } \
    SBAR(); \
    GAPB(o[0]=__builtin_amdgcn_mfma_f32_32x32x16_bf16(PAF(0),VFR(0),o[0],0,0,0), C0,0); \
    GAPB(o[1]=__builtin_amdgcn_mfma_f32_32x32x16_bf16(PAF(0),VFR(4),o[1],0,0,0), C0,4); \
    KRD(GL,0); GAPB(o[0]=__builtin_amdgcn_mfma_f32_32x32x16_bf16(PAF(1),VFR(1),o[0],0,0,0), C0,8); \
    KRD(GL,1); GAPB(o[1]=__builtin_amdgcn_mfma_f32_32x32x16_bf16(PAF(1),VFR(5),o[1],0,0,0), C0,12); \
    KRD(GL,2); GAPB(o[0]=__builtin_amdgcn_mfma_f32_32x32x16_bf16(PAF(2),VFR(2),o[0],0,0,0), C1,0); \
    KRD(GL,3); GAPB(o[1]=__builtin_amdgcn_mfma_f32_32x32x16_bf16(PAF(2),VFR(6),o[1],0,0,0), C1,4); \
    GAPB(o[0]=__builtin_amdgcn_mfma_f32_32x32x16_bf16(PAF(3),VFR(3),o[0],0,0,0), C1,8); \
    GAPB(o[1]=__builtin_amdgcn_mfma_f32_32x32x16_bf16(PAF(3),VFR(7),o[1],0,0,0), C1,12); \
    }while(0)
  int t=1;
  #define ENDW(tt) do{ if((tt)+3<NT){WAIT_BAR(2);} else if((tt)+2<NT){WAIT_BAR(1);} else {WAIT_BAR(0);} }while(0)
  for(;t+1<NT;t+=2){
    STEP(pB0,pB1,pA0,pA1,t,(t+3<NT),(t+1<NT),(t+1<NT));       ENDW(t);   RESC(); ROT();
    STEP(pA0,pA1,pB0,pB1,t+1,(t+4<NT),(t+2<NT),(t+2<NT));     ENDW(t+1); RESC(); ROT();
  }
  STEP(pB0,pB1,pA0,pA1,NT-1,false,false,false); RESC();
  { float sacc=pB0[0]+pB0[1]; _Pragma("unroll") for(int r=2;r<16;++r)sacc+=pB0[r]; _Pragma("unroll") for(int r=0;r<16;++r)sacc+=pB1[r]; l_reg+=sacc;
    pw0=(u32x4){PKW(pB0,0),PKW(pB0,2),PKW(pB0,4),PKW(pB0,6)};pw1=(u32x4){PKW(pB0,8),PKW(pB0,10),PKW(pB0,12),PKW(pB0,14)};pw2=(u32x4){PKW(pB1,0),PKW(pB1,2),PKW(pB1,4),PKW(pB1,6)};pw3=(u32x4){PKW(pB1,8),PKW(pB1,10),PKW(pB1,12),PKW(pB1,14)};
    SBAR(); pv(o,vb0+sl_cur,PAF(0),PAF(1),PAF(2),PAF(3)); }
  #undef PKW
  #undef PAF
  #undef VFR
  #undef PIN
  #undef MX3
  #undef GAPA
  #undef GAPB
  #undef EX
  #undef VRD
  #undef KRD
  #undef STEP
  #undef ENDW
  {auto rr=__builtin_amdgcn_permlane32_swap(__float_as_uint(l_reg),__float_as_uint(l_reg),false,false);l_reg=__uint_as_float(rr[0])+__uint_as_float(rr[1]);}
  if(hi==0)wsf[32+r32]=l_reg;asm volatile("s_waitcnt lgkmcnt(0)":::"memory");
  float rli[16];
  #pragma unroll
  for(int r=0;r<16;++r)rli[r]=__builtin_amdgcn_rcpf(wsf[32+crow(r,hi)]);
  bf16*Ow=O+(rowbase+q0+wid*QBLK)*OPITCH+h*D;
  { bf16*stg=(bf16*)(shm+LDS_OST)+wid*2048;
    #pragma unroll
    for(int r=0;r<16;++r){const int orow=crow(r,hi);
      #pragma unroll
      for(int d0=0;d0<2;++d0)stg[orow*64+d0*32+r32]=__float2bfloat16(o[d0][r]*rli[r]);}
    asm volatile("s_waitcnt lgkmcnt(0)":::"memory");
    #pragma unroll
    for(int i=0;i<4;++i){const int row=i*8+(lane>>3),ch=lane&7; const u32x4 v=*(const u32x4*)(stg+row*64+ch*8); ATTN_STORE16(Ow+(long)row*OPITCH+ch*8,v);} }
  asm volatile("s_waitcnt lgkmcnt(0)\n\ts_barrier":::"memory");
  #undef DMA_K
  #undef DMA_V
  #undef CMASK
  #undef KAUG
  #undef START
  #undef RESC
  #undef ROT
}
constexpr int ATTN_LDS_BYTES=LDS_BYTES;
struct AttnTensors { const bf16* Q; const bf16* K; const bf16* V; bf16* O; };
struct AttnUnit { int bh; int qb; };
#undef SBAR
#undef WAIT_BAR
}
#define GAS __attribute__((address_space(1)))
#define LAS __attribute__((address_space(3)))
typedef unsigned short bf16;
typedef unsigned v4u __attribute__((ext_vector_type(4)));
typedef float f32x4 __attribute__((ext_vector_type(4)));
typedef short bf16x8 __attribute__((ext_vector_type(8)));
typedef GAS unsigned gu32;
typedef GAS unsigned long long gu64;
#define RLX_AGENT __ATOMIC_RELAXED, __HIP_MEMORY_SCOPE_AGENT
#define LDS_WAIT() asm volatile("s_waitcnt lgkmcnt(0)" ::: "memory")
#define VM_WAIT() asm volatile("s_waitcnt vmcnt(0)" ::: "memory")
__device__ __forceinline__ unsigned long long rt() { return __builtin_amdgcn_s_memrealtime(); }
__device__ __forceinline__ unsigned f2bf(float f) { unsigned u = __builtin_bit_cast(unsigned, f); return (u + 0x7fffu + ((u >> 16) & 1u)) >> 16; }
__device__ __forceinline__ unsigned pk2(float lo, float hi) { unsigned r; asm("v_cvt_pk_bf16_f32 %0, %1, %2" : "=v"(r) : "v"(lo), "v"(hi)); return r; }

#define XB_TMO      128
#define XB_XCNT(j)  (256  + 64 * (j))
#define XB_XSUB(j)  (1280 + 64 * (j))
#define XB_XGEN(j)  (2304 + 64 * (j))
#define XB_TOP      3328
#define XB_TOPGEN   3392
#define XCD_BAR_WORDS 3456
#define XB_SPIN_CAP (1u << 18)

__device__ __forceinline__ unsigned xb_ld(unsigned* p)              { return __hip_atomic_load(p, __ATOMIC_RELAXED, __HIP_MEMORY_SCOPE_AGENT); }
__device__ __forceinline__ unsigned xb_add(unsigned* p, unsigned v) { return __hip_atomic_fetch_add(p, v, __ATOMIC_RELAXED, __HIP_MEMORY_SCOPE_AGENT); }
__device__ __forceinline__ unsigned xb_xcc_id() { return (unsigned)__builtin_amdgcn_s_getreg((3 << 11) | 20) & 0xFu; }
#define XB_SPIN(cond, bar) do { unsigned _sp = 0; while (cond) { __builtin_amdgcn_s_sleep(1); \
    if ((++_sp & 255u) == 0u) { if (xb_ld(&(bar)[XB_TMO])) break; if (_sp > XB_SPIN_CAP) { atomicAdd(&(bar)[XB_TMO], 1u); break; } } } } while (0)

struct XcdBarrier {
    unsigned* bar; unsigned x;
    volatile LAS unsigned* st;
};

__device__ __forceinline__ XcdBarrier xcd_barrier_post(unsigned* bar, volatile LAS unsigned* st) {
    XcdBarrier b; b.bar = bar; b.x = xb_xcc_id(); b.st = st;
    if (threadIdx.x == 0) (void)xb_add(&bar[XB_XCNT(b.x)], 1u);
    return b;
}
__device__ __forceinline__ void xcd_barrier_complete(unsigned* bar, unsigned x, unsigned& nloc, unsigned& nx) {
    const unsigned G = gridDim.x * gridDim.y * gridDim.z;
    unsigned sum, cnt, mine, sp = 0u;
    for (;;) {
        sum = 0u; cnt = 0u; mine = 0u;
#pragma unroll
        for (unsigned j = 0; j < 16; ++j) { const unsigned c = xb_ld(&bar[XB_XCNT(j)]); sum += c; cnt += (c > 0u) ? 1u : 0u; mine = (j == x) ? c : mine; }
        if (sum == G) break;
        __builtin_amdgcn_s_sleep(1);
        if ((++sp & 255u) == 0u) { if (xb_ld(&bar[XB_TMO])) break; if (sp > XB_SPIN_CAP) { atomicAdd(&bar[XB_TMO], 1u); break; } }
    }
    nloc = mine > 0u ? mine : 1u; nx = cnt > 0u ? cnt : 1u;
}

__device__ __forceinline__ void xcd_barrier(const XcdBarrier& b) {
    asm volatile("s_waitcnt vmcnt(0)" ::: "memory");
    __syncthreads();
    if (threadIdx.x == 0) {
        unsigned* bar = b.bar;
        __builtin_amdgcn_s_waitcnt(0);
        unsigned nloc = b.st[0], nx = b.st[1];
        if (nloc == 0u) { xcd_barrier_complete(bar, b.x, nloc, nx); b.st[0] = nloc; b.st[1] = nx; }
        const unsigned old = xb_add(&bar[XB_XSUB(b.x)], 1u);
        const unsigned gen = old / nloc;
        if (old + 1u == (gen + 1u) * nloc) {
            __builtin_amdgcn_fence(__ATOMIC_RELEASE, "agent");
            asm volatile("s_waitcnt vmcnt(0)" ::: "memory");
            const unsigned og = xb_add(&bar[XB_TOP], 1u);
            const unsigned tg = og / nx;
            if (og + 1u == (tg + 1u) * nx) xb_add(&bar[XB_TOPGEN], 1u);
            else XB_SPIN(xb_ld(&bar[XB_TOPGEN]) == tg, bar);
            __builtin_amdgcn_fence(__ATOMIC_ACQUIRE, "agent");
            xb_add(&bar[XB_XGEN(b.x)], 1u);
            asm volatile("s_waitcnt vmcnt(0)" ::: "memory");
        } else {
            XB_SPIN(xb_ld(&bar[XB_XGEN(b.x)]) == gen, bar);
            __builtin_amdgcn_fence(__ATOMIC_ACQUIRE, "agent");
            asm volatile("s_waitcnt vmcnt(0)" ::: "memory");
        }
    }
    __syncthreads();
}


constexpr int NWAVES = 8, NTHR = NWAVES * 64;
constexpr int DMODEL = 1024, NB = 8, SEQ = 2048, MP = NB * SEQ, DB = 128, MT = MP + DB, MPAD = 16640;
constexpr int FH = 8, FD = 64, FW = 512, GH = 4, GD = 128, GW = 512, FFN = 2816;
constexpr int NIN = 3840, NUP = 2 * FFN, NGQKV = 3 * GW;
constexpr int NPAGES = 16, PAGE = 128;
constexpr float EPS = 1e-6f, LOG2E = 1.4426950408889634f, QSCALE = 0.08838834764831845f;
constexpr int NCHUNK = 32, NCH_TOT = NB * GH * NCHUNK;
constexpr size_t OUT_YP = 0, OUT_YS = OUT_YP + (size_t)MP * DMODEL, OUT_KP = OUT_YS + (size_t)DB * DMODEL, OUT_VP = OUT_KP + (size_t)MP * FW,
    OUT_LFP = OUT_VP + (size_t)MP * FW, OUT_GSP = OUT_LFP + (size_t)MP * FH, OUT_GCP = OUT_GSP + (size_t)NB * GH * GD * GD, OUT_FCP = OUT_GCP + (size_t)NB * 3 * NGQKV,
    OUT_KS = OUT_FCP + (size_t)NB * 2 * FFN, OUT_VS = OUT_KS + (size_t)DB * FW, OUT_LFS = OUT_VS + (size_t)DB * FW, OUT_GSS = OUT_LFS + (size_t)DB * FH,
    OUT_GCS = OUT_GSS + (size_t)DB * GH * GD * GD, OUT_FCS = OUT_GCS + (size_t)DB * 3 * NGQKV, OUT_END = OUT_FCS + (size_t)DB * 2 * FFN;
static_assert(OUT_END == 44254208, "output size");
constexpr size_t MiB = 1u << 20;
constexpr size_t WS_CTL = 0, CTL_ZERO_BYTES = 1 * MiB;
constexpr size_t WS_WIN = 2 * MiB, WS_WOUT = 10 * MiB, WS_WUP = 12 * MiB, WS_WDN = 23 * MiB, WS_GATE = 29 * MiB, WS_PT = 31 * MiB, WS_DPART = 32 * MiB;
constexpr size_t WS_XN = 40 * MiB, WS_QB = 73 * MiB, WS_KB = 90 * MiB, WS_VB = 107 * MiB, WS_GQKV = 124 * MiB, WS_GZ = 173 * MiB, WS_MIX = 190 * MiB;
constexpr size_t WS_X1 = 223 * MiB, WS_GU = 288 * MiB, WS_ACT = 467 * MiB, WS_X2 = 557 * MiB, WS_GDN = 622 * MiB, WS_GL = 694 * MiB, WS_CUM = 695 * MiB, WS_SSQ = 703 * MiB, WS_END = 706 * MiB;
constexpr size_t GDN_CH_BYTES = 73728;
static_assert(WS_GDN + (size_t)NCH_TOT * GDN_CH_BYTES <= WS_GL, "gdn chunk buffers");
static_assert(WS_GU + (size_t)MPAD * NUP * 2 <= WS_ACT && WS_ACT + (size_t)MPAD * FFN * 2 <= WS_X2 && WS_X2 + (size_t)MPAD * DMODEL * 4 <= WS_GDN, "ws map");
constexpr int CW_BAR = 4096, CW_DEC = 8192, CW_FIN = 16384, CW_SFIN = 24576;
constexpr int CW_FIN_DUMMY = 0;
constexpr int CW_BAR_ = 0, CW_DEC_ = 0;
constexpr int DP_UNIT = 640, DP_HEAD = 80;
constexpr int RING_OFF = 0, RING_BYTES = 131072, LDSCTL_OFF = 150528, MISC_OFF = LDSCTL_OFF + 320, LDS_BYTES = 151552;
constexpr int BIAS_OFF = 86016, WTOT_OFF = BIAS_OFF + 32768;
static_assert(attn_body::ATTN_LDS_BYTES <= BIAS_OFF && WTOT_OFF + 64 <= RING_BYTES, "attention LDS");
constexpr int NPH = 13;
#ifndef PROBE_DUP
#define PROBE_DUP -1
#endif

typedef float f32x2v __attribute__((ext_vector_type(2)));
typedef unsigned v2u __attribute__((ext_vector_type(2)));
__device__ __forceinline__ float bf2f(unsigned short u) { return __uint_as_float((unsigned)u << 16); }
__device__ __forceinline__ float bflo(unsigned u) { return __uint_as_float(u << 16); }
__device__ __forceinline__ float bfhi(unsigned u) { return __uint_as_float(u & 0xffff0000u); }
__device__ __forceinline__ float wave_sum(float v) {
#pragma unroll
    for (int o = 1; o < 64; o <<= 1) v += __shfl_xor(v, o);
    return v;
}
template <int CTRL> __device__ __forceinline__ float dppf(float x) { return __builtin_bit_cast(float, __builtin_amdgcn_mov_dpp(__builtin_bit_cast(int, x), CTRL, 0xf, 0xf, true)); }
__device__ __forceinline__ float sigmoidf_(float x) { return __builtin_amdgcn_rcpf(1.f + __expf(-x)); }
__device__ __forceinline__ float siluf_(float x) { return x * __builtin_amdgcn_rcpf(1.f + __expf(-x)); }
__device__ __forceinline__ float softplusf_(float x) { return fmaxf(x, 0.f) + __logf(1.f + __expf(-fabsf(x))); }

struct EpiInProj {
    static constexpr bool PERM = true, AFTER_DRAIN = false;
    bf16 *QB, *KB, *VB, *GQKV, *GZ; float* GATE; float* out; const float *b_forget, *a_log, *dt_bias;
    __device__ __forceinline__ void operator()(const pg8::f32x4 (&acc)[2][2][4][2], const pg8::Unit& u, int wr, int wc, int fr, int fq) const {
        const int pn = u.pn;
#pragma unroll
        for (int ai = 0; ai < 2; ++ai)
#pragma unroll
            for (int m = 0; m < 4; ++m) {
                const int row = u.pm * 256 + ai * 128 + wr * 64 + m * 16 + fr;
#pragma unroll
                for (int bj = 0; bj < 2; ++bj) {
                    const int col8 = bj * 128 + wc * 32 + 8 * fq;
                    const pg8::f32x4 v0 = acc[ai][bj][m][0], v1 = acc[ai][bj][m][1];
                    if (pn < 2) {
                        const float s = attn_body::C2; v4u w; w.x = pg8::cvt_pk_bf16(v0[0] * s, v0[1] * s); w.y = pg8::cvt_pk_bf16(v0[2] * s, v0[3] * s); w.z = pg8::cvt_pk_bf16(v1[0] * s, v1[1] * s); w.w = pg8::cvt_pk_bf16(v1[2] * s, v1[3] * s);
                        *(v4u*)(QB + (size_t)row * FW + pn * 256 + col8) = w;
                    } else if (pn < 6) {
                        const int isv = pn >= 4, c = (pn - (isv ? 4 : 2)) * 256 + col8;
                        v4u w; w.x = pg8::cvt_pk_bf16(v0[0], v0[1]); w.y = pg8::cvt_pk_bf16(v0[2], v0[3]); w.z = pg8::cvt_pk_bf16(v1[0], v1[1]); w.w = pg8::cvt_pk_bf16(v1[2], v1[3]);
                        *(v4u*)((isv ? VB : KB) + (size_t)row * FW + c) = w;
                        if (row < MT) { float* o = out + (row < MP ? (isv ? OUT_VP : OUT_KP) + (size_t)row * FW : (isv ? OUT_VS : OUT_KS) + (size_t)(row - MP) * FW) + c;
                            *(pg8::f32x4*)o = v0; *(pg8::f32x4*)(o + 4) = v1; }
                    } else if (pn < 12) {
                        const int c = (pn - 6) * 256 + col8;
                        v4u w; w.x = pg8::cvt_pk_bf16(v0[0], v0[1]); w.y = pg8::cvt_pk_bf16(v0[2], v0[3]); w.z = pg8::cvt_pk_bf16(v1[0], v1[1]); w.w = pg8::cvt_pk_bf16(v1[2], v1[3]);
                        *(v4u*)(GQKV + (size_t)row * NGQKV + c) = w;
                        if (row < MP) { const int t = row & (SEQ - 1), b = row >> 11;
                            if (t >= SEQ - 3) { float* o = out + OUT_GCP + (size_t)(b * 3 + (t - (SEQ - 3))) * NGQKV + c; *(pg8::f32x4*)o = v0; *(pg8::f32x4*)(o + 4) = v1; } }
                        else if (row < MT) { float* o = out + OUT_GCS + (size_t)((row - MP) * 3 + 2) * NGQKV + c; *(pg8::f32x4*)o = v0; *(pg8::f32x4*)(o + 4) = v1; }
                    } else if (pn < 14) {
                        v4u w; w.x = pg8::cvt_pk_bf16(v0[0], v0[1]); w.y = pg8::cvt_pk_bf16(v0[2], v0[3]); w.z = pg8::cvt_pk_bf16(v1[0], v1[1]); w.w = pg8::cvt_pk_bf16(v1[2], v1[3]);
                        *(v4u*)(GZ + (size_t)row * GW + (pn - 12) * 256 + col8) = w;
                    } else {
                        if (col8 == 0) {
                            float lf[8];
#pragma unroll
                            for (int j = 0; j < 8; ++j) { const float x = (j < 4 ? v0[j] : v1[j - 4]) + b_forget[j]; lf[j] = -softplusf_(-x); }
                            float* g = GATE + (size_t)row * 16; *(pg8::f32x4*)g = (pg8::f32x4){lf[0], lf[1], lf[2], lf[3]}; *(pg8::f32x4*)(g + 4) = (pg8::f32x4){lf[4], lf[5], lf[6], lf[7]};
                            if (row < MT) { float* o = out + (row < MP ? OUT_LFP + (size_t)row * FH : OUT_LFS + (size_t)(row - MP) * FH);
                                *(pg8::f32x4*)o = (pg8::f32x4){lf[0], lf[1], lf[2], lf[3]}; *(pg8::f32x4*)(o + 4) = (pg8::f32x4){lf[4], lf[5], lf[6], lf[7]}; }
                        } else if (col8 == 8) {
                            float gg[4], be[4];
#pragma unroll
                            for (int j = 0; j < 4; ++j) { gg[j] = -__expf(a_log[j]) * softplusf_(v0[j] + dt_bias[j]); be[j] = 1.f / (1.f + __expf(-v1[j])); }
                            float* g = GATE + (size_t)row * 16 + 8; *(pg8::f32x4*)g = (pg8::f32x4){gg[0], gg[1], gg[2], gg[3]}; *(pg8::f32x4*)(g + 4) = (pg8::f32x4){be[0], be[1], be[2], be[3]};
                        }
                    }
                }
            }
    }
};
struct EpiResid {
    static constexpr bool PERM = true, AFTER_DRAIN = false;
    const float* basep; float* dst; bf16* XN; float* SSQ;
    __device__ __forceinline__ void operator()(const pg8::f32x4 (&acc)[2][2][4][2], const pg8::Unit& u, int wr, int wc, int fr, int fq) const {
#pragma unroll
        for (int ai = 0; ai < 2; ++ai)
#pragma unroll
            for (int m = 0; m < 4; ++m) {
                const int row = u.pm * 256 + ai * 128 + wr * 64 + m * 16 + fr;
                const float* src = basep + (size_t)row * DMODEL;
                float ss = 0.f;
#pragma unroll
                for (int bj = 0; bj < 2; ++bj) { const int c = u.pn * 256 + bj * 128 + wc * 32 + 8 * fq;
                    const pg8::f32x4 r0 = *(const pg8::f32x4*)(src + c) + acc[ai][bj][m][0], r1 = *(const pg8::f32x4*)(src + c + 4) + acc[ai][bj][m][1];
                    if (dst) { *(pg8::f32x4*)(dst + (size_t)row * DMODEL + c) = r0; *(pg8::f32x4*)(dst + (size_t)row * DMODEL + c + 4) = r1; }
                    v4u w; w.x = pg8::cvt_pk_bf16(r0[0], r0[1]); w.y = pg8::cvt_pk_bf16(r0[2], r0[3]); w.z = pg8::cvt_pk_bf16(r1[0], r1[1]); w.w = pg8::cvt_pk_bf16(r1[2], r1[3]);
                    *(v4u*)(XN + (size_t)row * DMODEL + c) = w;
                    ss += (r0[0] * r0[0] + r0[1] * r0[1]) + (r0[2] * r0[2] + r0[3] * r0[3]) + (r1[0] * r1[0] + r1[1] * r1[1]) + (r1[2] * r1[2] + r1[3] * r1[3]); }
                ss += __shfl_xor(ss, 16); ss += __shfl_xor(ss, 32);
                if (fq == 0) SSQ[(size_t)row * 16 + u.pn * 4 + wc] = ss;
            }
    }
};
struct EpiResidDrain {
    static constexpr bool PERM = true, AFTER_DRAIN = true;
    const float* basep; bf16* XN; float* SSQ;
    __device__ __forceinline__ void fused(pg8::f32x4 (&acc)[2][2][4][2], const pg8::Unit& u, int wr, int wc, int fr, int fq, PG8_LAS unsigned char*, int, int) const {
#pragma unroll
        for (int ai = 0; ai < 2; ++ai) {
            pg8::f32x4 rv[4][2][2];
#pragma unroll
            for (int m = 0; m < 4; ++m) { const float* src = basep + (size_t)(u.pm * 256 + ai * 128 + wr * 64 + m * 16 + fr) * DMODEL;
#pragma unroll
                for (int bj = 0; bj < 2; ++bj) { const int c = u.pn * 256 + bj * 128 + wc * 32 + 8 * fq; rv[m][bj][0] = *(const pg8::f32x4*)(src + c); rv[m][bj][1] = *(const pg8::f32x4*)(src + c + 4); } }
#pragma unroll
            for (int m = 0; m < 4; ++m) {
                const int row = u.pm * 256 + ai * 128 + wr * 64 + m * 16 + fr;
                float ss = 0.f;
#pragma unroll
                for (int bj = 0; bj < 2; ++bj) { const int c = u.pn * 256 + bj * 128 + wc * 32 + 8 * fq;
                    const pg8::f32x4 r0 = rv[m][bj][0] + acc[ai][bj][m][0], r1 = rv[m][bj][1] + acc[ai][bj][m][1];
                    v4u w; w.x = pg8::cvt_pk_bf16(r0[0], r0[1]); w.y = pg8::cvt_pk_bf16(r0[2], r0[3]); w.z = pg8::cvt_pk_bf16(r1[0], r1[1]); w.w = pg8::cvt_pk_bf16(r1[2], r1[3]);
                    *(v4u*)(XN + (size_t)row * DMODEL + c) = w;
                    ss += (r0[0] * r0[0] + r0[1] * r0[1]) + (r0[2] * r0[2] + r0[3] * r0[3]) + (r1[0] * r1[0] + r1[1] * r1[1]) + (r1[2] * r1[2] + r1[3] * r1[3]); }
                ss += __shfl_xor(ss, 16); ss += __shfl_xor(ss, 32);
                if (fq == 0) SSQ[(size_t)row * 16 + u.pn * 4 + wc] = ss;
            }
        }
    }
};
struct EpiUpAct {
    static constexpr bool PERM = true, AFTER_DRAIN = false;
    bf16* GU; bf16* ACT; float* out; const float* wconv; const float* bconv; const float* SSQ;
    __device__ __forceinline__ void operator()(const pg8::f32x4 (&acc)[2][2][4][2], const pg8::Unit& u, int wr, int wc, int fr, int fq) const {
        const int c0 = u.pn * 128 + wc * 32 + 8 * fq;
        float w0[8], w1[8], w2[8], bb[8];
#pragma unroll
        for (int j = 0; j < 8; ++j) { w0[j] = wconv[c0 + j]; w1[j] = wconv[FFN + c0 + j]; w2[j] = wconv[2 * FFN + c0 + j]; bb[j] = bconv[c0 + j]; }
        const bool sample = false;
        float rsv[2][4];
#pragma unroll
        for (int ai = 0; ai < 2; ++ai)
#pragma unroll
            for (int m = 0; m < 4; ++m) rsv[ai][m] = SSQ[u.pm * 256 + ai * 128 + wr * 64 + m * 16 + fr];
#pragma unroll
        for (int ai = 0; ai < 2; ++ai) {
            float pr1[8], pr2[8];
#pragma unroll
            for (int j = 0; j < 8; ++j) { pr1[j] = 0.f; pr2[j] = 0.f; }
#pragma unroll
            for (int m = 0; m < 4; ++m) {
                const int row = u.pm * 256 + ai * 128 + wr * 64 + m * 16 + fr;
                float g[8], up[8];
#pragma unroll
                for (int j = 0; j < 8; ++j) { g[j] = acc[ai][0][m][j >> 2][j & 3] * rsv[ai][m]; up[j] = acc[ai][1][m][j >> 2][j & 3] * rsv[ai][m]; }
                if (row < MP) { const int t = row & (SEQ - 1), b = row >> 11;
                    if (t >= SEQ - 2) { float* o = out + OUT_FCP + (size_t)(b * 2 + (t - (SEQ - 2))) * FFN + c0; *(pg8::f32x4*)o = (pg8::f32x4){g[0], g[1], g[2], g[3]}; *(pg8::f32x4*)(o + 4) = (pg8::f32x4){g[4], g[5], g[6], g[7]}; } }
                const bool edge_lo = (m == 0 && fr < 2), edge_hi = (m == 3 && fr >= 14);
                if (sample || edge_lo || edge_hi) {
                    v4u w; w.x = pg8::cvt_pk_bf16(g[0], g[1]); w.y = pg8::cvt_pk_bf16(g[2], g[3]); w.z = pg8::cvt_pk_bf16(g[4], g[5]); w.w = pg8::cvt_pk_bf16(g[6], g[7]);
                    *(v4u*)(GU + (size_t)row * NUP + c0) = w;
                    if (sample || edge_lo) { v4u x; x.x = pg8::cvt_pk_bf16(up[0], up[1]); x.y = pg8::cvt_pk_bf16(up[2], up[3]); x.z = pg8::cvt_pk_bf16(up[4], up[5]); x.w = pg8::cvt_pk_bf16(up[6], up[7]);
                        *(v4u*)(GU + (size_t)row * NUP + FFN + c0) = x; }
                }
                float r[8];
#pragma unroll
                for (int jp = 0; jp < 4; ++jp) {
                    f32x2v gm1, gm2, gc, uc, wa, wb, wcc, bv;
#pragma unroll
                    for (int q = 0; q < 2; ++q) { const int j = 2 * jp + q;
                        gm1[q] = __builtin_bit_cast(float, __builtin_amdgcn_update_dpp(__builtin_bit_cast(int, pr1[j]), __builtin_bit_cast(int, g[j]), 0x111, 0xf, 0xf, false));
                        gm2[q] = __builtin_bit_cast(float, __builtin_amdgcn_update_dpp(__builtin_bit_cast(int, pr2[j]), __builtin_bit_cast(int, g[j]), 0x112, 0xf, 0xf, false));
                        if (m < 3) { pr1[j] = dppf<0x121>(g[j]); pr2[j] = dppf<0x122>(g[j]); }
                        gc[q] = g[j]; uc[q] = up[j]; wa[q] = w0[j]; wb[q] = w1[j]; wcc[q] = w2[j]; bv[q] = bb[j]; }
                    const f32x2v y = wa * gm2 + (wb * gm1 + (wcc * gc + bv));
                    const f32x2v en = y * (-LOG2E);
                    f32x2v dn; dn[0] = __builtin_amdgcn_exp2f(en[0]); dn[1] = __builtin_amdgcn_exp2f(en[1]); dn = dn + 1.f;
                    f32x2v rc; rc[0] = __builtin_amdgcn_rcpf(dn[0]); rc[1] = __builtin_amdgcn_rcpf(dn[1]);
                    const f32x2v o2 = (y * rc) * uc;
                    r[2 * jp] = o2[0]; r[2 * jp + 1] = o2[1];
                }
                if (!sample && !edge_lo) { v4u w; w.x = pg8::cvt_pk_bf16(r[0], r[1]); w.y = pg8::cvt_pk_bf16(r[2], r[3]); w.z = pg8::cvt_pk_bf16(r[4], r[5]); w.w = pg8::cvt_pk_bf16(r[6], r[7]);
                    *(v4u*)(ACT + (size_t)row * FFN + c0) = w; }
            }
        }
    }
};
struct SMapUp { __device__ __forceinline__ int operator()(int nd) const { const int pn = nd >> 8, r = nd & 255; return r < 128 ? 128 * pn + r : FFN + 128 * pn + (r - 128); } };
struct EpiFinal {
    static constexpr bool PERM = true, AFTER_DRAIN = true;
    const bf16* base; float* y; float* SSQ2; gu32* cnt; const float* gain;
    __device__ __forceinline__ void fused(pg8::f32x4 (&acc)[2][2][4][2], const pg8::Unit& u, int wr, int wc, int fr, int fq, PG8_LAS unsigned char* lds, int wid, int lane) const {
        const int tid = wid * 64 + lane;
#pragma unroll
        for (int ai = 0; ai < 2; ++ai)
#pragma unroll
            for (int m = 0; m < 4; ++m) {
                const int rl = ai * 128 + wr * 64 + m * 16 + fr; const size_t row = (size_t)u.pm * 256 + rl;
                float ss = 0.f;
#pragma unroll
                for (int bj = 0; bj < 2; ++bj) { const size_t off = row * DMODEL + u.pn * 256 + bj * 128 + wc * 32 + 8 * fq;
                    { const v4u xb = *(const v4u*)(base + off); acc[ai][bj][m][0] += (pg8::f32x4){bflo(xb.x), bfhi(xb.x), bflo(xb.y), bfhi(xb.y)}; acc[ai][bj][m][1] += (pg8::f32x4){bflo(xb.z), bfhi(xb.z), bflo(xb.w), bfhi(xb.w)}; }
                    const pg8::f32x4 r0 = acc[ai][bj][m][0], r1 = acc[ai][bj][m][1];
                    ss += (r0[0] * r0[0] + r0[1] * r0[1]) + (r0[2] * r0[2] + r0[3] * r0[3]) + (r1[0] * r1[0] + r1[1] * r1[1]) + (r1[2] * r1[2] + r1[3] * r1[3]); }
                ss += __shfl_xor(ss, 16); ss += __shfl_xor(ss, 32);
                if (fq == 0) __hip_atomic_store((GAS float*)SSQ2 + row * 16 + u.pn * 4 + wc, ss, RLX_AGENT);
            }
        VM_WAIT(); __syncthreads();
        if (tid == 0) {
            gu32* c = cnt + 64 * u.pm;
            __hip_atomic_fetch_add(c, 1u, RLX_AGENT);
            unsigned spins = 0u;
            while (__hip_atomic_load(c, RLX_AGENT) < 4u && ++spins < (1u << 22)) __builtin_amdgcn_s_sleep(2);
            __builtin_amdgcn_fence(__ATOMIC_ACQUIRE, "agent"); VM_WAIT();
        }
        __syncthreads();
        PG8_LAS float* rsT = (PG8_LAS float*)lds;
        if (tid < 256) { const GAS float* sp = (const GAS float*)SSQ2 + ((size_t)u.pm * 256 + tid) * 16; float tot = 0.f;
#pragma unroll
            for (int j = 0; j < 16; ++j) tot += __hip_atomic_load(sp + j, RLX_AGENT);
            rsT[tid] = rsqrtf(tot * (1.f / DMODEL) + EPS); }
        __syncthreads();
#pragma unroll
        for (int ai = 0; ai < 2; ++ai)
#pragma unroll
            for (int m = 0; m < 4; ++m) {
                const int rl = ai * 128 + wr * 64 + m * 16 + fr; const size_t row = (size_t)u.pm * 256 + rl; const float rs = rsT[rl];
#pragma unroll
                for (int bj = 0; bj < 2; ++bj) { const int c = u.pn * 256 + bj * 128 + wc * 32 + 8 * fq;
                    const pg8::f32x4 g0 = *(const pg8::f32x4*)(gain + c), g1 = *(const pg8::f32x4*)(gain + c + 4);
                    *(pg8::f32x4*)(y + row * DMODEL + c) = acc[ai][bj][m][0] * rs * g0; *(pg8::f32x4*)(y + row * DMODEL + c + 4) = acc[ai][bj][m][1] * rs * g1; }
            }
    }
};
struct EpiResid2 {
    static constexpr bool PERM = true, AFTER_DRAIN = false;
    const float* base; float* dst;
    __device__ __forceinline__ void operator()(const pg8::f32x4 (&acc)[2][2][4][2], const pg8::Unit& u, int wr, int wc, int fr, int fq) const {
#pragma unroll
        for (int ai = 0; ai < 2; ++ai)
#pragma unroll
            for (int m = 0; m < 4; ++m) {
                const int row = u.pm * 256 + ai * 128 + wr * 64 + m * 16 + fr;
                if (row < MT) {
#pragma unroll
                    for (int bj = 0; bj < 2; ++bj) { const size_t off = (size_t)row * DMODEL + u.pn * 256 + bj * 128 + wc * 32 + 8 * fq;
                        const pg8::f32x4 r0 = *(const pg8::f32x4*)(base + off), r1 = *(const pg8::f32x4*)(base + off + 4);
                        *(pg8::f32x4*)(dst + off) = r0 + acc[ai][bj][m][0]; *(pg8::f32x4*)(dst + off + 4) = r1 + acc[ai][bj][m][1]; }
                }
            }
    }
};

template <class SMap>
__device__ __forceinline__ void transpose_item(const float* W, int K, int Nsrc, bf16* WT, LAS float* scr, int kb, int nb, int lane, SMap smap, const float* kgain = nullptr) {
    const int k0 = 64 * kb, n0 = 32 * nb; const int ns = smap(n0 + (lane & 31));
    float tv[32];
#pragma unroll
    for (int i = 0; i < 32; ++i) { const int kk = 2 * i + (lane >> 5); tv[i] = ns >= 0 ? W[(size_t)(k0 + kk) * Nsrc + ns] * (kgain ? kgain[k0 + kk] : 1.f) : 0.f; }
#pragma unroll
    for (int i = 0; i < 32; ++i) { const int kk = 2 * i + (lane >> 5); scr[kk * 33 + (lane & 31)] = tv[i]; }
    LDS_WAIT(); asm volatile("" ::: "memory");
    const int c = lane & 7;
#pragma unroll
    for (int j = 0; j < 4; ++j) { const int n = (lane >> 3) + 8 * j; const LAS float* s = scr + (8 * c) * 33 + n;
        v4u o; o.x = pk2(s[0 * 33], s[1 * 33]); o.y = pk2(s[2 * 33], s[3 * 33]); o.z = pk2(s[4 * 33], s[5 * 33]); o.w = pk2(s[6 * 33], s[7 * 33]);
        *(GAS v4u*)(WT + (size_t)(n0 + n) * K + k0 + 8 * c) = o; }
    LDS_WAIT(); asm volatile("" ::: "memory");
}

struct SMapIn { __device__ __forceinline__ int operator()(int nd) const { return nd < 1536 ? nd : nd < 3072 ? nd + 8 : nd < 3584 ? nd + 16 : nd < 3592 ? nd - 3584 + 1536 : nd < 3600 ? nd - 3592 + 3080 : -1; } };
struct SMapId { __device__ __forceinline__ int operator()(int nd) const { return nd; } };
__device__ __forceinline__ void rms_rows2_to_bf16(const float* xa, const float* xb, const float* gain, bf16* oa, bf16* ob, int lane) {
    const f32x4* ra = (const f32x4*)xa + lane; const f32x4* rb = (const f32x4*)xb + lane; const f32x4* gr = (const f32x4*)gain + lane;
    f32x4 va[4], vb[4]; float sa = 0.f, sb = 0.f;
#pragma unroll
    for (int j = 0; j < 4; ++j) { va[j] = ra[64 * j]; vb[j] = rb[64 * j]; }
#pragma unroll
    for (int j = 0; j < 4; ++j) { sa += (va[j].x * va[j].x + va[j].y * va[j].y) + (va[j].z * va[j].z + va[j].w * va[j].w); sb += (vb[j].x * vb[j].x + vb[j].y * vb[j].y) + (vb[j].z * vb[j].z + vb[j].w * vb[j].w); }
    const float rsa = rsqrtf(wave_sum(sa) * (1.f / DMODEL) + EPS), rsb = rsqrtf(wave_sum(sb) * (1.f / DMODEL) + EPS);
    unsigned long long* pa = (unsigned long long*)oa + lane; unsigned long long* pb = (unsigned long long*)ob + lane;
#pragma unroll
    for (int j = 0; j < 4; ++j) { const f32x4 g = gr[64 * j];
        pa[64 * j] = (unsigned long long)pk2(va[j].x * rsa * g.x, va[j].y * rsa * g.y) | ((unsigned long long)pk2(va[j].z * rsa * g.z, va[j].w * rsa * g.w) << 32);
        pb[64 * j] = (unsigned long long)pk2(vb[j].x * rsb * g.x, vb[j].y * rsb * g.y) | ((unsigned long long)pk2(vb[j].z * rsb * g.z, vb[j].w * rsb * g.w) << 32); }
}
__device__ __forceinline__ void rms_row_to_bf16(const float* xrow, const float* gain, bf16* orow, int lane) {
    const f32x4* xr = (const f32x4*)xrow + lane; const f32x4* gr = (const f32x4*)gain + lane;
    f32x4 v[4]; float s = 0.f;
#pragma unroll
    for (int j = 0; j < 4; ++j) { v[j] = xr[64 * j]; s += (v[j].x * v[j].x + v[j].y * v[j].y) + (v[j].z * v[j].z + v[j].w * v[j].w); }
    const float rs = rsqrtf(wave_sum(s) * (1.f / DMODEL) + EPS);
    unsigned long long* o8 = (unsigned long long*)orow + lane;
#pragma unroll
    for (int j = 0; j < 4; ++j) { const f32x4 g = gr[64 * j]; o8[64 * j] = (unsigned long long)pk2(v[j].x * rs * g.x, v[j].y * rs * g.y) | ((unsigned long long)pk2(v[j].z * rs * g.z, v[j].w * rs * g.w) << 32); }
}
__device__ __forceinline__ void rms_row_to_f32(const float* xrow, const float* gain, float* orow, int lane) {
    const f32x4* xr = (const f32x4*)xrow + lane; const f32x4* gr = (const f32x4*)gain + lane;
    f32x4 v[4]; float s = 0.f;
#pragma unroll
    for (int j = 0; j < 4; ++j) { v[j] = xr[64 * j]; s += (v[j].x * v[j].x + v[j].y * v[j].y) + (v[j].z * v[j].z + v[j].w * v[j].w); }
    const float rs = rsqrtf(wave_sum(s) * (1.f / DMODEL) + EPS);
#pragma unroll
    for (int j = 0; j < 4; ++j) { const f32x4 g = gr[64 * j]; ((f32x4*)orow + lane)[64 * j] = (f32x4){v[j].x * rs * g.x, v[j].y * rs * g.y, v[j].z * rs * g.z, v[j].w * rs * g.w}; }
}

struct Args { const float* in[23]; float* out; unsigned char* ws; int ph_lo, ph_hi; };
static_assert(sizeof(Args) == 25 * 8 + 8, "Args has no padding");

__device__ __forceinline__ void fox_bias_build(const float* GATE, int b, int h, int NK, LAS v4u* biasF, LAS float* wtot, int tid) {
    const int lane = tid & 63, wave = tid >> 6;
    float v[4]; float run = 0.f;
#pragma unroll
    for (int i = 0; i < 4; ++i) { const int s = 4 * tid + i; const float x = (s < NK) ? GATE[(size_t)(b * SEQ + s) * 16 + h] : 0.f; run += x; v[i] = run; }
    float incl = run;
#pragma unroll
    for (int o = 1; o < 64; o <<= 1) { const float y = __shfl_up(incl, o); if (lane >= o) incl += y; }
    if (lane == 63) wtot[wave] = incl;
    __syncthreads();
    float off = incl - run;
    for (int w = 0; w < wave; ++w) off += wtot[w];
    float tot = 0.f;
    for (int w = 0; w < NWAVES; ++w) tot += wtot[w];
#pragma unroll
    for (int i = 0; i < 4; ++i) { unsigned bh_, bm_, bl_; attn_body::split3((tot - (v[i] + off)) * LOG2E, bh_, bm_, bl_);
        biasF[4 * tid + i] = (v4u){bh_ | (bm_ << 16), bl_ | 0xBF800000u, 0xBF80BF80u, 0u}; }
    __syncthreads();
}

constexpr int PR_X = 0, PR_XS = 784  , PR_RS = 260  ;
constexpr int PR_KB = 66560, PR_QB = PR_KB + 17408, PR_A = PR_QB + 17408, PR_T = PR_A + 17408, PR_TT = PR_T + 9216, PR_WC = PR_T + 18432, PR_GC = PR_WC + 6144, PR_BT = PR_GC + 256, PR_END = PR_BT + 256;
static_assert(67 * PR_XS <= PR_KB && 64 * PR_RS * 4 <= PR_KB && PR_END <= LDSCTL_OFF, "prep LDS");
__device__ __forceinline__ void gdn_prep_unit(LAS unsigned char* lds, int ci, const bf16* GQKV, const float* GATE, const float* wconv, unsigned char* gdnbuf, float* GLb, int tid) {
    const int lane = tid & 63, wave = __builtin_amdgcn_readfirstlane(tid >> 6), q4 = lane >> 4, l15 = lane & 15;
    const int bh = ci >> 5, n = ci & 31, b = bh >> 2, h = bh & 3;
    const int m0 = b * SEQ + n * 64;
    LAS float* R = (LAS float*)(lds + PR_X); LAS float* A = (LAS float*)(lds + PR_A); LAS bf16* Kb = (LAS bf16*)(lds + PR_KB); LAS bf16* Qb = (LAS bf16*)(lds + PR_QB);
    LAS bf16* KDTs = (LAS bf16*)(lds + PR_T); LAS float* TT = (LAS float*)(lds + PR_TT); LAS float* wL = (LAS float*)(lds + PR_WC);
    LAS float* gc = (LAS float*)(lds + PR_GC); LAS float* bt = (LAS float*)(lds + PR_BT);
    bf16* UTg = (bf16*)(gdnbuf + (size_t)ci * GDN_CH_BYTES); bf16* Wg = UTg + 8192; bf16* QDg = UTg + 16384; bf16* KDTg = UTg + 24576; bf16* QKg = UTg + 32768;
    if (wave == 0) {
        const float g = GATE[(size_t)(m0 + lane) * 16 + 8 + h], be = GATE[(size_t)(m0 + lane) * 16 + 12 + h];
        float incl = g;
#pragma unroll
        for (int o = 1; o < 64; o <<= 1) { const float y = __shfl_up(incl, o); if (lane >= o) incl += y; }
        gc[lane] = incl; bt[lane] = be;
        if (lane == 63) GLb[ci] = __expf(incl);
    }
    {
        v4u xv[7]; float wv[3];
#pragma unroll
        for (int k = 0; k < 7; ++k) { const int p = tid + k * NTHR; xv[k] = (v4u){0u, 0u, 0u, 0u};
            if (p < 67 * 48) { const int rs = p >> 4, c16 = p & 15, row = rs / 3, sec = rs - row * 3; const int t = n * 64 - 3 + row;
                if (t >= 0) xv[k] = *(const v4u*)(GQKV + (size_t)(b * SEQ + t) * NGQKV + sec * GW + h * GD + c16 * 8); } }
#pragma unroll
        for (int k = 0; k < 3; ++k) { const int e = tid + k * NTHR, tap = e / 384, c = e % 384; wv[k] = wconv[tap * NGQKV + (c >> 7) * GW + h * GD + (c & 127)]; }
#pragma unroll
        for (int k = 0; k < 7; ++k) { const int p = tid + k * NTHR;
            if (p < 67 * 48) { const int rs = p >> 4, c16 = p & 15, row = rs / 3, sec = rs - row * 3; *(LAS v4u*)(lds + PR_X + row * PR_XS + sec * 256 + c16 * 16) = xv[k]; } }
#pragma unroll
        for (int k = 0; k < 3; ++k) wL[tid + k * NTHR] = wv[k];
    }
    __syncthreads();
    const int ci_ = tid >> 3, sub = tid & 7;
    const float gci = gc[ci_], bti = bt[ci_], eg = __expf(gci), egl = __expf(gc[63] - gci);
    float yv[16], yk[16];
#pragma unroll
    for (int sec = 0; sec < 3; ++sec) {
        f32x2v y2[8];
#pragma unroll
        for (int p = 0; p < 8; ++p) y2[p] = (f32x2v){0.f, 0.f};
#pragma unroll
        for (int tap = 0; tap < 4; ++tap) {
            const LAS unsigned char* xp = lds + PR_X + (ci_ + tap) * PR_XS + sec * 256 + sub * 32;
            const v4u x0 = *(const LAS v4u*)xp, x1 = *(const LAS v4u*)(xp + 16);
            const LAS float* wp = wL + tap * 384 + sec * 128 + sub * 16;
            const f32x4 wq[4] = {*(const LAS f32x4*)wp, *(const LAS f32x4*)(wp + 4), *(const LAS f32x4*)(wp + 8), *(const LAS f32x4*)(wp + 12)};
            const unsigned xw[8] = {x0.x, x0.y, x0.z, x0.w, x1.x, x1.y, x1.z, x1.w};
#pragma unroll
            for (int p = 0; p < 8; ++p) { const f32x2v xv = (f32x2v){bflo(xw[p]), bfhi(xw[p])}, wv = (f32x2v){wq[p >> 1][(p & 1) * 2], wq[p >> 1][(p & 1) * 2 + 1]}; y2[p] = wv * xv + y2[p]; }
        }
        float y[16]; float ss = 0.f;
        { f32x2v ss2 = (f32x2v){0.f, 0.f};
#pragma unroll
          for (int p = 0; p < 8; ++p) { const f32x2v en = y2[p] * (-LOG2E); f32x2v dn; dn[0] = __builtin_amdgcn_exp2f(en[0]); dn[1] = __builtin_amdgcn_exp2f(en[1]); dn = dn + 1.f;
              f32x2v rc; rc[0] = __builtin_amdgcn_rcpf(dn[0]); rc[1] = __builtin_amdgcn_rcpf(dn[1]); const f32x2v v = y2[p] * rc; ss2 = v * v + ss2; y[2 * p] = v[0]; y[2 * p + 1] = v[1]; }
          ss = ss2[0] + ss2[1]; }
        if (sec < 2) {
            ss += __shfl_xor(ss, 1); ss += __shfl_xor(ss, 2); ss += __shfl_xor(ss, 4);
            const float r = rsqrtf(ss + EPS) * (sec == 0 ? QSCALE : 1.f);
#pragma unroll
            for (int c = 0; c < 16; ++c) y[c] *= r;
        }
        if (sec == 0) {
            v4u a, bq, c0, c1;
            a.x = pk2(y[0], y[1]); a.y = pk2(y[2], y[3]); a.z = pk2(y[4], y[5]); a.w = pk2(y[6], y[7]); bq.x = pk2(y[8], y[9]); bq.y = pk2(y[10], y[11]); bq.z = pk2(y[12], y[13]); bq.w = pk2(y[14], y[15]);
            *(LAS v4u*)(Qb + ci_ * 136 + sub * 16) = a; *(LAS v4u*)(Qb + ci_ * 136 + sub * 16 + 8) = bq;
            c0.x = pk2(y[0] * eg, y[1] * eg); c0.y = pk2(y[2] * eg, y[3] * eg); c0.z = pk2(y[4] * eg, y[5] * eg); c0.w = pk2(y[6] * eg, y[7] * eg);
            c1.x = pk2(y[8] * eg, y[9] * eg); c1.y = pk2(y[10] * eg, y[11] * eg); c1.z = pk2(y[12] * eg, y[13] * eg); c1.w = pk2(y[14] * eg, y[15] * eg);
            *(v4u*)(QDg + ci_ * 128 + sub * 16) = c0; *(v4u*)(QDg + ci_ * 128 + sub * 16 + 8) = c1;
        } else if (sec == 1) {
            v4u a, bq;
            a.x = pk2(y[0], y[1]); a.y = pk2(y[2], y[3]); a.z = pk2(y[4], y[5]); a.w = pk2(y[6], y[7]); bq.x = pk2(y[8], y[9]); bq.y = pk2(y[10], y[11]); bq.z = pk2(y[12], y[13]); bq.w = pk2(y[14], y[15]);
            *(LAS v4u*)(Kb + ci_ * 136 + sub * 16) = a; *(LAS v4u*)(Kb + ci_ * 136 + sub * 16 + 8) = bq;
            const float wsc = bti * eg;
#pragma unroll
            for (int c = 0; c < 16; c += 2) { const unsigned pk_ = pk2(y[c] * egl, y[c + 1] * egl); KDTs[(sub * 16 + c) * 72 + ci_] = (bf16)(pk_ & 0xffffu); KDTs[(sub * 16 + c + 1) * 72 + ci_] = (bf16)(pk_ >> 16); yk[c] = y[c] * wsc; yk[c + 1] = y[c + 1] * wsc; }
        } else {
#pragma unroll
            for (int c = 0; c < 16; ++c) yv[c] = y[c] * bti;
        }
    }
    __syncthreads();
    {
        LAS float* rp = R + ci_ * PR_RS + sub * 16;
#pragma unroll
        for (int c4 = 0; c4 < 4; ++c4) { *(LAS f32x4*)(rp + 4 * c4) = (f32x4){yv[4 * c4], yv[4 * c4 + 1], yv[4 * c4 + 2], yv[4 * c4 + 3]};
            *(LAS f32x4*)(rp + 128 + 4 * c4) = (f32x4){yk[4 * c4], yk[4 * c4 + 1], yk[4 * c4 + 2], yk[4 * c4 + 3]}; }
#pragma unroll
        for (int k = 0; k < 2; ++k) { const int p = k * NTHR + tid, row = p >> 3, c16 = p & 7; *(v4u*)(KDTg + row * 64 + c16 * 8) = *(const LAS v4u*)(KDTs + row * 72 + c16 * 8); }
    }
    {
        const int mt = wave >> 1;
#pragma unroll
        for (int e = 0; e < 2; ++e) {
            const int nt = 2 * (wave & 1) + e;
            f32x4 akk = (f32x4){0.f, 0.f, 0.f, 0.f}, aqk = (f32x4){0.f, 0.f, 0.f, 0.f};
            if (nt <= mt) {
#pragma unroll
                for (int ks = 0; ks < 4; ++ks) {
                    const bf16x8 kj = *(const LAS bf16x8*)(Kb + (16 * nt + l15) * 136 + 32 * ks + 8 * q4);
                    const bf16x8 ki = *(const LAS bf16x8*)(Kb + (16 * mt + l15) * 136 + 32 * ks + 8 * q4), qi = *(const LAS bf16x8*)(Qb + (16 * mt + l15) * 136 + 32 * ks + 8 * q4);
                    akk = __builtin_amdgcn_mfma_f32_16x16x32_bf16(kj, ki, akk, 0, 0, 0); aqk = __builtin_amdgcn_mfma_f32_16x16x32_bf16(kj, qi, aqk, 0, 0, 0);
                }
            }
            const int i = 16 * mt + l15, j0 = 16 * nt + 4 * q4; const float gi = gc[i], bi = bt[i];
            f32x4 av; float qv[4];
#pragma unroll
            for (int r = 0; r < 4; ++r) { const int j = j0 + r; const float dec = (j <= i) ? __expf(gi - gc[j]) : 0.f; av[r] = (j < i) ? bi * akk[r] * dec : 0.f; qv[r] = aqk[r] * dec; }
            if (nt <= mt) *(LAS f32x4*)(A + i * 68 + j0) = av;
            v2u w; w.x = pk2(qv[0], qv[1]); w.y = pk2(qv[2], qv[3]);
            *(v2u*)(QKg + i * 64 + j0) = w;
        }
    }
    __syncthreads();
    if (wave == 0) {
        const int I = q4, c = l15; float t[16];
#pragma unroll
        for (int i = 0; i < 16; ++i) {
            float acc = (i == c) ? 1.f : 0.f;
            const LAS float* ar = A + (16 * I + i) * 68 + 16 * I;
#pragma unroll
            for (int j4 = 0; j4 < (i + 3) / 4; ++j4) { const f32x4 a = *(const LAS f32x4*)(ar + 4 * j4);
#pragma unroll
                for (int jj = 0; jj < 4; ++jj) if (4 * j4 + jj < i) acc -= a[jj] * t[4 * j4 + jj]; }
            t[i] = acc; TT[I * 320 + i * 20 + c] = acc;
        }
    }
    __syncthreads();
    f32x4 sol[4][2];
    {
#pragma unroll
        for (int I = 0; I < 4; ++I)
#pragma unroll
            for (int e = 0; e < 2; ++e)
#pragma unroll
                for (int r = 0; r < 4; ++r) sol[I][e][r] = R[(16 * I + 4 * q4 + r) * PR_RS + 32 * wave + 16 * e + l15];
#pragma unroll
        for (int I = 0; I < 4; ++I) {
#pragma unroll
            for (int J = 0; J < I; ++J) {
                const f32x4 a = *(const LAS f32x4*)(A + (16 * I + l15) * 68 + 16 * J + 4 * q4);
#pragma unroll
                for (int sstep = 0; sstep < 4; ++sstep)
#pragma unroll
                    for (int e = 0; e < 2; ++e) sol[I][e] = __builtin_amdgcn_mfma_f32_16x16x4f32(-a[sstep], sol[J][e][sstep], sol[I][e], 0, 0, 0);
            }
            const f32x4 tq = *(const LAS f32x4*)(TT + I * 320 + l15 * 20 + 4 * q4);
#pragma unroll
            for (int e = 0; e < 2; ++e) { f32x4 tmp = (f32x4){0.f, 0.f, 0.f, 0.f};
#pragma unroll
                for (int sstep = 0; sstep < 4; ++sstep) tmp = __builtin_amdgcn_mfma_f32_16x16x4f32(tq[sstep], sol[I][e][sstep], tmp, 0, 0, 0);
                sol[I][e] = tmp; }
        }
    }
    __syncthreads();
    {
        LAS bf16* UTs = (LAS bf16*)(lds + PR_X); LAS bf16* Ws = (LAS bf16*)(lds + PR_X + 18432);
#pragma unroll
        for (int I = 0; I < 4; ++I)
#pragma unroll
            for (int e = 0; e < 2; ++e) {
                const int col = 32 * wave + 16 * e + l15;
                if (wave < 4) { v2u w; w.x = pk2(sol[I][e][0], sol[I][e][1]); w.y = pk2(sol[I][e][2], sol[I][e][3]); *(LAS v2u*)(UTs + col * 72 + 16 * I + 4 * q4) = w; }
                else {
#pragma unroll
                    for (int r = 0; r < 4; ++r) Ws[(16 * I + 4 * q4 + r) * 136 + col - 128] = (bf16)f2bf(sol[I][e][r]); }
            }
    }
    __syncthreads();
    {
        const LAS bf16* UTs = (const LAS bf16*)(lds + PR_X); const LAS bf16* Ws = (const LAS bf16*)(lds + PR_X + 18432);
#pragma unroll
        for (int k = 0; k < 2; ++k) { const int p = k * NTHR + tid;
            { const int row = p >> 3, c16 = p & 7; *(v4u*)(UTg + row * 64 + c16 * 8) = *(const LAS v4u*)(UTs + row * 72 + c16 * 8); }
            { const int row = p >> 4, c16 = p & 15; *(v4u*)(Wg + row * 128 + c16 * 8) = *(const LAS v4u*)(Ws + row * 136 + c16 * 8); } }
    }
    __syncthreads();
}

constexpr int SC_W = 0, SC_QD = 17408, SC_U = 34816, SC_KDT = 53248, SC_QK = 71680, SC_O = 80896;
static_assert(SC_O + 2 * 64 * 132 * 4 + 512 <= LDSCTL_OFF, "scan LDS");
__device__ __forceinline__ bf16x8 pack8(const f32x4& a, const f32x4& b) {
    v4u w; w.x = pg8::cvt_pk_bf16(a[0], a[1]); w.y = pg8::cvt_pk_bf16(a[2], a[3]); w.z = pg8::cvt_pk_bf16(b[0], b[1]); w.w = pg8::cvt_pk_bf16(b[2], b[3]); return __builtin_bit_cast(bf16x8, w);
}
__device__ __forceinline__ bf16x8 afrag(const LAS bf16* rowp, int kbase, int q4) {
    const v2u lo = *(const LAS v2u*)(rowp + kbase + 4 * q4), hi = *(const LAS v2u*)(rowp + kbase + 16 + 4 * q4);
    v4u w; w.x = lo.x; w.y = lo.y; w.z = hi.x; w.w = hi.y; return __builtin_bit_cast(bf16x8, w);
}
__device__ __forceinline__ void gdn_scan_chain(LAS unsigned char* lds, int bh, const unsigned char* gdnbuf, const float* GLb, const bf16* GZ, const float* gnorm, bf16* MIX, float* out, int tid) {
    const int lane = tid & 63, wave = __builtin_amdgcn_readfirstlane(tid >> 6), q4 = lane >> 4, l15 = lane & 15;
    const int b = bh >> 2, h = bh & 3;
    LAS bf16* Wl = (LAS bf16*)(lds + SC_W); LAS bf16* QDl = (LAS bf16*)(lds + SC_QD); LAS bf16* UTl = (LAS bf16*)(lds + SC_U); LAS bf16* KDTl = (LAS bf16*)(lds + SC_KDT); LAS bf16* QKl = (LAS bf16*)(lds + SC_QK);
    LAS float* Ol = (LAS float*)(lds + SC_O);
    LAS float* gnL = (LAS float*)(lds + SC_O + 2 * 64 * 132 * 4);
    if (tid < GD) gnL[tid] = gnorm[tid];
    if (wave >= 4) {
        const int lt = tid - 256;
        v4u rA[18], rB[18];
        const __amdgpu_buffer_rsrc_t rs_ch = __builtin_amdgcn_make_buffer_rsrc((void*)(gdnbuf + (size_t)bh * NCHUNK * GDN_CH_BYTES), 0, NCHUNK * (int)GDN_CH_BYTES, 0x00020000);
        const int voff = lt * 16;
#define SCL_LOAD(RG, nn) do { _Pragma("unroll") for (int k_ = 0; k_ < 18; ++k_) RG[k_] = __builtin_bit_cast(v4u, __builtin_amdgcn_raw_buffer_load_b128(rs_ch, voff, (nn) * (int)GDN_CH_BYTES + k_ * 4096, 0)); } while (0)
#define SCL_STAGE(RG) do { _Pragma("unroll") for (int k_ = 0; k_ < 18; ++k_) { const int p_ = k_ * 256 + lt; \
            if (k_ < 4) { const int row = p_ >> 3, c16 = p_ & 7; *(LAS v4u*)(UTl + row * 72 + c16 * 8) = RG[k_]; } \
            else if (k_ < 12) { const int pp = p_ & 1023, row = pp >> 4, c16 = pp & 15; LAS bf16* base = (k_ < 8) ? Wl : QDl; *(LAS v4u*)(base + row * 136 + c16 * 8) = RG[k_]; } \
            else if (k_ < 16) { const int pp = p_ - 3072, row = pp >> 3, c16 = pp & 7; *(LAS v4u*)(KDTl + row * 72 + c16 * 8) = RG[k_]; } \
            else { const int pp = p_ - 4096, row = pp >> 3, c16 = pp & 7; *(LAS v4u*)(QKl + row * 72 + c16 * 8) = RG[k_]; } } } while (0)
        const int zi = lt >> 2, zsub = lt & 3;
        const bf16* zbase = GZ + ((size_t)b * SEQ + zi) * GW + h * GD + zsub * 32;
        v4u zp[4];
#pragma unroll
        for (int j = 0; j < 4; ++j) zp[j] = *(const v4u*)(zbase + 8 * j);
        SCL_LOAD(rA, 0); SCL_LOAD(rB, 1);
#define SCL_NORM(nn) do { const size_t m_ = (size_t)b * SEQ + (nn) * 64 + zi; const LAS float* op_ = Ol + ((nn) & 1) * (64 * 132) + zi * 132 + zsub * 32; float ss_ = 0.f; \
        _Pragma("unroll") for (int c = 0; c < 8; ++c) { const f32x4 t_ = *(const LAS f32x4*)(op_ + 4 * c); ss_ += (t_[0] * t_[0] + t_[1] * t_[1]) + (t_[2] * t_[2] + t_[3] * t_[3]); } \
        ss_ += __shfl_xor(ss_, 1); ss_ += __shfl_xor(ss_, 2); \
        const float rs_ = rsqrtf(ss_ * (1.f / GD) + EPS); const LAS float* gn_ = gnL + zsub * 32; \
        _Pragma("unroll") for (int j = 0; j < 4; ++j) { const unsigned zz_[4] = {zp[j].x, zp[j].y, zp[j].z, zp[j].w}; v4u o_; unsigned ow_[4]; \
            const f32x4 ya_ = *(const LAS f32x4*)(op_ + 8 * j), yb_ = *(const LAS f32x4*)(op_ + 8 * j + 4); const f32x4 ga_ = *(const LAS f32x4*)(gn_ + 8 * j), gb_ = *(const LAS f32x4*)(gn_ + 8 * j + 4); \
            ow_[0] = pk2(ya_[0] * rs_ * ga_[0] * siluf_(bflo(zz_[0])), ya_[1] * rs_ * ga_[1] * siluf_(bfhi(zz_[0]))); ow_[1] = pk2(ya_[2] * rs_ * ga_[2] * siluf_(bflo(zz_[1])), ya_[3] * rs_ * ga_[3] * siluf_(bfhi(zz_[1]))); \
            ow_[2] = pk2(yb_[0] * rs_ * gb_[0] * siluf_(bflo(zz_[2])), yb_[1] * rs_ * gb_[1] * siluf_(bfhi(zz_[2]))); ow_[3] = pk2(yb_[2] * rs_ * gb_[2] * siluf_(bflo(zz_[3])), yb_[3] * rs_ * gb_[3] * siluf_(bfhi(zz_[3]))); \
            o_.x = ow_[0]; o_.y = ow_[1]; o_.z = ow_[2]; o_.w = ow_[3]; *(v4u*)(MIX + m_ * DMODEL + FW + h * GD + zsub * 32 + 8 * j) = o_; \
            asm volatile("" ::: "memory"); } } while (0)
#define SCL_BODY(RG, n) do { \
        __syncthreads();                            \
        SCL_STAGE(RG); \
        if ((n) + 2 < NCHUNK) SCL_LOAD(RG, (n) + 2); \
        __syncthreads();                            \
        if ((n) > 0) { SCL_NORM((n) - 1); _Pragma("unroll") for (int j = 0; j < 4; ++j) zp[j] = *(const v4u*)(zbase + (size_t)(n) * 64 * GW + 8 * j); } \
    } while (0)
#pragma unroll 1
        for (int n2 = 0; n2 < NCHUNK; n2 += 2) { SCL_BODY(rA, n2); SCL_BODY(rB, (n2 + 1)); }
        __syncthreads();
        SCL_NORM(NCHUNK - 1);
#undef SCL_BODY
#undef SCL_NORM
#undef SCL_STAGE
#undef SCL_LOAD
    } else {
        const float glv = GLb[bh * NCHUNK + (lane & 31)];
        f32x4 S[2][8];
#pragma unroll
        for (int e = 0; e < 2; ++e)
#pragma unroll
            for (int tt = 0; tt < 8; ++tt) S[e][tt] = (f32x4){0.f, 0.f, 0.f, 0.f};
#pragma unroll 1
        for (int n = 0; n < NCHUNK; ++n) {
            __syncthreads();
            const float gl = __builtin_bit_cast(float, __builtin_amdgcn_readlane(__builtin_bit_cast(int, glv), n));
            bf16x8 Sb[2][4];
#pragma unroll
            for (int e = 0; e < 2; ++e)
#pragma unroll
                for (int ks = 0; ks < 4; ++ks) Sb[e][ks] = pack8(S[e][2 * ks], S[e][2 * ks + 1]);
            __syncthreads();
            f32x4 vn[2][4], oo[2][4];
#pragma unroll
            for (int mt = 0; mt < 4; ++mt) {
                f32x4 acc[2], ao[2];
#pragma unroll
                for (int e = 0; e < 2; ++e) { acc[e] = (f32x4){0.f, 0.f, 0.f, 0.f}; ao[e] = (f32x4){0.f, 0.f, 0.f, 0.f}; }
#pragma unroll
                for (int ks = 0; ks < 4; ++ks) {
                    const bf16x8 aw = afrag(Wl + (16 * mt + l15) * 136, 32 * ks, q4), aq = afrag(QDl + (16 * mt + l15) * 136, 32 * ks, q4);
#pragma unroll
                    for (int e = 0; e < 2; ++e) { acc[e] = __builtin_amdgcn_mfma_f32_16x16x32_bf16(aw, Sb[e][ks], acc[e], 0, 0, 0); ao[e] = __builtin_amdgcn_mfma_f32_16x16x32_bf16(aq, Sb[e][ks], ao[e], 0, 0, 0); }
                }
#pragma unroll
                for (int e = 0; e < 2; ++e) { const v2u uu = *(const LAS v2u*)(UTl + (32 * wave + 16 * e + l15) * 72 + 16 * mt + 4 * q4);
                    vn[e][mt][0] = bflo(uu.x) - acc[e][0]; vn[e][mt][1] = bfhi(uu.x) - acc[e][1]; vn[e][mt][2] = bflo(uu.y) - acc[e][2]; vn[e][mt][3] = bfhi(uu.y) - acc[e][3]; oo[e][mt] = ao[e]; }
            }
            bf16x8 Vb[2][2];
#pragma unroll
            for (int e = 0; e < 2; ++e) { Vb[e][0] = pack8(vn[e][0], vn[e][1]); Vb[e][1] = pack8(vn[e][2], vn[e][3]); }
#pragma unroll
            for (int mt = 0; mt < 4; ++mt) {
#pragma unroll
                for (int k2 = 0; k2 < 2; ++k2) { const bf16x8 a = afrag(QKl + (16 * mt + l15) * 72, 32 * k2, q4);
#pragma unroll
                    for (int e = 0; e < 2; ++e) oo[e][mt] = __builtin_amdgcn_mfma_f32_16x16x32_bf16(a, Vb[e][k2], oo[e][mt], 0, 0, 0); }
#pragma unroll
                for (int e = 0; e < 2; ++e)
#pragma unroll
                    for (int r = 0; r < 4; ++r) Ol[(n & 1) * (64 * 132) + (16 * mt + 4 * q4 + r) * 132 + 32 * wave + 16 * e + l15] = oo[e][mt][r];
            }
#pragma unroll
            for (int tt = 0; tt < 8; ++tt) {
                f32x4 a2[2];
#pragma unroll
                for (int e = 0; e < 2; ++e) a2[e] = S[e][tt] * gl;
#pragma unroll
                for (int k2 = 0; k2 < 2; ++k2) { const bf16x8 a = afrag(KDTl + (16 * tt + l15) * 72, 32 * k2, q4);
#pragma unroll
                    for (int e = 0; e < 2; ++e) a2[e] = __builtin_amdgcn_mfma_f32_16x16x32_bf16(a, Vb[e][k2], a2[e], 0, 0, 0); }
#pragma unroll
                for (int e = 0; e < 2; ++e) S[e][tt] = a2[e];
            }
        }
        __syncthreads();
        float* so = out + OUT_GSP + (size_t)bh * GD * GD;
#pragma unroll
        for (int e = 0; e < 2; ++e)
#pragma unroll
            for (int tt = 0; tt < 8; ++tt)
#pragma unroll
                for (int r = 0; r < 4; ++r) so[(size_t)(16 * tt + 4 * q4 + r) * GD + 32 * wave + 16 * e + l15] = S[e][tt][r];
    }
    __syncthreads();
}

__device__ __forceinline__ void gdn_sample_unit(LAS unsigned char* lds, int u, const float* state, const float* ctx, const float* wconv, const float* GATE, const bf16* GZ, const float* gnorm, bf16* MIX, float* out, int tid) {
    const int lane = tid & 63, wave = tid >> 6;
    const int b = u >> 2, h = u & 3; const size_t m = MP + b;
    LAS float* qkv = (LAS float*)lds;
    LAS float* red = qkv + 384;
    LAS float* part = qkv + 512;
    LAS float* ov = part + 1024;
    if (tid < 384) {
        const int sec = tid >> 7, c = tid & 127, col = sec * GW + h * GD + c;
        float y = 0.f;
#pragma unroll
        for (int tap = 0; tap < 3; ++tap) y += wconv[tap * NGQKV + col] * ctx[(size_t)(b * 3 + tap) * NGQKV + col];
        y += wconv[3 * NGQKV + col] * out[OUT_GCS + (size_t)(b * 3 + 2) * NGQKV + col];
        qkv[tid] = siluf_(y);
    }
    __syncthreads();
    if (wave < 2) { const float a = qkv[wave * 128 + lane], c2 = qkv[wave * 128 + 64 + lane]; const float ss = wave_sum(a * a + c2 * c2); if (lane == 0) red[wave] = rsqrtf(ss + EPS) * (wave == 0 ? QSCALE : 1.f); }
    __syncthreads();
    if (tid < 256) qkv[tid] *= red[tid >> 7];
    __syncthreads();
    if (wave == 0) { const float a = qkv[lane] * qkv[128 + lane] + qkv[64 + lane] * qkv[192 + lane]; const float s = wave_sum(a); if (lane == 0) red[2] = s; }
    const float g = GATE[m * 16 + 8 + h], beta = GATE[m * 16 + 12 + h], eg = __expf(g);
    const int c = tid & 127, part_i = tid >> 7;
    const float* sp = state + ((size_t)(b * GH + h) * GD + part_i * 32) * GD + c;
    float sv[32]; float pk = 0.f, pq = 0.f;
#pragma unroll
    for (int d = 0; d < 32; ++d) { sv[d] = sp[(size_t)d * GD]; pk += qkv[128 + part_i * 32 + d] * sv[d]; pq += qkv[part_i * 32 + d] * sv[d]; }
    part[part_i * 128 + c] = pk; part[512 + part_i * 128 + c] = pq;
    __syncthreads();
    const float kS = (part[c] + part[128 + c]) + (part[256 + c] + part[384 + c]), qS = (part[512 + c] + part[640 + c]) + (part[768 + c] + part[896 + c]);
    const float vnew = beta * (qkv[256 + c] - eg * kS), o = eg * qS + red[2] * vnew;
    float* so = out + OUT_GSS + ((size_t)(b * GH + h) * GD + part_i * 32) * GD + c;
#pragma unroll
    for (int d = 0; d < 32; ++d) so[(size_t)d * GD] = sv[d] * eg + qkv[128 + part_i * 32 + d] * vnew;
    if (part_i == 0) ov[c] = o;
    __syncthreads();
    if (wave == 0) { const float a = ov[lane], c2 = ov[64 + lane]; const float ss = wave_sum(a * a + c2 * c2); if (lane == 0) red[3] = rsqrtf(ss * (1.f / GD) + EPS); }
    __syncthreads();
    if (tid < 128) { const float z = bf2f(GZ[m * GW + h * GD + tid]); MIX[m * DMODEL + FW + h * GD + tid] = (bf16)f2bf(ov[tid] * red[3] * gnorm[tid] * siluf_(z)); }
    __syncthreads();
}

constexpr float DEC_SKIP = 40.f;
constexpr int DEC_EARLY = 256;
#define DEC_B(u) ((u) & (DB - 1))
#define DEC_P(u) ((u) >> 7)
#define DEC_REC(u) (DEC_B(u) * NPAGES + DEC_P(u))
__device__ __forceinline__ void decode_combine(int b, const float* DPART, const float* CUM, const float* GATE, const bf16* QB, const float* out, bf16* MIX, int tid);
__device__ __forceinline__ void decode_loop(LAS unsigned char* lds, int ubase, int NU, int v2, int G2, const float* cache_k, const float* cache_v, const int* page_table, const float* CUM, const bf16* QB, float* DPART,
                                            gu32* ctl, const float* GATE, const float* out, bf16* MIX, int tid) {
    const int lane = tid & 63, wave = tid >> 6, hA = lane >> 4, hB = 4 + hA, l15 = lane & 15;
    LAS unsigned* pf = (LAS unsigned*)(lds + 2 * 16896);
    int pgv = 0; { const int ue = ubase + v2 + lane * G2; if (lane < 32 && ue < NU) pgv = page_table[DEC_REC(ue)]; }
    LAS float* mlbT = (LAS float*)(lds + 2 * 16896 + 64);
    for (int e2 = 0, u2 = ubase + v2; u2 < NU && e2 < 32; ++e2, u2 += G2) { const int b_ = DEC_B(u2);
        const float d_ = wave_sum(bf2f(QB[(size_t)(MP + b_) * FW + wave * FD + lane]) * out[OUT_KS + (size_t)b_ * FW + wave * FD + lane]);
        if (lane == 0) mlbT[e2 * 8 + wave] = d_ - (CUM[((size_t)b_ * (NPAGES * PAGE) + NPAGES * PAGE - 1) * FH + wave] + GATE[(size_t)(MP + b_) * 16 + wave] * LOG2E); }
    __syncthreads();
    f32x4 xA[16][2]; float cR0, cR1; v2u qa, qb;
#define DEC_ISSUE(uu, ee) do { const int b_ = DEC_B(uu), p_ = DEC_P(uu); const int page_ = __builtin_amdgcn_readlane(pgv, ee); \
        const float* Kp_ = cache_k + (size_t)page_ * (PAGE * FW) + (size_t)(wave * 16) * FW + lane * 4; const float* Cp_ = CUM + ((size_t)b_ * (NPAGES * PAGE) + p_ * PAGE + wave * 16) * FH + lane; \
        cR0 = Cp_[0]; cR1 = Cp_[64]; \
        qa = *(const v2u*)(QB + (size_t)(MP + b_) * FW + lane * 4); qb = *(const v2u*)(QB + (size_t)(MP + b_) * FW + 256 + lane * 4); \
        _Pragma("unroll") for (int i_ = 0; i_ < 16; ++i_) { xA[i_][0] = __builtin_nontemporal_load((const f32x4*)(Kp_ + (size_t)i_ * FW)); xA[i_][1] = __builtin_nontemporal_load((const f32x4*)(Kp_ + (size_t)i_ * FW + 256)); } \
        } while (0)
#define RED16(d) do { d += dppf<0xB1>(d); d += dppf<0x4E>(d); d += dppf<0x141>(d); d += dppf<0x128>(d); } while (0)
    int u = ubase + v2, e = 0; unsigned pend = 0u;
    if (u < NU) DEC_ISSUE(u, 0);
#pragma unroll 1
    for (; u < NU; u += G2, ++e) {
        const int page = __builtin_amdgcn_readlane(pgv, e);
        const float* Vp = cache_v + (size_t)page * (PAGE * FW) + (size_t)(wave * 16) * FW + lane * 4;
        LAS float* mL = (LAS float*)(lds + (e & 1) * 16896); LAS float* lL = mL + 64; LAS float* accL = lL + 64;
        const float qA0 = bflo(qa.x), qA1 = bfhi(qa.x), qA2 = bflo(qa.y), qA3 = bfhi(qa.y), qB0 = bflo(qb.x), qB1 = bfhi(qb.x), qB2 = bflo(qb.y), qB3 = bfhi(qb.y);
        const float mlbA = mlbT[e * 8 + hA], mlbB = mlbT[e * 8 + hB];
        float scA[16], scB[16]; float mwA = -1e30f, mwB = -1e30f;
#pragma unroll
        for (int i = 0; i < 16; ++i) {
            const f32x4 k0 = xA[i][0], k1 = xA[i][1];
            float dA = qA0 * k0.x + qA1 * k0.y + qA2 * k0.z + qA3 * k0.w, dB = qB0 * k1.x + qB1 * k1.y + qB2 * k1.z + qB3 * k1.w;
            RED16(dA); RED16(dB);
            const int cr = __builtin_bit_cast(int, (i < 8) ? cR0 : cR1);
            const float cA0 = __builtin_bit_cast(float, __builtin_amdgcn_ds_bpermute(((i & 7) * 8 + hA) * 4, cr)), cA1 = __builtin_bit_cast(float, __builtin_amdgcn_ds_bpermute(((i & 7) * 8 + 4 + hA) * 4, cr));
            scA[i] = dA - cA0; scB[i] = dB - cA1; mwA = fmaxf(mwA, scA[i]); mwB = fmaxf(mwB, scB[i]);
        }
        float lwA = 0.f, lwB = 0.f; f32x4 aA = (f32x4){0.f, 0.f, 0.f, 0.f}, aB = (f32x4){0.f, 0.f, 0.f, 0.f};
        if (__any(fmaxf(mwA - mlbA, mwB - mlbB) > -DEC_SKIP)) {
#pragma unroll
            for (int i = 0; i < 16; ++i) { xA[i][0] = __builtin_nontemporal_load((const f32x4*)(Vp + (size_t)i * FW)); xA[i][1] = __builtin_nontemporal_load((const f32x4*)(Vp + (size_t)i * FW + 256)); }
#pragma unroll
            for (int i = 0; i < 16; ++i) { const float pA = exp2f(scA[i] - mwA), pB = exp2f(scB[i] - mwB); lwA += pA; lwB += pB; aA += xA[i][0] * pA; aB += xA[i][1] * pB; }
        } else { mwA = -1e30f; mwB = -1e30f; }
        { const int un = u + G2; if (un < NU) DEC_ISSUE(un, e + 1); }
        if (l15 == 0) { mL[wave * 8 + hA] = mwA; lL[wave * 8 + hA] = lwA; mL[wave * 8 + hB] = mwB; lL[wave * 8 + hB] = lwB; }
        *(LAS f32x4*)(accL + wave * 512 + lane * 4) = aA; *(LAS f32x4*)(accL + wave * 512 + 256 + lane * 4) = aB;
        __syncthreads();
        {
            const int h2 = tid >> 6, d = tid & 63;
            float M = mL[h2];
#pragma unroll
            for (int w = 1; w < 8; ++w) M = fmaxf(M, mL[w * 8 + h2]);
            float L = 0.f, O = 0.f;
#pragma unroll
            for (int w = 0; w < 8; ++w) { const float f = exp2f(mL[w * 8 + h2] - M); L += lL[w * 8 + h2] * f; O += accL[w * 512 + h2 * 64 + d] * f; }
            GAS float* dp = (GAS float*)DPART + (size_t)DEC_REC(u) * DP_UNIT + h2 * DP_HEAD;
            __hip_atomic_store(dp + 16 + d, O, RLX_AGENT); if (d == 0) { __hip_atomic_store(dp, M, RLX_AGENT); __hip_atomic_store(dp + 1, L, RLX_AGENT); }
        }
    }
#undef DEC_ISSUE
#undef RED16
    VM_WAIT(); __syncthreads();
    if (tid < 32) { unsigned bit = 0u; const int uu = ubase + v2 + tid * G2;
        if (tid < e && uu < NU) { const unsigned o = __hip_atomic_fetch_add(ctl + CW_DEC + 64 * DEC_B(uu), 1u, RLX_AGENT); bit = (o == NPAGES - 1) ? (1u << tid) : 0u; }
#pragma unroll
        for (int o2 = 1; o2 < 32; o2 <<= 1) bit |= (unsigned)__shfl_xor((int)bit, o2);
        if (tid == 0) *pf = bit; }
    __syncthreads(); pend = *pf;
    if (pend) { __builtin_amdgcn_fence(__ATOMIC_ACQUIRE, "agent"); VM_WAIT(); __syncthreads();
        e = 0; for (int uu = ubase + v2; uu < NU; uu += G2, ++e) if ((pend >> e) & 1u) decode_combine(DEC_B(uu), DPART, CUM, GATE, QB, out, MIX, tid); }
    __syncthreads();
}
__device__ __forceinline__ void decode_combine(int b, const float* DPART, const float* CUM, const float* GATE, const bf16* QB, const float* out, bf16* MIX, int tid) {
    const int h = tid >> 6, d = tid & 63; const size_t m = MP + b;
    float pm[NPAGES], pl[NPAGES], po[NPAGES];
#pragma unroll
    for (int p = 0; p < NPAGES; ++p) { const float* dp = DPART + (size_t)(b * NPAGES + p) * DP_UNIT + h * DP_HEAD; pm[p] = dp[0]; pl[p] = dp[1]; po[p] = dp[16 + d]; }
    const float cum2 = GATE[m * 16 + h] * LOG2E + CUM[((size_t)b * (NPAGES * PAGE) + NPAGES * PAGE - 1) * FH + h];
    const float q = bf2f(QB[m * FW + h * FD + d]), kn = out[OUT_KS + (size_t)b * FW + h * FD + d], vnw = out[OUT_VS + (size_t)b * FW + h * FD + d];
    const float sn = wave_sum(q * kn) - cum2;
    float M = sn;
#pragma unroll
    for (int p = 0; p < NPAGES; ++p) M = fmaxf(M, pm[p]);
    const float fn = exp2f(sn - M); float L = fn, O = fn * vnw;
#pragma unroll
    for (int p = 0; p < NPAGES; ++p) { const float f = exp2f(pm[p] - M); L += pl[p] * f; O += po[p] * f; }
    MIX[m * DMODEL + h * FD + d] = (bf16)f2bf(O / L);
}


template <int K, bool NORM, class Epi>
__device__ __forceinline__ void small_gemm_unit(LAS float* red, const bf16* A, const bf16* Bt, int su, const Epi& E, int tid) {
    const int lane = tid & 63, wave = tid >> 6, q4 = lane >> 4, l15 = lane & 15;
    const int m0 = (su & 3) * 32, n0 = (su >> 2) * 32;
    constexpr int KW = K / 8, NKS = KW / 32;
    const bf16* ap = A + (size_t)(m0 + l15) * K + wave * KW + 8 * q4;
    const bf16* bp = Bt + (size_t)(n0 + l15) * K + wave * KW + 8 * q4;
    f32x4 acc[2][2]; float ss0 = 0.f, ss1 = 0.f;
#pragma unroll
    for (int i = 0; i < 2; ++i)
#pragma unroll
        for (int j = 0; j < 2; ++j) acc[i][j] = (f32x4){0.f, 0.f, 0.f, 0.f};
#pragma unroll
    for (int b0 = 0; b0 < NKS; b0 += 4) {
        bf16x8 a0[4], a1[4], w0[4], w1[4];
#pragma unroll
        for (int j = 0; j < 4; ++j) if (b0 + j < NKS) { const int ko = 32 * (b0 + j);
            a0[j] = *(const bf16x8*)(ap + ko); a1[j] = *(const bf16x8*)(ap + (size_t)16 * K + ko); w0[j] = *(const bf16x8*)(bp + ko); w1[j] = *(const bf16x8*)(bp + (size_t)16 * K + ko); }
#pragma unroll
        for (int j = 0; j < 4; ++j) if (b0 + j < NKS) {
            acc[0][0] = __builtin_amdgcn_mfma_f32_16x16x32_bf16(a0[j], w0[j], acc[0][0], 0, 0, 0); acc[0][1] = __builtin_amdgcn_mfma_f32_16x16x32_bf16(a0[j], w1[j], acc[0][1], 0, 0, 0);
            acc[1][0] = __builtin_amdgcn_mfma_f32_16x16x32_bf16(a1[j], w0[j], acc[1][0], 0, 0, 0); acc[1][1] = __builtin_amdgcn_mfma_f32_16x16x32_bf16(a1[j], w1[j], acc[1][1], 0, 0, 0);
            if (NORM) {
#pragma unroll
                for (int q = 0; q < 8; ++q) { const float x0 = bf2f((unsigned short)a0[j][q]), x1 = bf2f((unsigned short)a1[j][q]); ss0 += x0 * x0; ss1 += x1 * x1; } } }
        __builtin_amdgcn_sched_barrier(0);
    }
#pragma unroll
    for (int t = 0; t < 4; ++t) *(LAS f32x4*)(red + ((wave * 4 + t) * 64 + lane) * 4) = acc[t >> 1][t & 1];
    if (NORM) { ss0 += __shfl_xor(ss0, 16); ss0 += __shfl_xor(ss0, 32); ss1 += __shfl_xor(ss1, 16); ss1 += __shfl_xor(ss1, 32);
        if (q4 == 0) { red[8192 + wave * 32 + l15] = ss0; red[8192 + wave * 32 + 16 + l15] = ss1; } }
    __syncthreads();
    {
        const int t = tid >> 7, ln = (tid & 127) >> 1, rr = (tid & 1) * 2;
        float s0 = 0.f, s1 = 0.f;
#pragma unroll
        for (int w = 0; w < 8; ++w) { const f32x2v v = *(const LAS f32x2v*)(red + ((w * 4 + t) * 64 + ln) * 4 + rr); s0 += v.x; s1 += v.y; }
        const int rl = 16 * (t >> 1) + 4 * (ln >> 4) + rr, row = m0 + rl, col = n0 + 16 * (t & 1) + (ln & 15);
        if (NORM) { float q0 = 0.f, q1 = 0.f;
#pragma unroll
            for (int w = 0; w < 8; ++w) { q0 += red[8192 + w * 32 + rl]; q1 += red[8192 + w * 32 + rl + 1]; }
            s0 *= rsqrtf(q0 * (1.f / K) + EPS); s1 *= rsqrtf(q1 * (1.f / K) + EPS); }
        E(row, col, s0); E(row + 1, col, s1);
    }
    __syncthreads();
}

__device__ __forceinline__ void small_up_unit(LAS float* red, const bf16* A, const bf16* Bt, int su, const float* wconv, const float* bconv, const float* ctx, bf16* ACT, float* out, int tid) {
    constexpr int K = DMODEL, KW = K / 8, NKS = KW / 32;
    const int lane = tid & 63, wave = tid >> 6, q4 = lane >> 4, l15 = lane & 15;
    const int m0 = (su & 3) * 32, c0 = (su >> 2) * 16, ng = 256 * (c0 >> 7) + (c0 & 127);
    const bf16* ap = A + (size_t)(m0 + l15) * K + wave * KW + 8 * q4;
    const bf16* bp = Bt + (size_t)(ng + l15) * K + wave * KW + 8 * q4;
    f32x4 acc[2][2]; float ss0 = 0.f, ss1 = 0.f;
#pragma unroll
    for (int i = 0; i < 2; ++i)
#pragma unroll
        for (int j = 0; j < 2; ++j) acc[i][j] = (f32x4){0.f, 0.f, 0.f, 0.f};
    bf16x8 a0[NKS], a1[NKS], w0[NKS], w1[NKS];
#pragma unroll
    for (int j = 0; j < NKS; ++j) { const int ko = 32 * j; a0[j] = *(const bf16x8*)(ap + ko); a1[j] = *(const bf16x8*)(ap + (size_t)16 * K + ko); w0[j] = *(const bf16x8*)(bp + ko); w1[j] = *(const bf16x8*)(bp + (size_t)128 * K + ko); }
#pragma unroll
    for (int j = 0; j < NKS; ++j) {
        acc[0][0] = __builtin_amdgcn_mfma_f32_16x16x32_bf16(a0[j], w0[j], acc[0][0], 0, 0, 0); acc[0][1] = __builtin_amdgcn_mfma_f32_16x16x32_bf16(a0[j], w1[j], acc[0][1], 0, 0, 0);
        acc[1][0] = __builtin_amdgcn_mfma_f32_16x16x32_bf16(a1[j], w0[j], acc[1][0], 0, 0, 0); acc[1][1] = __builtin_amdgcn_mfma_f32_16x16x32_bf16(a1[j], w1[j], acc[1][1], 0, 0, 0);
#pragma unroll
        for (int q = 0; q < 8; ++q) { const float x0 = bf2f((unsigned short)a0[j][q]), x1 = bf2f((unsigned short)a1[j][q]); ss0 += x0 * x0; ss1 += x1 * x1; } }
#pragma unroll
    for (int t = 0; t < 4; ++t) *(LAS f32x4*)(red + ((wave * 4 + t) * 64 + lane) * 4) = acc[t >> 1][t & 1];
    ss0 += __shfl_xor(ss0, 16); ss0 += __shfl_xor(ss0, 32); ss1 += __shfl_xor(ss1, 16); ss1 += __shfl_xor(ss1, 32);
    if (q4 == 0) { red[8192 + wave * 32 + l15] = ss0; red[8192 + wave * 32 + 16 + l15] = ss1; }
    __syncthreads();
    {
        const int mt = tid >> 8, ln = (tid >> 2) & 63, r = tid & 3;
        float g = 0.f, u = 0.f, q0 = 0.f;
        const int rl = 16 * mt + 4 * (ln >> 4) + r, row = m0 + rl, ch = c0 + (ln & 15);
#pragma unroll
        for (int w = 0; w < 8; ++w) { g += red[((w * 4 + 2 * mt) * 64 + ln) * 4 + r]; u += red[((w * 4 + 2 * mt + 1) * 64 + ln) * 4 + r]; q0 += red[8192 + w * 32 + rl]; }
        const float rs = rsqrtf(q0 * (1.f / K) + EPS); g *= rs; u *= rs;
        out[OUT_FCS + (size_t)(row * 2 + 1) * FFN + ch] = g;
        const float y = wconv[ch] * ctx[(size_t)(row * 2) * FFN + ch] + wconv[FFN + ch] * ctx[(size_t)(row * 2 + 1) * FFN + ch] + wconv[2 * FFN + ch] * g + bconv[ch];
        ACT[(size_t)(MP + row) * FFN + ch] = (bf16)f2bf(siluf_(y) * u);
    }
    __syncthreads();
}
struct SEpiInProj {
    bf16 *QB, *KB, *VB, *GQKV, *GZ; float* GATE; float* out; const float *b_forget, *a_log, *dt_bias;
    __device__ __forceinline__ void operator()(int row, int nd, float v) const {
        const size_t m = MP + row;
        if (nd < 512) QB[m * FW + nd] = (bf16)f2bf(v * attn_body::C2);
        else if (nd < 1024) { KB[m * FW + nd - 512] = (bf16)f2bf(v); out[OUT_KS + (size_t)row * FW + nd - 512] = v; }
        else if (nd < 1536) { VB[m * FW + nd - 1024] = (bf16)f2bf(v); out[OUT_VS + (size_t)row * FW + nd - 1024] = v; }
        else if (nd < 3072) { GQKV[m * NGQKV + nd - 1536] = (bf16)f2bf(v); out[OUT_GCS + (size_t)(row * 3 + 2) * NGQKV + nd - 1536] = v; }
        else if (nd < 3584) GZ[m * GW + nd - 3072] = (bf16)f2bf(v);
        else if (nd < 3592) { const int j = nd - 3584; const float lf = -softplusf_(-(v + b_forget[j])); GATE[m * 16 + j] = lf; out[OUT_LFS + (size_t)row * FH + j] = lf; }
        else if (nd < 3596) { const int j = nd - 3592; GATE[m * 16 + 8 + j] = -expf(a_log[j]) * softplusf_(v + dt_bias[j]); }
        else if (nd < 3600) { const int j = nd - 3596; GATE[m * 16 + 12 + j] = 1.f / (1.f + expf(-v)); }
    }
};
struct SEpiResid { const float* base; float* dst; bf16* XN;
    __device__ __forceinline__ void operator()(int row, int col, float v) const { const float r = base[(size_t)row * DMODEL + col] + v; dst[(size_t)(MP + row) * DMODEL + col] = r; if (XN) XN[(size_t)(MP + row) * DMODEL + col] = (bf16)f2bf(r); } };
struct SEpiResidWT { const float* base; float* dst;
    __device__ __forceinline__ void operator()(int row, int col, float v) const { __hip_atomic_store((GAS float*)dst + (size_t)(MP + row) * DMODEL + col, base[(size_t)row * DMODEL + col] + v, RLX_AGENT); } };
struct SEpiUp { bf16* GU; float* out;
    __device__ __forceinline__ void operator()(int row, int nd, float v) const {
        const int pn = nd >> 8, r = nd & 255;
        if (r < 128) { const int c = 128 * pn + r; GU[(size_t)(MP + row) * NUP + c] = (bf16)f2bf(v); out[OUT_FCS + (size_t)(row * 2 + 1) * FFN + c] = v; }
        else GU[(size_t)(MP + row) * NUP + FFN + 128 * pn + r - 128] = (bf16)f2bf(v);
    } };

__global__ void __launch_bounds__(NTHR, 2) fwd(Args args) {
    extern __shared__ __attribute__((aligned(16))) unsigned char lds_raw[];
    LAS unsigned char* lds = (LAS unsigned char*)lds_raw;
    volatile LAS unsigned* MISC = (volatile LAS unsigned*)(lds + MISC_OFF);
    const int tid = threadIdx.x, lane = tid & 63, wave = __builtin_amdgcn_readfirstlane(tid >> 6);
    const int G = gridDim.x; const int bx = blockIdx.x; const int vcu = (G % 8 == 0) ? (bx % 8) * (G / 8) + bx / 8 : bx;
    unsigned char* ws = args.ws; float* out = args.out;
    gu32* ctl = (gu32*)(ws + WS_CTL);
    const float* x_prompt = args.in[0]; const float* x_sample = args.in[1]; const float* cache_k = args.in[2]; const float* cache_v = args.in[3]; const float* cache_lf = args.in[4];
    const float* state_gdn = args.in[5]; const float* state_gconv = args.in[6]; const float* state_fconv = args.in[7]; const int* page_table = (const int*)args.in[8];
    const float* norm_mix = args.in[9]; const float* w_in = args.in[10]; const float* b_forget = args.in[11]; const float* a_log = args.in[12]; const float* dt_bias = args.in[13];
    const float* w_gconv = args.in[14]; const float* gnorm = args.in[15]; const float* w_out = args.in[16]; const float* norm_ffn = args.in[17]; const float* w_up = args.in[18];
    const float* w_fconv = args.in[19]; const float* b_fconv = args.in[20]; const float* w_down = args.in[21]; const float* norm_final = args.in[22];
    bf16* WinT = (bf16*)(ws + WS_WIN); bf16* WoutT = (bf16*)(ws + WS_WOUT); bf16* WupT = (bf16*)(ws + WS_WUP); bf16* WdnT = (bf16*)(ws + WS_WDN);
    float* GATE = (float*)(ws + WS_GATE); float* CUM = (float*)(ws + WS_CUM); float* DPART = (float*)(ws + WS_DPART);
    bf16* XN = (bf16*)(ws + WS_XN); bf16* QB = (bf16*)(ws + WS_QB); bf16* KB = (bf16*)(ws + WS_KB); bf16* VB = (bf16*)(ws + WS_VB); bf16* GQKV = (bf16*)(ws + WS_GQKV); bf16* GZ = (bf16*)(ws + WS_GZ);
    bf16* MIX = (bf16*)(ws + WS_MIX); float* X1 = (float*)(ws + WS_X1); bf16* GU = (bf16*)(ws + WS_GU); bf16* ACT = (bf16*)(ws + WS_ACT); float* X2 = (float*)(ws + WS_X2);
    unsigned char* gdnbuf = ws + WS_GDN; float* GLb = (float*)(ws + WS_GL); float* SSQ = (float*)(ws + WS_SSQ);

    for (int u = tid; u < (LDS_BYTES - LDSCTL_OFF) / 4; u += NTHR) ((LAS unsigned*)(lds + LDSCTL_OFF))[u] = 0u;
    __syncthreads();
    const int lo = args.ph_lo, hi = args.ph_hi;
    const bool one_launch = (hi - lo) > 1;
    XcdBarrier bar; bar.bar = (unsigned*)(ctl + CW_BAR); bar.x = 0; bar.st = nullptr;
    if (one_launch) bar = xcd_barrier_post((unsigned*)(ctl + CW_BAR), MISC + 8);
#ifdef ONLY_PH
#define IN(k) ((k) == ONLY_PH && lo <= (k) && (k) < hi)
#else
#define IN(k) (lo <= (k) && (k) < hi)
#endif
#define SEAM(k) do { if (IN(k) && IN((k) + 1)) xcd_barrier(bar); } while (0)
    const int gw = vcu * NWAVES + wave, NGW = G * NWAVES;

    constexpr int I_IN = 16 * (NIN / 32), I_OUT = 16 * 32, I_UP = 16 * (NUP / 32), I_DN = (FFN / 64) * 32, NITEMS = I_IN + I_OUT + I_UP + I_DN;
    if (IN(0)) {
        LAS float* scr = (LAS float*)(lds + RING_OFF + wave * 16384);
        const int nit0 = (G == 256) ? I_IN + I_OUT + I_UP : NITEMS;
        for (int it = gw; it < nit0; it += NGW) {
            int r = it;
            if (r < I_IN) { transpose_item(w_in, DMODEL, 3600, WinT, scr, r / (NIN / 32), r % (NIN / 32), lane, SMapIn()); continue; } r -= I_IN;
            if (r < I_OUT) { transpose_item(w_out, DMODEL, DMODEL, WoutT, scr, r / 32, r % 32, lane, SMapId()); continue; } r -= I_OUT;
            if (r < I_UP) { transpose_item(w_up, DMODEL, NUP, WupT, scr, r / (NUP / 32), r % (NUP / 32), lane, SMapUp(), norm_ffn  ); continue; } r -= I_UP;
            transpose_item(w_down, FFN, DMODEL, WdnT, scr, r / 32, r % 32, lane, SMapId());
        }
        for (int m = gw; m < MT; m += 2 * NGW) {
            const int m2 = m + NGW;
            const float* xa = m < MP ? x_prompt + (size_t)m * DMODEL : x_sample + (size_t)(m - MP) * DMODEL;
            if (m2 < MT) { const float* xb = m2 < MP ? x_prompt + (size_t)m2 * DMODEL : x_sample + (size_t)(m2 - MP) * DMODEL;
                rms_rows2_to_bf16(xa, xb, norm_mix, XN + (size_t)m * DMODEL, XN + (size_t)m2 * DMODEL, lane); }
            else rms_row_to_bf16(xa, norm_mix, XN + (size_t)m * DMODEL, lane);
        }
        { const int gt = vcu * NTHR + tid, NGT = G * NTHR;
          for (int e = gt; e < DB * 2 * NGQKV / 4; e += NGT) { const int bb = e / (2 * NGQKV / 4), r = e % (2 * NGQKV / 4);
              *((f32x4*)(out + OUT_GCS + (size_t)bb * 3 * NGQKV) + r) = *((const f32x4*)(state_gconv + (size_t)bb * 3 * NGQKV + NGQKV) + r); }
          for (int e = gt; e < DB * FFN / 4; e += NGT) { const int bb = e / (FFN / 4), r = e % (FFN / 4);
              *((f32x4*)(out + OUT_FCS + (size_t)bb * 2 * FFN) + r) = *((const f32x4*)(state_fconv + (size_t)bb * 2 * FFN + FFN) + r); } }
        if (G == 256) {
            LAS float* tot = (LAS float*)(lds + RING_OFF); LAS float* tot0 = tot + 512;
            __syncthreads();
            const int b = vcu >> 1, half = vcu & 1, hh = tid & 7, seg = tid >> 3;
            const int t0 = half * 1024 + seg * 16;
            const float* lp = cache_lf + (size_t)page_table[b * NPAGES + (t0 >> 7)] * (PAGE * FH) + (size_t)(t0 & 127) * FH + hh;
            float loc[16]; float run = 0.f, run0 = 0.f;
#pragma unroll
            for (int i = 0; i < 16; ++i) { run += lp[i * FH]; loc[i] = run; }
            if (half) { const int u0 = seg * 16; const float* lq = cache_lf + (size_t)page_table[b * NPAGES + (u0 >> 7)] * (PAGE * FH) + (size_t)(u0 & 127) * FH + hh;
#pragma unroll
                for (int i = 0; i < 16; ++i) run0 += lq[i * FH]; }
            tot[seg * 8 + hh] = run; tot0[seg * 8 + hh] = run0;
            __syncthreads();
            float off = 0.f;
            for (int s2 = 0; s2 < seg; ++s2) off += tot[s2 * 8 + hh];
            if (half) for (int s2 = 0; s2 < 64; ++s2) off += tot0[s2 * 8 + hh];
            float* cp = CUM + ((size_t)b * (NPAGES * PAGE) + t0) * FH + hh;
#pragma unroll
            for (int i = 0; i < 16; ++i) cp[i * FH] = (off + loc[i]) * LOG2E;
        } else
        for (int b = vcu; b < DB; b += G) {
            LAS float* tot = (LAS float*)(lds + RING_OFF);
            __syncthreads();
            const int hh = tid & 7, seg = tid >> 3;
            float loc[32]; float run = 0.f;
            const float* lp = cache_lf + (size_t)page_table[b * NPAGES + (seg >> 2)] * (PAGE * FH) + (size_t)((seg & 3) * 32) * FH + hh;
#pragma unroll
            for (int i = 0; i < 32; ++i) { run += lp[i * FH]; loc[i] = run; }
            tot[seg * 8 + hh] = run;
            __syncthreads();
            float off = 0.f;
            for (int s2 = 0; s2 < seg; ++s2) off += tot[s2 * 8 + hh];
            float* cp = CUM + ((size_t)b * (NPAGES * PAGE) + seg * 32) * FH + hh;
#pragma unroll
            for (int i = 0; i < 32; ++i) cp[i * FH] = (off + loc[i]) * LOG2E;
        }
        __syncthreads();
    }
    SEAM(0);
    if (IN(1)) {
        pg8::Gemm g{XN, WinT, MP, NIN, DMODEL}; pg8::StaticOrder S; S.init(MP, NIN, G, bx);
        EpiInProj E{QB, KB, VB, GQKV, GZ, GATE, out, b_forget, a_log, dt_bias};
        pg8::gemm_phase<EpiInProj, pg8::StaticOrder, true, true>(lds + RING_OFF, g, S, E);
        { const int nun = (MP / 256) * (NIN / 256), full = nun / G, rem = nun - full * G;
          const int nidle = G - rem, ir = bx - rem; SEpiInProj SE{QB, KB, VB, GQKV, GZ, GATE, out, b_forget, a_log, dt_bias};
          LAS float* red = (LAS float*)(lds + RING_OFF);
          if (nidle == G) { for (int su = bx; su < NIN / 8; su += G) small_gemm_unit<DMODEL, false>(red, XN + (size_t)MP * DMODEL, WinT, su, SE, tid); }
          else if (ir >= 0) { for (int su = ir; su < NIN / 8; su += nidle) small_gemm_unit<DMODEL, false>(red, XN + (size_t)MP * DMODEL, WinT, su, SE, tid); } }
    }
    SEAM(1);
    if (IN(2)) { }
    if (IN(3)) {
        if (vcu & 1) {
        decode_loop(lds + RING_OFF, 0, (G > 64) ? DEC_EARLY : 0, vcu, G, cache_k, cache_v, page_table, CUM, QB, DPART, ctl, GATE, out, MIX, tid);
        for (int u = vcu; u < (G == 256 ? 256 : DB * GH); u += G) { int tl = tid; asm volatile("" : "+v"(tl)); gdn_sample_unit(lds + RING_OFF, u, state_gdn, state_gconv, w_gconv, GATE, GZ, gnorm, MIX, out, tl); }
        if (G == 256) { for (int t4 = 0; t4 < 4; ++t4) { const int ci = (((vcu >> 5) * 4 + t4) << 5) + (vcu & 31); int tl = tid; asm volatile("" : "+v"(tl)); gdn_prep_unit(lds + RING_OFF, ci, GQKV, GATE, w_gconv, gdnbuf, GLb, tl); } }
        else for (int ci = vcu; ci < NCH_TOT; ci += G) { int tl = tid; asm volatile("" : "+v"(tl)); gdn_prep_unit(lds + RING_OFF, ci, GQKV, GATE, w_gconv, gdnbuf, GLb, tl); }
        } else {
        if (G == 256) { for (int t4 = 0; t4 < 4; ++t4) { const int ci = (((vcu >> 5) * 4 + t4) << 5) + (vcu & 31); int tl = tid; asm volatile("" : "+v"(tl)); gdn_prep_unit(lds + RING_OFF, ci, GQKV, GATE, w_gconv, gdnbuf, GLb, tl); } }
        else for (int ci = vcu; ci < NCH_TOT; ci += G) { int tl = tid; asm volatile("" : "+v"(tl)); gdn_prep_unit(lds + RING_OFF, ci, GQKV, GATE, w_gconv, gdnbuf, GLb, tl); }
        __syncthreads();
        decode_loop(lds + RING_OFF, 0, (G > 64) ? DEC_EARLY : 0, vcu, G, cache_k, cache_v, page_table, CUM, QB, DPART, ctl, GATE, out, MIX, tid);
        for (int u = vcu; u < (G == 256 ? 256 : DB * GH); u += G) { int tl = tid; asm volatile("" : "+v"(tl)); gdn_sample_unit(lds + RING_OFF, u, state_gdn, state_gconv, w_gconv, GATE, GZ, gnorm, MIX, out, tl); }
        }
    }
    SEAM(3);
    if (IN(4)) {
        const int NSC = (G > 64) ? NB * GH : 0;
        if (NSC == 0) { for (int u = vcu; u < NB * GH; u += G) gdn_scan_chain(lds + RING_OFF, u, gdnbuf, GLb, GZ, gnorm, MIX, out, tid); }
        const bool x256 = (G == 256);
        const bool is_scan = x256 ? ((vcu & 31) < 4) : (vcu < NSC);
        if (is_scan) { const int chain = x256 ? ((vcu >> 5) * 4 + (vcu & 31)) : vcu;
            gdn_scan_chain(lds + RING_OFF, chain, gdnbuf, GLb, GZ, gnorm, MIX, out, tid);
            if (x256) for (int u = 256 + chain; u < DB * GH; u += NB * GH) { int tl = tid; asm volatile("" : "+v"(tl)); gdn_sample_unit(lds + RING_OFF, u, state_gdn, state_gconv, w_gconv, GATE, GZ, gnorm, MIX, out, tl); }
 }
        else {
            const int v2 = x256 ? ((vcu >> 5) * 28 + (vcu & 31) - 4) : (vcu - NSC), G2 = G - NSC;
            if (v2 & 1) {
            decode_loop(lds + RING_OFF, (G > 64) ? DEC_EARLY : 0, DB * NPAGES, v2, G2, cache_k, cache_v, page_table, CUM, QB, DPART, ctl, GATE, out, MIX, tid);
            {
                LAS v4u* biasF = (LAS v4u*)(lds + BIAS_OFF); LAS float* wtot = (LAS float*)(lds + WTOT_OFF);
                for (int r = 0; r * G2 < 512; ++r) {
                    const int lo_ = r * G2, idx = (r & 1) ? lo_ + (G2 - 1 - v2) : lo_ + v2;
                    if (idx >= 512) continue;
                    const int qb = 7 - (idx >> 6), bh = idx & 63, b = bh >> 3, h = bh & 7;
                    int tl = tid; asm volatile("" : "+v"(tl));
                    fox_bias_build(GATE, b, h, (qb + 1) * 256, biasF, wtot, tl);
                    attn_body::attn_unit<8>(b, h, qb, (const attn_body::bf16*)QB, (const attn_body::bf16*)KB, (const attn_body::bf16*)VB, (attn_body::bf16*)MIX, (char*)lds_raw + RING_OFF, (const LAS char*)biasF);
                }
                __syncthreads();
            }
            } else {
            {
                LAS v4u* biasF = (LAS v4u*)(lds + BIAS_OFF); LAS float* wtot = (LAS float*)(lds + WTOT_OFF);
                for (int r = 0; r * G2 < 512; ++r) {
                    const int lo_ = r * G2, idx = (r & 1) ? lo_ + (G2 - 1 - v2) : lo_ + v2;
                    if (idx >= 512) continue;
                    const int qb = 7 - (idx >> 6), bh = idx & 63, b = bh >> 3, h = bh & 7;
                    int tl = tid; asm volatile("" : "+v"(tl));
                    fox_bias_build(GATE, b, h, (qb + 1) * 256, biasF, wtot, tl);
                    attn_body::attn_unit<8>(b, h, qb, (const attn_body::bf16*)QB, (const attn_body::bf16*)KB, (const attn_body::bf16*)VB, (attn_body::bf16*)MIX, (char*)lds_raw + RING_OFF, (const LAS char*)biasF);
                }
                __syncthreads();
            }
            decode_loop(lds + RING_OFF, (G > 64) ? DEC_EARLY : 0, DB * NPAGES, v2, G2, cache_k, cache_v, page_table, CUM, QB, DPART, ctl, GATE, out, MIX, tid);
            }
        }
        __syncthreads();
    }
    SEAM(4);
    if (IN(5)) { }
    if (IN(6)) { }
    if (IN(7)) {
        pg8::Gemm g{MIX, WoutT, MP, DMODEL, DMODEL}; pg8::StaticOrder S; S.init(MP, DMODEL, G, bx);
        if (G == 256) { EpiResidDrain E{x_prompt, XN, SSQ};
            pg8::gemm_phase<EpiResidDrain, pg8::StaticOrder, false, true>(lds + RING_OFF, g, S, E); }
        else { EpiResid E{x_prompt, X1, XN, SSQ};
            pg8::gemm_phase<EpiResid, pg8::StaticOrder, true, true>(lds + RING_OFF, g, S, E); }
        { SEpiResid SE{x_sample, X1, XN}; for (int su = bx; su < DMODEL / 8; su += G) small_gemm_unit<DMODEL, false>((LAS float*)(lds + RING_OFF), MIX + (size_t)MP * DMODEL, WoutT, su, SE, tid); }
    }
    SEAM(7);
    if (IN(8)) { }
    if (IN(9)) {
        pg8::Gemm g{XN, WupT, MP, NUP, DMODEL}; pg8::StaticOrder S; S.init(MP, NUP, G, bx);
        float* RS = SSQ + (size_t)MPAD * 16;
        {
          f32x4 pa[3][4]; int prow[3];
#pragma unroll
          for (int k = 0; k < 3; ++k) { pg8::Unit u0; prow[k] = -1;
              if (S.next(2 * k + (tid >> 8), u0)) { prow[k] = u0.pm * 256 + (tid & 255); const float* sp = SSQ + (size_t)prow[k] * 16;
#pragma unroll
                  for (int j = 0; j < 4; ++j) pa[k][j] = *(const f32x4*)(sp + 4 * j); } }
#pragma unroll
          for (int k = 0; k < 3; ++k) if (prow[k] >= 0) {
              const float tot = ((pa[k][0][0] + pa[k][0][1]) + (pa[k][0][2] + pa[k][0][3])) + ((pa[k][1][0] + pa[k][1][1]) + (pa[k][1][2] + pa[k][1][3])) + ((pa[k][2][0] + pa[k][2][1]) + (pa[k][2][2] + pa[k][2][3])) + ((pa[k][3][0] + pa[k][3][1]) + (pa[k][3][2] + pa[k][3][3]));
              RS[prow[k]] = rsqrtf(tot * (1.f / DMODEL) + EPS); }
          { pg8::Unit u0; for (int i = 6; S.next(i, u0); ++i) for (int r = tid; r < 256; r += NTHR) { const int row = u0.pm * 256 + r; const float* sp = SSQ + (size_t)row * 16;
              const f32x4 a = *(const f32x4*)sp, b2 = *(const f32x4*)(sp + 4), c2 = *(const f32x4*)(sp + 8), d2 = *(const f32x4*)(sp + 12);
              RS[row] = rsqrtf((((a[0] + a[1]) + (a[2] + a[3])) + ((b2[0] + b2[1]) + (b2[2] + b2[3])) + ((c2[0] + c2[1]) + (c2[2] + c2[3])) + ((d2[0] + d2[1]) + (d2[2] + d2[3]))) * (1.f / DMODEL) + EPS); } }
          VM_WAIT(); __syncthreads(); }
        EpiUpAct E{GU, ACT, out, w_fconv, b_fconv, RS};
        pg8::gemm_phase<EpiUpAct, pg8::StaticOrder, true, true>(lds + RING_OFF, g, S, E);
        { const int nun = (MP / 256) * (NUP / 256), full = nun / G, rem = nun - full * G; const int nidle = G - rem, ir = bx - rem;
          LAS float* red = (LAS float*)(lds + RING_OFF);
          if (nidle == G) { for (int su = bx; su < 4 * (FFN / 16); su += G) small_up_unit(red, XN + (size_t)MP * DMODEL, WupT, su, w_fconv, b_fconv, state_fconv, ACT, out, tid); }
          else if (ir >= 0) { for (int su = ir; su < 4 * (FFN / 16); su += nidle) small_up_unit(red, XN + (size_t)MP * DMODEL, WupT, su, w_fconv, b_fconv, state_fconv, ACT, out, tid);
            if (G == 256) {
                LAS float* scr = (LAS float*)(lds + RING_OFF + wave * 16384);
                for (int it = ir * NWAVES + wave; it < I_DN; it += nidle * NWAVES) transpose_item(w_down, FFN, DMODEL, WdnT, scr, it / 32, it % 32, lane, SMapId());
                __syncthreads(); } } }
    }
    SEAM(9);
    if (IN(10)) { }
    if (IN(11)) {
        pg8::Gemm g{ACT, WdnT, MP, DMODEL, FFN}; pg8::StaticOrder S; S.init(MP, DMODEL, G, bx);
        { pg8::Unit u0; for (int i = 0; S.next(i, u0); ++i) { const int m = u0.pm * 256 + (wave >> 1) * 64 + (wave & 1);
            bf16* arow = ACT + (size_t)m * FFN;
            const int t = m & (SEQ - 1);
            for (int c8 = lane; c8 < FFN / 8; c8 += 64) {
                const int c = c8 * 8;
                float gm2[8], gm1[8], g0[8], up[8];
                { const v4u a = *(const v4u*)(GU + (size_t)m * NUP + c), ub = *(const v4u*)(GU + (size_t)m * NUP + FFN + c);
                  g0[0] = bflo(a.x); g0[1] = bfhi(a.x); g0[2] = bflo(a.y); g0[3] = bfhi(a.y); g0[4] = bflo(a.z); g0[5] = bfhi(a.z); g0[6] = bflo(a.w); g0[7] = bfhi(a.w);
                  up[0] = bflo(ub.x); up[1] = bfhi(ub.x); up[2] = bflo(ub.y); up[3] = bfhi(ub.y); up[4] = bflo(ub.z); up[5] = bfhi(ub.z); up[6] = bflo(ub.w); up[7] = bfhi(ub.w); }
                if (m < MP) {
                    if (t >= 1) { const v4u a = *(const v4u*)(GU + (size_t)(m - 1) * NUP + c); gm1[0] = bflo(a.x); gm1[1] = bfhi(a.x); gm1[2] = bflo(a.y); gm1[3] = bfhi(a.y); gm1[4] = bflo(a.z); gm1[5] = bfhi(a.z); gm1[6] = bflo(a.w); gm1[7] = bfhi(a.w); }
                    else {
#pragma unroll
                        for (int j = 0; j < 8; ++j) gm1[j] = 0.f; }
                    if (t >= 2) { const v4u a = *(const v4u*)(GU + (size_t)(m - 2) * NUP + c); gm2[0] = bflo(a.x); gm2[1] = bfhi(a.x); gm2[2] = bflo(a.y); gm2[3] = bfhi(a.y); gm2[4] = bflo(a.z); gm2[5] = bfhi(a.z); gm2[6] = bflo(a.w); gm2[7] = bfhi(a.w); }
                    else {
#pragma unroll
                        for (int j = 0; j < 8; ++j) gm2[j] = 0.f; }
                } else {
                    const float* cx = state_fconv + (size_t)(m - MP) * 2 * FFN + c;
#pragma unroll
                    for (int j = 0; j < 8; ++j) { gm2[j] = cx[j]; gm1[j] = cx[FFN + j]; }
                }
                float r[8];
#pragma unroll
                for (int j = 0; j < 8; ++j) { const float y = w_fconv[c + j] * gm2[j] + w_fconv[FFN + c + j] * gm1[j] + w_fconv[2 * FFN + c + j] * g0[j] + b_fconv[c + j]; r[j] = siluf_(y) * up[j]; }
                v4u o; o.x = pk2(r[0], r[1]); o.y = pk2(r[2], r[3]); o.z = pk2(r[4], r[5]); o.w = pk2(r[6], r[7]);
                *(v4u*)(arow + c) = o;
            }
        } }
        VM_WAIT(); __syncthreads();
        if (G == 256) { EpiFinal E{XN, out + OUT_YP, SSQ + (size_t)MPAD * 17, ctl + CW_FIN, norm_final};
            pg8::gemm_phase<EpiFinal, pg8::StaticOrder, false, true>(lds + RING_OFF, g, S, E); }
        else { EpiResid2 E{X1, X2};
            pg8::gemm_phase<EpiResid2, pg8::StaticOrder, true, true>(lds + RING_OFF, g, S, E); }
        if (G == 256) {
            SEpiResidWT SE{X1 + (size_t)MP * DMODEL, X2}; LAS unsigned* lf = (LAS unsigned*)(lds + RING_OFF + 40960);
            for (int su = bx; su < DMODEL / 8; su += G) {
                small_gemm_unit<FFN, false>((LAS float*)(lds + RING_OFF), ACT + (size_t)MP * FFN, WdnT, su, SE, tid);
                VM_WAIT(); __syncthreads();
                if (tid == 0) { const unsigned old = __hip_atomic_fetch_add(ctl + CW_SFIN + 64 * (su & 3), 1u, RLX_AGENT); *lf = (old == 31u) ? 1u : 0u; }
                __syncthreads();
                if (*lf) { __builtin_amdgcn_fence(__ATOMIC_ACQUIRE, "agent"); VM_WAIT(); __syncthreads();
                    for (int r = wave; r < 32; r += NWAVES) { const int row = (su & 3) * 32 + r; rms_row_to_f32(X2 + (size_t)(MP + row) * DMODEL, norm_final, out + OUT_YS + (size_t)row * DMODEL, lane); } }
                __syncthreads();
            }
        } else { SEpiResid SE{X1 + (size_t)MP * DMODEL, X2, nullptr}; for (int su = bx; su < DMODEL / 8; su += G) small_gemm_unit<FFN, false>((LAS float*)(lds + RING_OFF), ACT + (size_t)MP * FFN, WdnT, su, SE, tid); }
    }
    if (G != 256) SEAM(11);
    if (IN(12)) {
        if (G != 256) for (int m = gw; m < MT; m += NGW) rms_row_to_f32(X2 + (size_t)m * DMODEL, norm_final, out + (m < MP ? OUT_YP + (size_t)m * DMODEL : OUT_YS + (size_t)(m - MP) * DMODEL), lane);
    }
#undef IN
#undef SEAM
}

#ifndef MK_ONE_LAUNCH
#define MK_ONE_LAUNCH 1
#endif
extern "C" void kernel_launch(void* const* d_in, const int* in_sizes, int n_in, void* d_out, int out_size, void* d_ws, size_t ws_size, hipStream_t stream) {
    static int grid = 0;
    if (grid == 0) {
        if (n_in != 23 || out_size != (int)OUT_END || ws_size < WS_END) { fprintf(stderr, "kernel_launch: unexpected sizes n_in %d out %d ws %zu\n", n_in, out_size, ws_size); grid = -1; return; }
        int dev = 0, cus = 0, per_cu = 0;
        if (hipGetDevice(&dev) != hipSuccess || hipDeviceGetAttribute(&cus, hipDeviceAttributeMultiprocessorCount, dev) != hipSuccess) { grid = -1; return; }
        if (hipFuncSetAttribute((const void*)fwd, hipFuncAttributeMaxDynamicSharedMemorySize, LDS_BYTES) != hipSuccess) { fprintf(stderr, "kernel_launch: hipFuncSetAttribute failed\n"); grid = -1; return; }
        if (hipOccupancyMaxActiveBlocksPerMultiprocessor(&per_cu, (const void*)fwd, NTHR, LDS_BYTES) != hipSuccess || per_cu < 1) { fprintf(stderr, "kernel_launch: occupancy query says %d\n", per_cu); }
        (void)hipGetLastError();
        grid = cus;
    }
    if (grid < 0) return;
    (void)hipMemsetAsync((char*)d_ws + WS_CTL, 0, CTL_ZERO_BYTES, stream);
    Args a{};
    for (int i = 0; i < 23; ++i) a.in[i] = (const float*)d_in[i];
    a.out = (float*)d_out; a.ws = (unsigned char*)d_ws;
#if MK_ONE_LAUNCH
    a.ph_lo = 0; a.ph_hi = NPH;
    hipLaunchKernelGGL(fwd, dim3(grid), dim3(NTHR), LDS_BYTES, stream, a);
#else
    for (int ph = 0; ph < NPH; ++ph) for (int rep = 0; rep < (ph == PROBE_DUP ? 2 : 1); ++rep) { a.ph_lo = ph; a.ph_hi = ph + 1; hipLaunchKernelGGL(fwd, dim3(grid), dim3(NTHR), LDS_BYTES, stream, a); }
#endif
}
```

```cpp
#include <hip/hip_runtime.h>
#include <cstdio>
#include <cstdint>
namespace pg8 {
#define PG8_LAS __attribute__((address_space(3)))
typedef unsigned short bf16_t;
typedef short bf16x8 __attribute__((ext_vector_type(8)));
typedef float f32x4 __attribute__((ext_vector_type(4)));
typedef unsigned u32x4 __attribute__((ext_vector_type(4)));
constexpr int BM = 256, BK = 64, HALF = 128, HTB = HALF * BK * 2  , STAGE_BYTES = 8 * HTB, NXCD = 8, WGM = 8;

__host__ __device__ __forceinline__ int lds_byte(int r, int c) { const int st = (r >> 4) * 2 + (c >> 5), rr = r & 15, cc = c & 31, ob = rr * 64 + cc * 2; return st * 1024 + (ob ^ (((ob >> 9) & 1) << 5)); }
__host__ __device__ __forceinline__ void stage_rc(int b, int& R, int& C) { const int st = b / 1024, sb = b % 1024, swz = sb ^ (((sb >> 9) & 1) << 5); R = (st >> 1) * 16 + swz / 64; C = (st & 1) * 32 + (swz % 64) / 2; }
__host__ __device__ __forceinline__ int perm32(int rho) { const int n = rho >> 4, i = rho & 15; return 8 * (i >> 2) + 4 * n + (i & 3); }

struct Unit { int pm, pn; };
struct Gemm { const bf16_t* A; const bf16_t* Bt; int M, N, K; };

struct StaticOrder {
    int nM, nN, nwg, G, c;
    __host__ __device__ __forceinline__ void init(int M, int N, int G_, int c_) { nM = M / BM; nN = N / BM; nwg = nM * nN; G = G_; c = c_; }
    __host__ __device__ __forceinline__ bool next(int i, Unit& u) const {
        const long L = (long)i * G + c; if (L >= nwg) return false;
        int wgid = (int)L; { const int q = nwg / NXCD, r = nwg % NXCD, xcd = wgid % NXCD, off = wgid / NXCD; wgid = (xcd < r ? xcd * (q + 1) : r * (q + 1) + (xcd - r) * q) + off; }
        const int nig = WGM * nN, gid = wgid / nig, fm = gid * WGM, gsz = (nM - fm) < WGM ? (nM - fm) : WGM;
        u.pm = fm + ((wgid % nig) % gsz); u.pn = (wgid % nig) / gsz; return true;
    }
    __device__ __forceinline__ void a_ready(const Unit&) const {}
    __device__ __forceinline__ void done(const Unit&) const {}
};

__device__ __forceinline__ unsigned cvt_pk_bf16(float lo, float hi) { unsigned r; asm volatile("v_cvt_pk_bf16_f32 %0, %1, %2" : "=v"(r) : "v"(lo), "v"(hi)); return r; }
template <class Epi, class Sched, bool ALIGN_EPI = false, bool SP2 = false>
__device__ __forceinline__ void gemm_phase(PG8_LAS unsigned char* lds, const Gemm g, const Sched& S, const Epi& E) {
    const int tid = threadIdx.x, wid = __builtin_amdgcn_readfirstlane(tid >> 6), lane = tid & 63, wr = wid >> 2, wc = wid & 3, fr = lane & 15, fq = lane >> 4;
    const int K = g.K, nt = K / BK;
    unsigned voffA[2], voffB[2];
#pragma unroll
    for (int i = 0; i < 2; ++i) { int R, C; stage_rc(tid * 16 + i * 8192, R, C); const int Rb = Epi::PERM ? ((R & ~31) + perm32(R & 31)) : R;
        voffA[i] = (unsigned)(R * K + C) * 2u; voffB[i] = (unsigned)(Rb * K + C) * 2u; }
    const size_t kstep = (size_t)(BK * 2);
    const size_t hstep = (size_t)HALF * K * 2;
    const size_t tstep = 2 * hstep;
    const unsigned ldsw = (unsigned)wid * 1024u;
    const int aoff = lds_byte(wr * 64 + fr, fq * 8), boff = lds_byte(wc * 32 + fr, fq * 8);
#define PG8_SA(b, h) (((b) * 2 + (h)) * HTB)
#define PG8_SB(b, h) ((4 + (b) * 2 + (h)) * HTB)
#define PG8_STAGE(bufoff, gbase, voff) do { _Pragma("unroll") for (int _i = 0; _i < 2; ++_i) \
        __builtin_amdgcn_global_load_lds((const unsigned*)((const char*)(gbase) + (voff)[_i]), (PG8_LAS unsigned*)(lds + (bufoff) + ldsw + _i * 8192), 16, 0, 0); } while (0)
#define PG8_LDA(dst, b, h) do { _Pragma("unroll") for (int m = 0; m < 4; ++m) _Pragma("unroll") for (int k = 0; k < 2; ++k) dst[m][k] = *(const PG8_LAS bf16x8*)(lds + PG8_SA(b, h) + aoff + m * 2048 + k * 1024); } while (0)
#define PG8_LDB(dst, b, h) do { _Pragma("unroll") for (int n = 0; n < 2; ++n) _Pragma("unroll") for (int k = 0; k < 2; ++k) dst[n][k] = *(const PG8_LAS bf16x8*)(lds + PG8_SB(b, h) + boff + n * 2048 + k * 1024); } while (0)
#define PG8_MMA(ai, bj, At, Bt) do { __builtin_amdgcn_s_setprio(1); _Pragma("unroll") for (int m = 0; m < 4; ++m) _Pragma("unroll") for (int n = 0; n < 2; ++n) _Pragma("unroll") for (int k = 0; k < 2; ++k) \
        acc[ai][bj][m][n] = __builtin_amdgcn_mfma_f32_16x16x32_bf16(Bt[n][k], At[m][k], acc[ai][bj][m][n], 0, 0, 0); __builtin_amdgcn_s_setprio(0); } while (0)
#define PG8_WAIT_V(n) asm volatile("s_waitcnt vmcnt(" #n ")" ::: "memory")
#define PG8_WAIT_L(n) asm volatile("s_waitcnt lgkmcnt(" #n ")" ::: "memory")
#define PG8_BAR __builtin_amdgcn_s_barrier()
#define PG8_SCHED __builtin_amdgcn_sched_barrier(0)
    Unit cur, nxt; int ui = 0;
    if (!S.next(0, cur)) return;
    f32x4 acc[2][2][4][2];
#pragma unroll
    for (int a = 0; a < 2; ++a)
#pragma unroll
        for (int b = 0; b < 2; ++b)
#pragma unroll
            for (int m = 0; m < 4; ++m)
#pragma unroll
                for (int n = 0; n < 2; ++n) acc[a][b][m][n] = (f32x4){0.f, 0.f, 0.f, 0.f};
    bf16x8 At[4][2], B0[2][2], B1[2][2];
    const char* cA = (const char*)g.A + (size_t)cur.pm * tstep; const char* cB = (const char*)g.Bt + (size_t)cur.pn * tstep;
    S.a_ready(cur);
    if constexpr (SP2) {
        PG8_STAGE(PG8_SB(0, 0), cB, voffB); PG8_STAGE(PG8_SB(0, 1), cB + hstep, voffB); PG8_STAGE(PG8_SA(0, 0), cA, voffA); PG8_STAGE(PG8_SA(0, 1), cA + hstep, voffA);
        if (wr == 1) PG8_BAR;
        PG8_WAIT_V(2); PG8_BAR;
        PG8_STAGE(PG8_SB(1, 0), cB + kstep, voffB); PG8_STAGE(PG8_SA(1, 0), cA + kstep, voffA); PG8_STAGE(PG8_SB(1, 1), cB + hstep + kstep, voffB);
        PG8_WAIT_V(6); PG8_BAR;
    } else {
        PG8_STAGE(PG8_SB(0, 0), cB, voffB); PG8_STAGE(PG8_SA(0, 0), cA, voffA); PG8_STAGE(PG8_SB(0, 1), cB + hstep, voffB); PG8_STAGE(PG8_SA(0, 1), cA + hstep, voffA);
        if (wr == 1) PG8_BAR;
        PG8_WAIT_V(4); PG8_BAR;
        PG8_STAGE(PG8_SB(1, 0), cB + kstep, voffB); PG8_STAGE(PG8_SA(1, 0), cA + kstep, voffA); PG8_STAGE(PG8_SB(1, 1), cB + hstep + kstep, voffB);
        PG8_WAIT_V(6); PG8_BAR;
    }
    for (;;) {
        const bool has_next = S.next(ui + 1, nxt);
        const char* nA = has_next ? (const char*)g.A + (size_t)nxt.pm * tstep : cA; const char* nB = has_next ? (const char*)g.Bt + (size_t)nxt.pn * tstep : cB;
        for (int t = 0; t < nt; t += 2) {
            const bool last = (t == nt - 2);
            const char* a1 = cA + (size_t)(t + 1) * kstep;
            const char* a2 = last ? nA : cA + (size_t)(t + 2) * kstep; const char* b2 = last ? nB : cB + (size_t)(t + 2) * kstep;
            const char* a3 = a2 + kstep; const char* b3 = b2 + kstep;
            if (last && has_next) S.a_ready(nxt);
            if constexpr (SP2) {
            PG8_LDB(B0, 0, 0); PG8_LDB(B1, 0, 1); PG8_SCHED; PG8_LDA(At, 0, 0); PG8_STAGE(PG8_SA(1, 1), a1 + hstep, voffA);
            PG8_WAIT_V(8); PG8_WAIT_L(0); PG8_BAR; PG8_MMA(0, 0, At, B0); PG8_MMA(0, 1, At, B1); PG8_BAR; PG8_SCHED;
            PG8_LDA(At, 0, 1); PG8_STAGE(PG8_SB(0, 0), b2, voffB); PG8_STAGE(PG8_SB(0, 1), b2 + hstep, voffB); PG8_STAGE(PG8_SA(0, 0), a2, voffA);
            PG8_WAIT_V(8); PG8_WAIT_L(0); PG8_BAR; PG8_MMA(1, 0, At, B0); PG8_MMA(1, 1, At, B1); PG8_BAR; PG8_SCHED;
            PG8_LDB(B0, 1, 0); PG8_LDB(B1, 1, 1); PG8_SCHED; PG8_LDA(At, 1, 0); PG8_STAGE(PG8_SA(0, 1), a2 + hstep, voffA);
            PG8_WAIT_V(8); PG8_WAIT_L(0); PG8_BAR; PG8_MMA(0, 0, At, B0); PG8_MMA(0, 1, At, B1); PG8_BAR; PG8_SCHED;
            PG8_LDA(At, 1, 1); PG8_STAGE(PG8_SB(1, 0), b3, voffB); PG8_STAGE(PG8_SB(1, 1), b3 + hstep, voffB); PG8_STAGE(PG8_SA(1, 0), a3, voffA);
            PG8_WAIT_V(8); PG8_WAIT_L(0); PG8_BAR; PG8_MMA(1, 0, At, B0); PG8_MMA(1, 1, At, B1); PG8_BAR; PG8_SCHED;
            } else {
            PG8_LDB(B0, 0, 0); PG8_SCHED; PG8_LDA(At, 0, 0); PG8_STAGE(PG8_SA(1, 1), a1 + hstep, voffA);
            PG8_WAIT_L(8); PG8_BAR; PG8_WAIT_L(0); PG8_MMA(0, 0, At, B0); PG8_BAR; PG8_SCHED;
            PG8_LDB(B1, 0, 1); PG8_STAGE(PG8_SB(0, 0), b2, voffB);
            PG8_BAR; PG8_WAIT_L(0); PG8_MMA(0, 1, At, B1); PG8_BAR;
            PG8_LDA(At, 0, 1); PG8_STAGE(PG8_SA(0, 0), a2, voffA);
            PG8_BAR; PG8_WAIT_L(0); PG8_MMA(1, 0, At, B0); PG8_BAR; PG8_SCHED;
            PG8_STAGE(PG8_SB(0, 1), b2 + hstep, voffB);
            PG8_WAIT_V(6); PG8_BAR; PG8_MMA(1, 1, At, B1); PG8_BAR;
            PG8_LDB(B0, 1, 0); PG8_SCHED; PG8_LDA(At, 1, 0); PG8_STAGE(PG8_SA(0, 1), a2 + hstep, voffA);
            PG8_WAIT_L(8); PG8_BAR; PG8_WAIT_L(0); PG8_MMA(0, 0, At, B0); PG8_BAR; PG8_SCHED;
            PG8_LDB(B1, 1, 1); PG8_STAGE(PG8_SB(1, 0), b3, voffB);
            PG8_BAR; PG8_WAIT_L(0); PG8_MMA(0, 1, At, B1); PG8_BAR;
            PG8_LDA(At, 1, 1); PG8_STAGE(PG8_SA(1, 0), a3, voffA);
            PG8_BAR; PG8_WAIT_L(0); PG8_MMA(1, 0, At, B0); PG8_BAR; PG8_SCHED;
            PG8_STAGE(PG8_SB(1, 1), b3 + hstep, voffB);
            PG8_WAIT_V(6); PG8_BAR; PG8_MMA(1, 1, At, B1); PG8_BAR;
            }
        }
        if constexpr (ALIGN_EPI) { if (wr == 0) PG8_BAR; }
        if constexpr (!Epi::AFTER_DRAIN) { E(acc, cur, wr, wc, fr, fq); S.done(cur); }
        if (!has_next) break;
#pragma unroll
        for (int a = 0; a < 2; ++a)
#pragma unroll
            for (int b = 0; b < 2; ++b)
#pragma unroll
                for (int m = 0; m < 4; ++m)
#pragma unroll
                    for (int n = 0; n < 2; ++n) acc[a][b][m][n] = (f32x4){0.f, 0.f, 0.f, 0.f};
        cur = nxt; cA = nA; cB = nB; ++ui;
        if constexpr (ALIGN_EPI) { if (wr == 1) PG8_BAR; }
    }
    PG8_WAIT_V(0);
    if constexpr (!ALIGN_EPI) { if (wr == 0) PG8_BAR; }
    PG8_BAR;
    if constexpr (Epi::AFTER_DRAIN) { E.fused(acc, cur, wr, wc, fr, fq, lds, wid, lane); S.done(cur); }
#undef PG8_SA
#undef PG8_SB
#undef PG8_STAGE
#undef PG8_LDA
#undef PG8_LDB
#undef PG8_MMA
#undef PG8_WAIT_V
#undef PG8_WAIT_L
#undef PG8_BAR
#undef PG8_SCHED
}
}
#include <hip/hip_bf16.h>
#include <cmath>
namespace attn_body {
using bf16=__hip_bfloat16;
using bf16x8=__attribute__((ext_vector_type(8)))short;
using s16x4=__attribute__((ext_vector_type(4)))short;
using f32x16=__attribute__((ext_vector_type(16)))float;
using u32x4=__attribute__((ext_vector_type(4)))unsigned;
constexpr int BATCH=8,NHEAD=8,SEQ=2048,D=64,DM=NHEAD*D,OPITCH=1024;
constexpr int NW=8,QBLK=32,QB=QBLK*NW,KVBLK=64,NQB=SEQ/QB;
constexpr int ATTN_PITCH=DM, ATTN_UNIT_ROWS=QB;
__device__ __forceinline__ int crow(int r,int hi){return (r&3)+8*(r>>2)+4*hi;}
#define SBAR() __builtin_amdgcn_sched_barrier(0)
__device__ __forceinline__ void cmask(f32x16&p0,f32x16&p1,int jb,int qrel,int hi){
  const float NEG=-INFINITY; int dq=qrel-64*jb-4*hi; asm volatile("":"+v"(dq));
  #pragma unroll
  for(int r=0;r<16;++r){const int c=(r&3)+8*(r>>2); if(c>dq)p0[r]=NEG; if(c+32>dq)p1[r]=NEG;}
}

constexpr int NSLOT=3, SLOTB=8192;
constexpr int LDS_K=0, LDS_V=NSLOT*SLOTB, LDS_WS=2*NSLOT*SLOTB, LDS_OST=LDS_WS+NW*64*4, LDS_BYTES=LDS_OST+NW*4096;
constexpr float C2=0.125f*1.4426950408889634f;
__device__ __forceinline__ void glds16(const void*gbase,unsigned voff,unsigned lds_dst){unsigned keep;
  asm volatile("s_mov_b32 %0, m0\n\ts_mov_b32 m0, %3\n\ts_nop 0\n\tglobal_load_lds_dwordx4 %1, %2\n\ts_mov_b32 m0, %0":"=&s"(keep):"v"(voff),"s"(gbase),"s"(lds_dst):"memory");}
__device__ __forceinline__ float max3f(float a,float b,float c){float r;asm("v_max3_f32 %0, %1, %2, %3":"=v"(r):"v"(a),"v"(b),"v"(c));return r;}
__device__ __forceinline__ float max2f(float a,float b){float r;asm("v_max_f32_e32 %0, %1, %2":"=v"(r):"v"(a),"v"(b));return r;}
__device__ __forceinline__ float fadd_s(float a,float b){float r;asm("v_add_f32_e32 %0, %1, %2":"=v"(r):"v"(a),"v"(b));return r;}
__device__ __forceinline__ float fsub_s(float a,float b){float r;asm("v_sub_f32_e32 %0, %1, %2":"=v"(r):"v"(a),"v"(b));return r;}
typedef float f32x2_t __attribute__((ext_vector_type(2))); typedef __bf16 bf16x2_t __attribute__((ext_vector_type(2)));
__device__ __forceinline__ unsigned cvtpk_s(float lo,float hi){f32x2_t v={lo,hi};bf16x2_t b=__builtin_convertvector(v,bf16x2_t);return __builtin_bit_cast(unsigned,b);}
#define WAIT_BAR(N) asm volatile("s_waitcnt vmcnt(" #N ") lgkmcnt(0)\n\ts_barrier":::"memory")

__device__ __forceinline__ void qkt(f32x16&p0,f32x16&p1,const char*Kslot,const bf16x8*qr,int r32,int hi){
  const char*kb=Kslot+hi*1024+r32*16;
  #pragma unroll
  for(int d0=0;d0<4;++d0){
    const bf16x8 b0=*reinterpret_cast<const bf16x8*>(kb+d0*2048);
    const bf16x8 b1=*reinterpret_cast<const bf16x8*>(kb+d0*2048+512);
    if(d0==0){p0=__builtin_amdgcn_mfma_f32_32x32x16_bf16(b0,qr[0],f32x16{},0,0,0);p1=__builtin_amdgcn_mfma_f32_32x32x16_bf16(b1,qr[0],f32x16{},0,0,0);}
    else{p0=__builtin_amdgcn_mfma_f32_32x32x16_bf16(b0,qr[d0],p0,0,0,0);p1=__builtin_amdgcn_mfma_f32_32x32x16_bf16(b1,qr[d0],p1,0,0,0);}}
}
typedef __attribute__((address_space(3))) const char* lds_cptr;
typedef short v4i16_t __attribute__((ext_vector_type(4)));
__device__ __forceinline__ void kload8(bf16x8*kf,lds_cptr kp){
  kf[0]=*(const __attribute__((address_space(3))) bf16x8*)(kp);      kf[1]=*(const __attribute__((address_space(3))) bf16x8*)(kp+512);
  kf[2]=*(const __attribute__((address_space(3))) bf16x8*)(kp+2048); kf[3]=*(const __attribute__((address_space(3))) bf16x8*)(kp+2560);
  kf[4]=*(const __attribute__((address_space(3))) bf16x8*)(kp+4096); kf[5]=*(const __attribute__((address_space(3))) bf16x8*)(kp+4608);
  kf[6]=*(const __attribute__((address_space(3))) bf16x8*)(kp+6144); kf[7]=*(const __attribute__((address_space(3))) bf16x8*)(kp+6656);
}
__device__ __forceinline__ void kload2(bf16x8*kf,lds_cptr kp,int j){ kf[2*j]=*(const __attribute__((address_space(3))) bf16x8*)(kp+j*2048); kf[2*j+1]=*(const __attribute__((address_space(3))) bf16x8*)(kp+j*2048+512); }
__device__ __forceinline__ s16x4 vtr(lds_cptr p){ return __builtin_bit_cast(s16x4,__builtin_amdgcn_ds_read_tr16_b64_v4i16((__attribute__((address_space(3))) v4i16_t*)p)); }
__device__ __forceinline__ float rowmax(const f32x16&p0,const f32x16&p1){
  float a=max3f(p0[0],p0[1],p1[0]),b=max3f(p0[2],p0[3],p1[1]);a=max3f(a,p1[2],p1[3]);
  #pragma unroll
  for(int r=4;r<16;r+=4){a=max3f(a,p0[r],p0[r+1]);b=max3f(b,p0[r+2],p0[r+3]);a=max3f(a,p1[r],p1[r+1]);b=max3f(b,p1[r+2],p1[r+3]);}
  const float m=max2f(a,b);
  auto rr=__builtin_amdgcn_permlane32_swap(__float_as_uint(m),__float_as_uint(m),false,false);
  return max2f(__uint_as_float(rr[0]),__uint_as_float(rr[1]));
}
__device__ __forceinline__ void pv(f32x16*o,int vb,bf16x8 pa0,bf16x8 pa1,bf16x8 pa2,bf16x8 pa3){
  #pragma unroll
  for(int d0=0;d0<2;++d0){s16x4 lo[4],hi[4];
    #pragma unroll
    for(int ks=0;ks<4;++ks){
      asm volatile("ds_read_b64_tr_b16 %0,%1 offset:%c2":"=&v"(lo[ks]):"v"(vb),"i"(d0*4096+ks*1024):"memory");
      asm volatile("ds_read_b64_tr_b16 %0,%1 offset:%c2":"=&v"(hi[ks]):"v"(vb),"i"(d0*4096+ks*1024+512):"memory");}
    asm volatile("s_waitcnt lgkmcnt(0)":::"memory");SBAR();
    #define PK(k) (bf16x8){lo[k][0],lo[k][1],lo[k][2],lo[k][3],hi[k][0],hi[k][1],hi[k][2],hi[k][3]}
    o[d0]=__builtin_amdgcn_mfma_f32_32x32x16_bf16(pa0,PK(0),o[d0],0,0,0);
    o[d0]=__builtin_amdgcn_mfma_f32_32x32x16_bf16(pa1,PK(1),o[d0],0,0,0);
    o[d0]=__builtin_amdgcn_mfma_f32_32x32x16_bf16(pa2,PK(2),o[d0],0,0,0);
    o[d0]=__builtin_amdgcn_mfma_f32_32x32x16_bf16(pa3,PK(3),o[d0],0,0,0);
    #undef PK
  }
}

#ifndef ATTN_STORE16
#define ATTN_STORE16(p,v) (*(u32x4*)(p)=(v))
#endif
__device__ __forceinline__ unsigned bf_rne(float f){unsigned u=__float_as_uint(f);return (u+0x7fffu+((u>>16)&1u))>>16;}
__device__ __forceinline__ void split3(float x,unsigned&h,unsigned&m,unsigned&l){h=bf_rne(x);float r=x-__uint_as_float(h<<16);m=bf_rne(r);r-=__uint_as_float(m<<16);l=bf_rne(r);}
__device__ __forceinline__ bf16x8 make_qa(float mhat,int hi){unsigned h,m,l;split3(mhat,h,m,l);u32x4 w;w.x=0x3F803F80u;w.y=0x3F80u|(h<<16);w.z=m|(l<<16);w.w=0u;if(hi){w.x=0u;w.y=0u;w.z=0u;}return __builtin_bit_cast(bf16x8,w);}
template<int THRL> __device__ __forceinline__ void attn_unit(int b,int h,int qb,const bf16*Q,const bf16*__restrict__ K,const bf16*__restrict__ V,bf16*O,char*shm,__attribute__((address_space(3))) const char* biasF){
  const int tid=threadIdx.x,lane=tid&63,r32=lane&31,hi=lane>>5; const int wid=__builtin_amdgcn_readfirstlane(tid>>6);
  const long rowbase=(long)b*SEQ; const int q0=qb*QB;
  const bf16*Qw=Q+(rowbase+q0+wid*QBLK)*DM+h*D;
  const bf16*Kh=K+rowbase*DM+h*D,*Vh=V+rowbase*DM+h*D;
  const unsigned lds0=(unsigned)(uintptr_t)shm;
  float*wsf=(float*)(shm+LDS_WS)+wid*64;
  const unsigned ksrc=(unsigned)(lane*DM+wid*8)*2u;
  const unsigned vsrc=(unsigned)((16*(wid&3)+(lane>>2))*DM+(wid>>2)*32+(lane&3)*8)*2u;
  const unsigned kdst=lds0+LDS_K+wid*1024, vdst=lds0+LDS_V+wid*1024;
  #define DMA_K(t,slot) glds16(Kh+(long)(NT-1-(t))*KVBLK*DM,ksrc,(unsigned)__builtin_amdgcn_readfirstlane(kdst+(slot)))
  #define DMA_V(t,slot) glds16(Vh+(long)(NT-1-(t))*KVBLK*DM,vsrc,(unsigned)__builtin_amdgcn_readfirstlane(vdst+(slot)))
  const int vb0=(int)(lds0+LDS_V)+((lane>>4)&1)*32+(lane&3)*8+(4*hi+((lane&15)>>2))*64;
  const char*Kbase=shm+LDS_K; bf16x8 kf[8];
  const lds_cptr shm3=(lds_cptr)shm; const lds_cptr kp0=shm3+LDS_K+hi*1024+r32*16; const lds_cptr vp0=shm3+LDS_V+((lane>>4)&1)*32+(lane&3)*8+(4*hi+((lane&15)>>2))*64;
  const int NT=(q0+QB)/KVBLK;
  DMA_K(0,0);DMA_V(0,0);DMA_K(1,SLOTB);
  bf16x8 qr[4];
  #pragma unroll
  for(int d0=0;d0<4;++d0)qr[d0]=*reinterpret_cast<const bf16x8*>(&Qw[(long)r32*DM+d0*16+hi*8]);
  const int qrel=wid*QBLK+r32;
  float mhat; { const u32x4 bw=*(const __attribute__((address_space(3))) u32x4*)(biasF+(q0+qrel)*16); mhat=(__uint_as_float(bw.x<<16)+__uint_as_float(bw.x&0xffff0000u))+__uint_as_float(bw.y<<16); }
  float l_reg=0.f;f32x16 o[2];o[0]=f32x16{};o[1]=f32x16{};bf16x8 qa=make_qa(mhat,hi);
  #define KAUG(tp,half) (*(const __attribute__((address_space(3))) bf16x8*)(biasF+(64*(tp)+32*(half)+r32)*16))
  #define CMASK(P0,P1,t) do{int jb_=3-(t); if(jb_>=0)cmask(P0,P1,jb_,qrel,hi);}while(0)
  bool resc=false;
  #define START(P0,P1) do{ const float rm=rowmax(P0,P1); resc=false; \
    if(__any(rm>(float)THRL)){ const float dl=max2f(rm,0.f); mhat=fadd_s(mhat,dl); \
      _Pragma("unroll") for(int r=0;r<16;++r){P0[r]=fsub_s(P0[r],dl);P1[r]=fsub_s(P1[r],dl);} \
      qa=make_qa(mhat,hi); } \
    _Pragma("unroll") for(int r=0;r<16;++r)P0[r]=__builtin_amdgcn_exp2f(P0[r]); }while(0)
  #define RESC() do{ if(resc){ asm volatile("s_waitcnt lgkmcnt(0)":::"memory"); \
      _Pragma("unroll") for(int d_=0;d_<2;++d_) _Pragma("unroll") for(int r=0;r<16;++r)o[d_][r]*=wsf[crow(r,hi)]; } }while(0)
  f32x16 pA0,pA1,pB0,pB1;
  int sl_prev=0,sl_cur=0,sl_next=SLOTB;
  #define ROT() do{sl_prev=sl_cur;sl_cur=sl_next;sl_next=(sl_next==(NSLOT-1)*SLOTB)?0:sl_next+SLOTB;}while(0)
  DMA_K(2,2*SLOTB);
  WAIT_BAR(3);
  qkt(pA0,pA1,Kbase,qr,r32,hi);{const bf16x8 ka0_=KAUG(NT-1,0),ka1_=KAUG(NT-1,1);pA0=__builtin_amdgcn_mfma_f32_32x32x16_bf16(ka0_,qa,pA0,0,0,0);pA1=__builtin_amdgcn_mfma_f32_32x32x16_bf16(ka1_,qa,pA1,0,0,0);}asm volatile("s_nop 15\n\ts_nop 7":"+v"(pA0),"+v"(pA1));CMASK(pA0,pA1,0);
  START(pA0,pA1);
  _Pragma("unroll") for(int r=0;r<16;++r)pA1[r]=__builtin_amdgcn_exp2f(pA1[r]);
  WAIT_BAR(0);
  DMA_K(3,0);DMA_V(1,SLOTB);
  ROT();
  kload8(kf,kp0+sl_cur);
  WAIT_BAR(2);
  s16x4 vlo[8],vhi[8]; u32x4 pw0,pw1,pw2,pw3;
  #define PKW(P,B) cvtpk_s(P[B],P[B+1])
  #define PAF(k) __builtin_bit_cast(bf16x8,pw##k)
  #define VFR(i) (bf16x8){vlo[i][0],vlo[i][1],vlo[i][2],vlo[i][3],vhi[i][0],vhi[i][1],vhi[i][2],vhi[i][3]}
  #define PIN(x) asm volatile("":"+v"(x))
  #define MX3(a,b,c) __builtin_fmaxf(__builtin_fmaxf((a),(b)),(c))
  #define GAPA(MF,A0,A1,A2,A3,W0,W1,PW) do{ MF; sacc+=A0; sacc+=A1; sacc+=A2; sacc+=A3; PIN(sacc); W0; W1; PIN(PW); SBAR(); }while(0)
  #define EX(v) __builtin_amdgcn_exp2f(v)
  #define GAPB(MF,X,B) do{ MF; X[B]=EX(X[B]); X[B+1]=EX(X[B+1]); X[B+2]=EX(X[B+2]); X[B+3]=EX(X[B+3]); PIN(X); SBAR(); }while(0)
  #define VRD(i) do{ vlo[i]=vtr(vp_+(((i)>>2)*4096+((i)&3)*1024)); vhi[i]=vtr(vp_+(((i)>>2)*4096+((i)&3)*1024+512)); }while(0)
  #define KRD(G,j) do{ if(G){ kload2(kf,kp0+sl_next,j); SBAR(); } }while(0)
  #define STEP(C0,C1,P0,P1,t,GK,GV,GL) do{ SBAR(); \
    const lds_cptr vp_=vp0+sl_prev; \
    VRD(0); SBAR(); float sacc=(P0[0]+P0[1]); \
    GAPA(C0=__builtin_amdgcn_mfma_f32_32x32x16_bf16(kf[0],qr[0],f32x16{},0,0,0), P0[2],P0[3],P0[4],P0[5],     pw0[0]=PKW(P0,0), pw0[1]=PKW(P0,2), pw0); \
    VRD(4); SBAR(); GAPA(C1=__builtin_amdgcn_mfma_f32_32x32x16_bf16(kf[1],qr[0],f32x16{},0,0,0), P0[6],P0[7],P0[8],P0[9],     pw0[2]=PKW(P0,4), pw0[3]=PKW(P0,6), pw0); \
    VRD(1); SBAR(); GAPA(C0=__builtin_amdgcn_mfma_f32_32x32x16_bf16(kf[2],qr[1],C0,0,0,0),   P0[10],P0[11],P0[12],P0[13], pw1[0]=PKW(P0,8), pw1[1]=PKW(P0,10), pw1); \
    VRD(5); SBAR(); GAPA(C1=__builtin_amdgcn_mfma_f32_32x32x16_bf16(kf[3],qr[1],C1,0,0,0),   P0[14],P0[15],P1[0],P1[1],   pw1[2]=PKW(P0,12),pw1[3]=PKW(P0,14), pw1); \
    VRD(2); SBAR(); GAPA(C0=__builtin_amdgcn_mfma_f32_32x32x16_bf16(kf[4],qr[2],C0,0,0,0),   P1[2],P1[3],P1[4],P1[5],     pw2[0]=PKW(P1,0), pw2[1]=PKW(P1,2), pw2); \
    VRD(6); SBAR(); GAPA(C1=__builtin_amdgcn_mfma_f32_32x32x16_bf16(kf[5],qr[2],C1,0,0,0),   P1[6],P1[7],P1[8],P1[9],     pw2[2]=PKW(P1,4), pw2[3]=PKW(P1,6), pw2); \
    VRD(3); const bf16x8 ka0_=KAUG(NT-1-(t),0); SBAR(); GAPA(C0=__builtin_amdgcn_mfma_f32_32x32x16_bf16(kf[6],qr[3],C0,0,0,0),   P1[10],P1[11],P1[12],P1[13], pw3[0]=PKW(P1,8), pw3[1]=PKW(P1,10), pw3); \
    VRD(7); const bf16x8 ka1_=KAUG(NT-1-(t),1); SBAR(); GAPA(C1=__builtin_amdgcn_mfma_f32_32x32x16_bf16(kf[7],qr[3],C1,0,0,0),   P1[14],P1[15],0.f,0.f,       pw3[2]=PKW(P1,12),pw3[3]=PKW(P1,14), pw3); \
    C0=__builtin_amdgcn_mfma_f32_32x32x16_bf16(ka0_,qa,C0,0,0,0); SBAR(); C1=__builtin_amdgcn_mfma_f32_32x32x16_bf16(ka1_,qa,C1,0,0,0); SBAR(); \
    l_reg+=sacc; \
    if(GK){DMA_K((t)+3,sl_cur);} if(GV){DMA_V((t)+1,sl_next);} \
    CMASK(C0,C1,t); \
    { float a=MX3(C0[0],C0[1],C1[0]),b=MX3(C0[2],C0[3],C1[1]); a=MX3(a,C1[2],C1[3]); \
      _Pragma("unroll") for(int r=4;r<16;r+=4){a=MX3(a,C0[r],C0[r+1]);b=MX3(b,C0[r+2],C0[r+3]);a=MX3(a,C1[r],C1[r+1]);b=MX3(b,C1[r+2],C1[r+3]);} \
      float rm=__builtin_fmaxf(a,b); { auto rr=__builtin_amdgcn_permlane32_swap(__float_as_uint(rm),__float_as_uint(rm),false,false); rm=__builtin_fmaxf(__uint_as_float(rr[0]),__uint_as_float(rr[1])); } \
      resc=false; \
      if(__builtin_expect(__any(rm>(float)THRL),0)){ const float dl=__builtin_fmaxf(rm,0.f); mhat+=dl; \
        _Pragma("unroll") for(int r=0;r<16;++r){C0[r]-=dl;C1[r]-=dl;} \
        qa=make_qa(mhat,hi); \
        const float f=__builtin_amdgcn_exp2f(-dl); l_reg*=f; if(hi==0)wsf[r32]=f; resc=true; } } \
    SBAR(); \
    GAPB(o[0]=__builtin_amdgcn_mfma_f32_32x32x16_bf16(PAF(0),VFR(0),o[0],0,0,0), C0,0); \
    GAPB(o[1]=__builtin_amdgcn_mfma_f32_32x32x16_bf16(PAF(0),VFR(4),o[1],0,0,0), C0,4); \
    KRD(GL,0); GAPB(o[0]=__builtin_amdgcn_mfma_f32_32x32x16_bf16(PAF(1),VFR(1),o[0],0,0,0), C0,8); \
    KRD(GL,1); GAPB(o[1]=__builtin_amdgcn_mfma_f32_32x32x16_bf16(PAF(1),VFR(5),o[1],0,0,0), C0,12); \
    KRD(GL,2); GAPB(o[0]=__builtin_amdgcn_mfma_f32_32x32x16_bf16(PAF(2),VFR(2),o[0],0,0,0), C1,0); \
    KRD(GL,3); GAPB(o[1]=__builtin_amdgcn_mfma_f32_32x32x16_bf16(PAF(2),VFR(6),o[1],0,0,0), C1,4); \
    GAPB(o[0]=__builtin_amdgcn_mfma_f32_32x32x16_bf16(PAF(3),VFR(3),o[0],0,0,0), C1,8); \
    GAPB(o[1]=__builtin_amdgcn_mfma_f32_32x32x16_bf16(PAF(3),VFR(7),o[1],0,0,0), C1,12); \
    }while(0)
  int t=1;
  #define ENDW(tt) do{ if((tt)+3<NT){WAIT_BAR(2);} else if((tt)+2<NT){WAIT_BAR(1);} else {WAIT_BAR(0);} }while(0)
  for(;t+1<NT;t+=2){
    STEP(pB0,pB1,pA0,pA1,t,(t+3<NT),(t+1<NT),(t+1<NT));       ENDW(t);   RESC(); ROT();
    STEP(pA0,pA1,pB0,pB1,t+1,(t+4<NT),(t+2<NT),(t+2<NT));     ENDW(t+1); RESC(); ROT();
  }
  STEP(pB0,pB1,pA0,pA1,NT-1,false,false,false); RESC();
  { float sacc=pB0[0]+pB0[1]; _Pragma("unroll") for(int r=2;r<16;++r)sacc+=pB0[r]; _Pragma("unroll") for(int r=0;r<16;++r)sacc+=pB1[r]; l_reg+=sacc;
    pw0=(u32x4){PKW(pB0,0),PKW(pB0,2),PKW(pB0,4),PKW(pB0,6)};pw1=(u32x4){PKW(pB0,8),PKW(pB0,10),PKW(pB0,12),PKW(pB0,14)};pw2=(u32x4){PKW(pB1,0),PKW(pB1,2),PKW(pB1,4),PKW(pB1,6)};pw3=(u32x4){PKW(pB1,8),PKW(pB1,10),PKW(pB1,12),PKW(pB1,14)};
    SBAR(); pv(o,vb0+sl_cur,PAF(0),PAF(1),PAF(2),PAF(3)); }
  #undef PKW
  #undef PAF
  #undef VFR
  #undef PIN
  #undef MX3
  #undef GAPA
  #undef GAPB
  #undef EX
  #undef VRD
  #undef KRD
  #undef STEP
  #undef ENDW
  {auto rr=__builtin_amdgcn_permlane32_swap(__float_as_uint(l_reg),__float_as_uint(l_reg),false,false);l_reg=__uint_as_float(rr[0])+__uint_as_float(rr[1]);}
  if(hi==0)wsf[32+r32]=l_reg;asm volatile("s_waitcnt lgkmcnt(0)":::"memory");
  float rli[16];
  #pragma unroll
  for(int r=0;r<16;++r)rli[r]=__builtin_amdgcn_rcpf(wsf[32+crow(r,hi)]);
  bf16*Ow=O+(rowbase+q0+wid*QBLK)*OPITCH+h*D;
  { bf16*stg=(bf16*)(shm+LDS_OST)+wid*2048;
    #pragma unroll
    for(int r=0;r<16;++r){const int orow=crow(r,hi);
      #pragma unroll
      for(int d0=0;d0<2;++d0)stg[orow*64+d0*32+r32]=__float2bfloat16(o[d0][r]*rli[r]);}
    asm volatile("s_waitcnt lgkmcnt(0)":::"memory");
    #pragma unroll
    for(int i=0;i<4;++i){const int row=i*8+(lane>>3),ch=lane&7; const u32x4 v=*(const u32x4*)(stg+row*64+ch*8); ATTN_STORE16(Ow+(long)row*OPITCH+ch*8,v);} }
  asm volatile("s_waitcnt lgkmcnt(0)\n\ts_barrier":::"memory");
  #undef DMA_K
  #undef DMA_V
  #undef CMASK
  #undef KAUG
  #undef START
  #undef RESC
  #undef ROT
}
constexpr int ATTN_LDS_BYTES=LDS_BYTES;
struct AttnTensors { const bf16* Q; const bf16* K; const bf16* V; bf16* O; };
struct AttnUnit { int bh; int qb; };
#undef SBAR
#undef WAIT_BAR
}
#define GAS __attribute__((address_space(1)))
#define LAS __attribute__((address_space(3)))
typedef unsigned short bf16;
typedef unsigned v4u __attribute__((ext_vector_type(4)));
typedef float f32x4 __attribute__((ext_vector_type(4)));
typedef short bf16x8 __attribute__((ext_vector_type(8)));
typedef GAS unsigned gu32;
typedef GAS unsigned long long gu64;
#define RLX_AGENT __ATOMIC_RELAXED, __HIP_MEMORY_SCOPE_AGENT
#define LDS_WAIT() asm volatile("s_waitcnt lgkmcnt(0)" ::: "memory")
#define VM_WAIT() asm volatile("s_waitcnt vmcnt(0)" ::: "memory")
__device__ __forceinline__ unsigned long long rt() { return __builtin_amdgcn_s_memrealtime(); }
__device__ __forceinline__ unsigned f2bf(float f) { unsigned u = __builtin_bit_cast(unsigned, f); return (u + 0x7fffu + ((u >> 16) & 1u)) >> 16; }
__device__ __forceinline__ unsigned pk2(float lo, float hi) { unsigned r; asm("v_cvt_pk_bf16_f32 %0, %1, %2" : "=v"(r) : "v"(lo), "v"(hi)); return r; }

#define XB_TMO      128
#define XB_XCNT(j)  (256  + 64 * (j))
#define XB_XSUB(j)  (1280 + 64 * (j))
#define XB_XGEN(j)  (2304 + 64 * (j))
#define XB_TOP      3328
#define XB_TOPGEN   3392
#define XCD_BAR_WORDS 3456
#define XB_SPIN_CAP (1u << 18)

__device__ __forceinline__ unsigned xb_ld(unsigned* p)              { return __hip_atomic_load(p, __ATOMIC_RELAXED, __HIP_MEMORY_SCOPE_AGENT); }
__device__ __forceinline__ unsigned xb_add(unsigned* p, unsigned v) { return __hip_atomic_fetch_add(p, v, __ATOMIC_RELAXED, __HIP_MEMORY_SCOPE_AGENT); }
__device__ __forceinline__ unsigned xb_xcc_id() { return (unsigned)__builtin_amdgcn_s_getreg((3 << 11) | 20) & 0xFu; }
#define XB_SPIN(cond, bar) do { unsigned _sp = 0; while (cond) { __builtin_amdgcn_s_sleep(1); \
    if ((++_sp & 255u) == 0u) { if (xb_ld(&(bar)[XB_TMO])) break; if (_sp > XB_SPIN_CAP) { atomicAdd(&(bar)[XB_TMO], 1u); break; } } } } while (0)

struct XcdBarrier {
    unsigned* bar; unsigned x;
    volatile LAS unsigned* st;
};

__device__ __forceinline__ XcdBarrier xcd_barrier_post(unsigned* bar, volatile LAS unsigned* st) {
    XcdBarrier b; b.bar = bar; b.x = xb_xcc_id(); b.st = st;
    if (threadIdx.x == 0) (void)xb_add(&bar[XB_XCNT(b.x)], 1u);
    return b;
}
__device__ __forceinline__ void xcd_barrier_complete(unsigned* bar, unsigned x, unsigned& nloc, unsigned& nx) {
    const unsigned G = gridDim.x * gridDim.y * gridDim.z;
    unsigned sum, cnt, mine, sp = 0u;
    for (;;) {
        sum = 0u; cnt = 0u; mine = 0u;
#pragma unroll
        for (unsigned j = 0; j < 16; ++j) { const unsigned c = xb_ld(&bar[XB_XCNT(j)]); sum += c; cnt += (c > 0u) ? 1u : 0u; mine = (j == x) ? c : mine; }
        if (sum == G) break;
        __builtin_amdgcn_s_sleep(1);
        if ((++sp & 255u) == 0u) { if (xb_ld(&bar[XB_TMO])) break; if (sp > XB_SPIN_CAP) { atomicAdd(&bar[XB_TMO], 1u); break; } }
    }
    nloc = mine > 0u ? mine : 1u; nx = cnt > 0u ? cnt : 1u;
}

__device__ __forceinline__ void xcd_barrier(const XcdBarrier& b) {
    asm volatile("s_waitcnt vmcnt(0)" ::: "memory");
    __syncthreads();
    if (threadIdx.x == 0) {
        unsigned* bar = b.bar;
        __builtin_amdgcn_s_waitcnt(0);
        unsigned nloc = b.st[0], nx = b.st[1];
        if (nloc == 0u) { xcd_barrier_complete(bar, b.x, nloc, nx); b.st[0] = nloc; b.st[1] = nx; }
        const unsigned old = xb_add(&bar[XB_XSUB(b.x)], 1u);
        const unsigned gen = old / nloc;
        if (old + 1u == (gen + 1u) * nloc) {
            __builtin_amdgcn_fence(__ATOMIC_RELEASE, "agent");
            asm volatile("s_waitcnt vmcnt(0)" ::: "memory");
            const unsigned og = xb_add(&bar[XB_TOP], 1u);
            const unsigned tg = og / nx;
            if (og + 1u == (tg + 1u) * nx) xb_add(&bar[XB_TOPGEN], 1u);
            else XB_SPIN(xb_ld(&bar[XB_TOPGEN]) == tg, bar);
            __builtin_amdgcn_fence(__ATOMIC_ACQUIRE, "agent");
            xb_add(&bar[XB_XGEN(b.x)], 1u);
            asm volatile("s_waitcnt vmcnt(0)" ::: "memory");
        } else {
            XB_SPIN(xb_ld(&bar[XB_XGEN(b.x)]) == gen, bar);
            __builtin_amdgcn_fence(__ATOMIC_ACQUIRE, "agent");
            asm volatile("s_waitcnt vmcnt(0)" ::: "memory");
        }
    }
    __syncthreads();
}


constexpr int NWAVES = 8, NTHR = NWAVES * 64;
constexpr int DMODEL = 1024, NB = 8, SEQ = 2048, MP = NB * SEQ, DB = 128, MT = MP + DB, MPAD = 16640;
constexpr int FH = 8, FD = 64, FW = 512, GH = 4, GD = 128, GW = 512, FFN = 2816;
constexpr int NIN = 3840, NUP = 2 * FFN, NGQKV = 3 * GW;
constexpr int NPAGES = 16, PAGE = 128;
constexpr float EPS = 1e-6f, LOG2E = 1.4426950408889634f, QSCALE = 0.08838834764831845f;
constexpr int NCHUNK = 32, NCH_TOT = NB * GH * NCHUNK;
constexpr size_t OUT_YP = 0, OUT_YS = OUT_YP + (size_t)MP * DMODEL, OUT_KP = OUT_YS + (size_t)DB * DMODEL, OUT_VP = OUT_KP + (size_t)MP * FW,
    OUT_LFP = OUT_VP + (size_t)MP * FW, OUT_GSP = OUT_LFP + (size_t)MP * FH, OUT_GCP = OUT_GSP + (size_t)NB * GH * GD * GD, OUT_FCP = OUT_GCP + (size_t)NB * 3 * NGQKV,
    OUT_KS = OUT_FCP + (size_t)NB * 2 * FFN, OUT_VS = OUT_KS + (size_t)DB * FW, OUT_LFS = OUT_VS + (size_t)DB * FW, OUT_GSS = OUT_LFS + (size_t)DB * FH,
    OUT_GCS = OUT_GSS + (size_t)DB * GH * GD * GD, OUT_FCS = OUT_GCS + (size_t)DB * 3 * NGQKV, OUT_END = OUT_FCS + (size_t)DB * 2 * FFN;
static_assert(OUT_END == 44254208, "output size");
constexpr size_t MiB = 1u << 20;
constexpr size_t WS_CTL = 0, CTL_ZERO_BYTES = 128 * 1024;
constexpr size_t WS_WIN = 2 * MiB, WS_WOUT = 10 * MiB, WS_WUP = 12 * MiB, WS_WDN = 23 * MiB, WS_GATE = 29 * MiB, WS_PT = 31 * MiB, WS_DPART = 32 * MiB;
constexpr size_t WS_XN = 40 * MiB, WS_QB = 73 * MiB, WS_KB = 90 * MiB, WS_VB = 107 * MiB, WS_GQKV = 124 * MiB, WS_GZ = 173 * MiB, WS_MIX = 190 * MiB;
constexpr size_t WS_X1 = 223 * MiB, WS_GU = 288 * MiB, WS_ACT = 467 * MiB, WS_X2 = 557 * MiB, WS_GDN = 622 * MiB, WS_GL = 694 * MiB, WS_CUM = 695 * MiB, WS_SSQ = 703 * MiB, WS_INVRS = WS_SSQ + 5 * MiB / 2, WS_END = 706 * MiB;
constexpr size_t GDN_CH_BYTES = 73728;
static_assert(WS_GDN + (size_t)NCH_TOT * GDN_CH_BYTES <= WS_GL, "gdn chunk buffers");
static_assert(WS_GU + (size_t)MPAD * NUP * 2 <= WS_ACT && WS_ACT + (size_t)MPAD * FFN * 2 <= WS_X2 && WS_X2 + (size_t)MPAD * DMODEL * 4 <= WS_GDN, "ws map");
constexpr int CW_BAR = 4096, CW_DEC = 8192, CW_FIN = 16384, CW_SFIN = 24576;
constexpr int CW_FIN_DUMMY = 0;
constexpr int CW_BAR_ = 0, CW_DEC_ = 0;
constexpr int DP_UNIT = 640, DP_HEAD = 80;
constexpr int RING_OFF = 0, RING_BYTES = 131072, LDSCTL_OFF = 150528, MISC_OFF = LDSCTL_OFF + 320, LDS_BYTES = 151552;
constexpr int BIAS_OFF = 86016, WTOT_OFF = BIAS_OFF + 32768;
static_assert(attn_body::ATTN_LDS_BYTES <= BIAS_OFF && WTOT_OFF + 64 <= RING_BYTES, "attention LDS");
constexpr int NPH = 13;
#ifndef PROBE_DUP
#define PROBE_DUP -1
#endif

typedef float f32x2v __attribute__((ext_vector_type(2)));
typedef unsigned v2u __attribute__((ext_vector_type(2)));
__device__ __forceinline__ float bf2f(unsigned short u) { return __uint_as_float((unsigned)u << 16); }
__device__ __forceinline__ float bflo(unsigned u) { return __uint_as_float(u << 16); }
__device__ __forceinline__ float bfhi(unsigned u) { return __uint_as_float(u & 0xffff0000u); }
__device__ __forceinline__ float wave_sum(float v) {
#pragma unroll
    for (int o = 1; o < 64; o <<= 1) v += __shfl_xor(v, o);
    return v;
}
template <int CTRL> __device__ __forceinline__ float dppf(float x) { return __builtin_bit_cast(float, __builtin_amdgcn_mov_dpp(__builtin_bit_cast(int, x), CTRL, 0xf, 0xf, true)); }
__device__ __forceinline__ float sigmoidf_(float x) { return __builtin_amdgcn_rcpf(1.f + __expf(-x)); }
__device__ __forceinline__ float siluf_(float x) { return x * __builtin_amdgcn_rcpf(1.f + __expf(-x)); }
__device__ __forceinline__ float softplusf_(float x) { return fmaxf(x, 0.f) + __logf(1.f + __expf(-fabsf(x))); }

struct EpiInProj {
    static constexpr bool PERM = true, AFTER_DRAIN = false;
    bf16 *QB, *KB, *VB, *GQKV, *GZ; float* GATE; float* out; const float *b_forget, *a_log, *dt_bias;
    __device__ __forceinline__ void operator()(const pg8::f32x4 (&acc)[2][2][4][2], const pg8::Unit& u, int wr, int wc, int fr, int fq) const {
        const int pn = u.pn;
#pragma unroll
        for (int ai = 0; ai < 2; ++ai)
#pragma unroll
            for (int m = 0; m < 4; ++m) {
                const int row = u.pm * 256 + ai * 128 + wr * 64 + m * 16 + fr;
#pragma unroll
                for (int bj = 0; bj < 2; ++bj) {
                    const int col8 = bj * 128 + wc * 32 + 8 * fq;
                    const pg8::f32x4 v0 = acc[ai][bj][m][0], v1 = acc[ai][bj][m][1];
                    if (pn < 2) {
                        const float s = attn_body::C2; v4u w; w.x = pg8::cvt_pk_bf16(v0[0] * s, v0[1] * s); w.y = pg8::cvt_pk_bf16(v0[2] * s, v0[3] * s); w.z = pg8::cvt_pk_bf16(v1[0] * s, v1[1] * s); w.w = pg8::cvt_pk_bf16(v1[2] * s, v1[3] * s);
                        *(v4u*)(QB + (size_t)row * FW + pn * 256 + col8) = w;
                    } else if (pn < 6) {
                        const int isv = pn >= 4, c = (pn - (isv ? 4 : 2)) * 256 + col8;
                        v4u w; w.x = pg8::cvt_pk_bf16(v0[0], v0[1]); w.y = pg8::cvt_pk_bf16(v0[2], v0[3]); w.z = pg8::cvt_pk_bf16(v1[0], v1[1]); w.w = pg8::cvt_pk_bf16(v1[2], v1[3]);
                        *(v4u*)((isv ? VB : KB) + (size_t)row * FW + c) = w;
                        if (row < MT) { float* o = out + (row < MP ? (isv ? OUT_VP : OUT_KP) + (size_t)row * FW : (isv ? OUT_VS : OUT_KS) + (size_t)(row - MP) * FW) + c;
                            *(pg8::f32x4*)o = v0; *(pg8::f32x4*)(o + 4) = v1; }
                    } else if (pn < 12) {
                        const int c = (pn - 6) * 256 + col8;
                        v4u w; w.x = pg8::cvt_pk_bf16(v0[0], v0[1]); w.y = pg8::cvt_pk_bf16(v0[2], v0[3]); w.z = pg8::cvt_pk_bf16(v1[0], v1[1]); w.w = pg8::cvt_pk_bf16(v1[2], v1[3]);
                        *(v4u*)(GQKV + (size_t)row * NGQKV + c) = w;
                        if (row < MP) { const int t = row & (SEQ - 1), b = row >> 11;
                            if (t >= SEQ - 3) { float* o = out + OUT_GCP + (size_t)(b * 3 + (t - (SEQ - 3))) * NGQKV + c; *(pg8::f32x4*)o = v0; *(pg8::f32x4*)(o + 4) = v1; } }
                        else if (row < MT) { float* o = out + OUT_GCS + (size_t)((row - MP) * 3 + 2) * NGQKV + c; *(pg8::f32x4*)o = v0; *(pg8::f32x4*)(o + 4) = v1; }
                    } else if (pn < 14) {
                        v4u w; w.x = pg8::cvt_pk_bf16(v0[0], v0[1]); w.y = pg8::cvt_pk_bf16(v0[2], v0[3]); w.z = pg8::cvt_pk_bf16(v1[0], v1[1]); w.w = pg8::cvt_pk_bf16(v1[2], v1[3]);
                        *(v4u*)(GZ + (size_t)row * GW + (pn - 12) * 256 + col8) = w;
                    } else {
                        if (col8 == 0) {
                            float lf[8];
#pragma unroll
                            for (int j = 0; j < 8; ++j) { const float x = (j < 4 ? v0[j] : v1[j - 4]) + b_forget[j]; lf[j] = -softplusf_(-x); }
                            float* g = GATE + (size_t)row * 16; *(pg8::f32x4*)g = (pg8::f32x4){lf[0], lf[1], lf[2], lf[3]}; *(pg8::f32x4*)(g + 4) = (pg8::f32x4){lf[4], lf[5], lf[6], lf[7]};
                            if (row < MT) { float* o = out + (row < MP ? OUT_LFP + (size_t)row * FH : OUT_LFS + (size_t)(row - MP) * FH);
                                *(pg8::f32x4*)o = (pg8::f32x4){lf[0], lf[1], lf[2], lf[3]}; *(pg8::f32x4*)(o + 4) = (pg8::f32x4){lf[4], lf[5], lf[6], lf[7]}; }
                        } else if (col8 == 8) {
                            float gg[4], be[4];
#pragma unroll
                            for (int j = 0; j < 4; ++j) { gg[j] = -__expf(a_log[j]) * softplusf_(v0[j] + dt_bias[j]); be[j] = 1.f / (1.f + __expf(-v1[j])); }
                            float* g = GATE + (size_t)row * 16 + 8; *(pg8::f32x4*)g = (pg8::f32x4){gg[0], gg[1], gg[2], gg[3]}; *(pg8::f32x4*)(g + 4) = (pg8::f32x4){be[0], be[1], be[2], be[3]};
                        }
                    }
                }
            }
    }
};
struct EpiResid {
    static constexpr bool PERM = true, AFTER_DRAIN = false;
    const float* basep; float* dst; bf16* XN; float* SSQ;
    __device__ __forceinline__ void operator()(const pg8::f32x4 (&acc)[2][2][4][2], const pg8::Unit& u, int wr, int wc, int fr, int fq) const {
#pragma unroll
        for (int ai = 0; ai < 2; ++ai)
#pragma unroll
            for (int m = 0; m < 4; ++m) {
                const int row = u.pm * 256 + ai * 128 + wr * 64 + m * 16 + fr;
                const float* src = basep + (size_t)row * DMODEL;
                float ss = 0.f;
#pragma unroll
                for (int bj = 0; bj < 2; ++bj) { const int c = u.pn * 256 + bj * 128 + wc * 32 + 8 * fq;
                    const pg8::f32x4 r0 = *(const pg8::f32x4*)(src + c) + acc[ai][bj][m][0], r1 = *(const pg8::f32x4*)(src + c + 4) + acc[ai][bj][m][1];
                    if (dst) { *(pg8::f32x4*)(dst + (size_t)row * DMODEL + c) = r0; *(pg8::f32x4*)(dst + (size_t)row * DMODEL + c + 4) = r1; }
                    v4u w; w.x = pg8::cvt_pk_bf16(r0[0], r0[1]); w.y = pg8::cvt_pk_bf16(r0[2], r0[3]); w.z = pg8::cvt_pk_bf16(r1[0], r1[1]); w.w = pg8::cvt_pk_bf16(r1[2], r1[3]);
                    *(v4u*)(XN + (size_t)row * DMODEL + c) = w;
                    ss += (r0[0] * r0[0] + r0[1] * r0[1]) + (r0[2] * r0[2] + r0[3] * r0[3]) + (r1[0] * r1[0] + r1[1] * r1[1]) + (r1[2] * r1[2] + r1[3] * r1[3]); }
                ss += __shfl_xor(ss, 16); ss += __shfl_xor(ss, 32);
                if (fq == 0) SSQ[(size_t)row * 16 + u.pn * 4 + wc] = ss;
            }
    }
};
struct EpiResidDrain {
    static constexpr bool PERM = true, AFTER_DRAIN = true;
    const float* invrs; const float* gain; bf16* XN; float* SSQ;
    __device__ __forceinline__ void fused(pg8::f32x4 (&acc)[2][2][4][2], const pg8::Unit& u, int wr, int wc, int fr, int fq, PG8_LAS unsigned char*, int, int) const {
        float ig[2][8];
#pragma unroll
        for (int bj = 0; bj < 2; ++bj) { const int c = u.pn * 256 + bj * 128 + wc * 32 + 8 * fq; const pg8::f32x4 g0 = *(const pg8::f32x4*)(gain + c), g1 = *(const pg8::f32x4*)(gain + c + 4);
#pragma unroll
            for (int j = 0; j < 4; ++j) { ig[bj][j] = __builtin_amdgcn_rcpf(g0[j]); ig[bj][4 + j] = __builtin_amdgcn_rcpf(g1[j]); } }
#pragma unroll
        for (int ai = 0; ai < 2; ++ai) {
            v4u xv[4][2]; float ir[4];
#pragma unroll
            for (int m = 0; m < 4; ++m) { const int row = u.pm * 256 + ai * 128 + wr * 64 + m * 16 + fr; ir[m] = invrs[row];
#pragma unroll
                for (int bj = 0; bj < 2; ++bj) { const int c = u.pn * 256 + bj * 128 + wc * 32 + 8 * fq; xv[m][bj] = *(const v4u*)(XN + (size_t)row * DMODEL + c); } }
#pragma unroll
            for (int m = 0; m < 4; ++m) {
                const int row = u.pm * 256 + ai * 128 + wr * 64 + m * 16 + fr;
                float ss = 0.f;
#pragma unroll
                for (int bj = 0; bj < 2; ++bj) { const int c = u.pn * 256 + bj * 128 + wc * 32 + 8 * fq;
                    const unsigned xw[4] = {xv[m][bj].x, xv[m][bj].y, xv[m][bj].z, xv[m][bj].w};
                    pg8::f32x4 r0, r1;
#pragma unroll
                    for (int q = 0; q < 2; ++q) { r0[2 * q] = bflo(xw[q]) * ig[bj][2 * q] * ir[m] + acc[ai][bj][m][0][2 * q]; r0[2 * q + 1] = bfhi(xw[q]) * ig[bj][2 * q + 1] * ir[m] + acc[ai][bj][m][0][2 * q + 1];
                        r1[2 * q] = bflo(xw[2 + q]) * ig[bj][4 + 2 * q] * ir[m] + acc[ai][bj][m][1][2 * q]; r1[2 * q + 1] = bfhi(xw[2 + q]) * ig[bj][5 + 2 * q] * ir[m] + acc[ai][bj][m][1][2 * q + 1]; }
                    v4u w; w.x = pg8::cvt_pk_bf16(r0[0], r0[1]); w.y = pg8::cvt_pk_bf16(r0[2], r0[3]); w.z = pg8::cvt_pk_bf16(r1[0], r1[1]); w.w = pg8::cvt_pk_bf16(r1[2], r1[3]);
                    *(v4u*)(XN + (size_t)row * DMODEL + c) = w;
                    ss += (r0[0] * r0[0] + r0[1] * r0[1]) + (r0[2] * r0[2] + r0[3] * r0[3]) + (r1[0] * r1[0] + r1[1] * r1[1]) + (r1[2] * r1[2] + r1[3] * r1[3]); }
                ss += __shfl_xor(ss, 16); ss += __shfl_xor(ss, 32);
                if (fq == 0) SSQ[(size_t)row * 16 + u.pn * 4 + wc] = ss;
            }
        }
    }
};
struct EpiUpAct {
    static constexpr bool PERM = true, AFTER_DRAIN = false;
    bf16* GU; bf16* ACT; float* out; const float* wconv; const float* bconv; const float* SSQ;
    __device__ __forceinline__ void operator()(const pg8::f32x4 (&acc)[2][2][4][2], const pg8::Unit& u, int wr, int wc, int fr, int fq) const {
        const int c0 = u.pn * 128 + wc * 32 + 8 * fq;
        float w0[8], w1[8], w2[8], bb[8];
#pragma unroll
        for (int j = 0; j < 8; ++j) { w0[j] = wconv[c0 + j]; w1[j] = wconv[FFN + c0 + j]; w2[j] = wconv[2 * FFN + c0 + j]; bb[j] = bconv[c0 + j]; }
        const bool sample = false;
        float rsv[2][4];
#pragma unroll
        for (int ai = 0; ai < 2; ++ai)
#pragma unroll
            for (int m = 0; m < 4; ++m) rsv[ai][m] = SSQ[u.pm * 256 + ai * 128 + wr * 64 + m * 16 + fr];
#pragma unroll
        for (int ai = 0; ai < 2; ++ai) {
            float pr1[8], pr2[8];
#pragma unroll
            for (int j = 0; j < 8; ++j) { pr1[j] = 0.f; pr2[j] = 0.f; }
#pragma unroll
            for (int m = 0; m < 4; ++m) {
                const int row = u.pm * 256 + ai * 128 + wr * 64 + m * 16 + fr;
                float g[8], up[8];
#pragma unroll
                for (int j = 0; j < 8; ++j) { g[j] = acc[ai][0][m][j >> 2][j & 3] * rsv[ai][m]; up[j] = acc[ai][1][m][j >> 2][j & 3] * rsv[ai][m]; }
                if (row < MP) { const int t = row & (SEQ - 1), b = row >> 11;
                    if (t >= SEQ - 2) { float* o = out + OUT_FCP + (size_t)(b * 2 + (t - (SEQ - 2))) * FFN + c0; *(pg8::f32x4*)o = (pg8::f32x4){g[0], g[1], g[2], g[3]}; *(pg8::f32x4*)(o + 4) = (pg8::f32x4){g[4], g[5], g[6], g[7]}; } }
                const bool edge_lo = (m == 0 && fr < 2), edge_hi = (m == 3 && fr >= 14);
                if (sample || edge_lo || edge_hi) {
                    v4u w; w.x = pg8::cvt_pk_bf16(g[0], g[1]); w.y = pg8::cvt_pk_bf16(g[2], g[3]); w.z = pg8::cvt_pk_bf16(g[4], g[5]); w.w = pg8::cvt_pk_bf16(g[6], g[7]);
                    *(v4u*)(GU + (size_t)row * NUP + c0) = w;
                    if (sample || edge_lo) { v4u x; x.x = pg8::cvt_pk_bf16(up[0], up[1]); x.y = pg8::cvt_pk_bf16(up[2], up[3]); x.z = pg8::cvt_pk_bf16(up[4], up[5]); x.w = pg8::cvt_pk_bf16(up[6], up[7]);
                        *(v4u*)(GU + (size_t)row * NUP + FFN + c0) = x; }
                }
                float r[8];
#pragma unroll
                for (int jp = 0; jp < 4; ++jp) {
                    f32x2v gm1, gm2, gc, uc, wa, wb, wcc, bv;
#pragma unroll
                    for (int q = 0; q < 2; ++q) { const int j = 2 * jp + q;
                        gm1[q] = __builtin_bit_cast(float, __builtin_amdgcn_update_dpp(__builtin_bit_cast(int, pr1[j]), __builtin_bit_cast(int, g[j]), 0x111, 0xf, 0xf, false));
                        gm2[q] = __builtin_bit_cast(float, __builtin_amdgcn_update_dpp(__builtin_bit_cast(int, pr2[j]), __builtin_bit_cast(int, g[j]), 0x112, 0xf, 0xf, false));
                        if (m < 3) { pr1[j] = dppf<0x121>(g[j]); pr2[j] = dppf<0x122>(g[j]); }
                        gc[q] = g[j]; uc[q] = up[j]; wa[q] = w0[j]; wb[q] = w1[j]; wcc[q] = w2[j]; bv[q] = bb[j]; }
                    const f32x2v y = wa * gm2 + (wb * gm1 + (wcc * gc + bv));
                    const f32x2v en = y * (-LOG2E);
                    f32x2v dn; dn[0] = __builtin_amdgcn_exp2f(en[0]); dn[1] = __builtin_amdgcn_exp2f(en[1]); dn = dn + 1.f;
                    f32x2v rc; rc[0] = __builtin_amdgcn_rcpf(dn[0]); rc[1] = __builtin_amdgcn_rcpf(dn[1]);
                    const f32x2v o2 = (y * rc) * uc;
                    r[2 * jp] = o2[0]; r[2 * jp + 1] = o2[1];
                }
                if (!sample && !edge_lo) { v4u w; w.x = pg8::cvt_pk_bf16(r[0], r[1]); w.y = pg8::cvt_pk_bf16(r[2], r[3]); w.z = pg8::cvt_pk_bf16(r[4], r[5]); w.w = pg8::cvt_pk_bf16(r[6], r[7]);
                    *(v4u*)(ACT + (size_t)row * FFN + c0) = w; }
            }
        }
    }
};
struct SMapUp { __device__ __forceinline__ int operator()(int nd) const { const int pn = nd >> 8, r = nd & 255; return r < 128 ? 128 * pn + r : FFN + 128 * pn + (r - 128); } };
struct EpiFinal {
    static constexpr bool PERM = true, AFTER_DRAIN = true;
    const bf16* base; float* y; float* SSQ2; gu32* cnt; const float* gain;
    __device__ __forceinline__ void fused(pg8::f32x4 (&acc)[2][2][4][2], const pg8::Unit& u, int wr, int wc, int fr, int fq, PG8_LAS unsigned char* lds, int wid, int lane) const {
        const int tid = wid * 64 + lane;
        v4u xb[2][4][2]; pg8::f32x4 gq[2][2];
#pragma unroll
        for (int ai = 0; ai < 2; ++ai)
#pragma unroll
            for (int m = 0; m < 4; ++m) { const size_t row = (size_t)u.pm * 256 + ai * 128 + wr * 64 + m * 16 + fr;
#pragma unroll
                for (int bj = 0; bj < 2; ++bj) xb[ai][m][bj] = *(const v4u*)(base + row * DMODEL + u.pn * 256 + bj * 128 + wc * 32 + 8 * fq); }
#pragma unroll
        for (int bj = 0; bj < 2; ++bj) { const int c = u.pn * 256 + bj * 128 + wc * 32 + 8 * fq; gq[bj][0] = *(const pg8::f32x4*)(gain + c); gq[bj][1] = *(const pg8::f32x4*)(gain + c + 4); }
#pragma unroll
        for (int ai = 0; ai < 2; ++ai)
#pragma unroll
            for (int m = 0; m < 4; ++m) {
                const int rl = ai * 128 + wr * 64 + m * 16 + fr; const size_t row = (size_t)u.pm * 256 + rl;
                float ss = 0.f;
#pragma unroll
                for (int bj = 0; bj < 2; ++bj) {
                    { const v4u x_ = xb[ai][m][bj]; acc[ai][bj][m][0] += (pg8::f32x4){bflo(x_.x), bfhi(x_.x), bflo(x_.y), bfhi(x_.y)}; acc[ai][bj][m][1] += (pg8::f32x4){bflo(x_.z), bfhi(x_.z), bflo(x_.w), bfhi(x_.w)}; }
                    const pg8::f32x4 r0 = acc[ai][bj][m][0], r1 = acc[ai][bj][m][1];
                    ss += (r0[0] * r0[0] + r0[1] * r0[1]) + (r0[2] * r0[2] + r0[3] * r0[3]) + (r1[0] * r1[0] + r1[1] * r1[1]) + (r1[2] * r1[2] + r1[3] * r1[3]); }
                ss += __shfl_xor(ss, 16); ss += __shfl_xor(ss, 32);
                if (fq == 0) __hip_atomic_store((GAS float*)SSQ2 + row * 16 + u.pn * 4 + wc, ss, RLX_AGENT);
            }
        VM_WAIT(); __syncthreads();
        if (tid == 0) {
            gu32* c = cnt + 64 * u.pm;
            __hip_atomic_fetch_add(c, 1u, RLX_AGENT);
            unsigned spins = 0u;
            while (__hip_atomic_load(c, RLX_AGENT) < 4u && ++spins < (1u << 22)) __builtin_amdgcn_s_sleep(2);
            __builtin_amdgcn_fence(__ATOMIC_ACQUIRE, "agent"); VM_WAIT();
        }
        __syncthreads();
        PG8_LAS float* rsT = (PG8_LAS float*)lds;
        if (tid < 256) { const GAS float* sp = (const GAS float*)SSQ2 + ((size_t)u.pm * 256 + tid) * 16; float tot = 0.f;
#pragma unroll
            for (int j = 0; j < 16; ++j) tot += __hip_atomic_load(sp + j, RLX_AGENT);
            rsT[tid] = rsqrtf(tot * (1.f / DMODEL) + EPS); }
        __syncthreads();
#pragma unroll
        for (int ai = 0; ai < 2; ++ai)
#pragma unroll
            for (int m = 0; m < 4; ++m) {
                const int rl = ai * 128 + wr * 64 + m * 16 + fr; const size_t row = (size_t)u.pm * 256 + rl; const float rs = rsT[rl];
#pragma unroll
                for (int bj = 0; bj < 2; ++bj) { const int c = u.pn * 256 + bj * 128 + wc * 32 + 8 * fq;
                    *(pg8::f32x4*)(y + row * DMODEL + c) = acc[ai][bj][m][0] * rs * gq[bj][0]; *(pg8::f32x4*)(y + row * DMODEL + c + 4) = acc[ai][bj][m][1] * rs * gq[bj][1]; }
            }
    }
};
struct EpiResid2 {
    static constexpr bool PERM = true, AFTER_DRAIN = false;
    const float* base; float* dst;
    __device__ __forceinline__ void operator()(const pg8::f32x4 (&acc)[2][2][4][2], const pg8::Unit& u, int wr, int wc, int fr, int fq) const {
#pragma unroll
        for (int ai = 0; ai < 2; ++ai)
#pragma unroll
            for (int m = 0; m < 4; ++m) {
                const int row = u.pm * 256 + ai * 128 + wr * 64 + m * 16 + fr;
                if (row < MT) {
#pragma unroll
                    for (int bj = 0; bj < 2; ++bj) { const size_t off = (size_t)row * DMODEL + u.pn * 256 + bj * 128 + wc * 32 + 8 * fq;
                        const pg8::f32x4 r0 = *(const pg8::f32x4*)(base + off), r1 = *(const pg8::f32x4*)(base + off + 4);
                        *(pg8::f32x4*)(dst + off) = r0 + acc[ai][bj][m][0]; *(pg8::f32x4*)(dst + off + 4) = r1 + acc[ai][bj][m][1]; }
                }
            }
    }
};

template <class SMap>
__device__ __forceinline__ void transpose_item(const float* W, int K, int Nsrc, bf16* WT, LAS float* scr, int kb, int nb, int lane, SMap smap, const float* kgain = nullptr) {
    const int k0 = 64 * kb, n0 = 32 * nb; const int ns = smap(n0 + (lane & 31));
    float tv[32];
#pragma unroll
    for (int i = 0; i < 32; ++i) { const int kk = 2 * i + (lane >> 5); tv[i] = ns >= 0 ? W[(size_t)(k0 + kk) * Nsrc + ns] * (kgain ? kgain[k0 + kk] : 1.f) : 0.f; }
#pragma unroll
    for (int i = 0; i < 32; ++i) { const int kk = 2 * i + (lane >> 5); scr[kk * 33 + (lane & 31)] = tv[i]; }
    LDS_WAIT(); asm volatile("" ::: "memory");
    const int c = lane & 7;
#pragma unroll
    for (int j = 0; j < 4; ++j) { const int n = (lane >> 3) + 8 * j; const LAS float* s = scr + (8 * c) * 33 + n;
        v4u o; o.x = pk2(s[0 * 33], s[1 * 33]); o.y = pk2(s[2 * 33], s[3 * 33]); o.z = pk2(s[4 * 33], s[5 * 33]); o.w = pk2(s[6 * 33], s[7 * 33]);
        *(GAS v4u*)(WT + (size_t)(n0 + n) * K + k0 + 8 * c) = o; }
    LDS_WAIT(); asm volatile("" ::: "memory");
}

struct SMapIn { __device__ __forceinline__ int operator()(int nd) const { return nd < 1536 ? nd : nd < 3072 ? nd + 8 : nd < 3584 ? nd + 16 : nd < 3592 ? nd - 3584 + 1536 : nd < 3600 ? nd - 3592 + 3080 : -1; } };
struct SMapId { __device__ __forceinline__ int operator()(int nd) const { return nd; } };
__device__ __forceinline__ void rms_rows2_to_bf16(const float* xa, const float* xb, const float* gain, bf16* oa, bf16* ob, int lane, float* inva = nullptr, float* invb = nullptr) {
    const f32x4* ra = (const f32x4*)xa + lane; const f32x4* rb = (const f32x4*)xb + lane; const f32x4* gr = (const f32x4*)gain + lane;
    f32x4 va[4], vb[4]; float sa = 0.f, sb = 0.f;
#pragma unroll
    for (int j = 0; j < 4; ++j) { va[j] = ra[64 * j]; vb[j] = rb[64 * j]; }
#pragma unroll
    for (int j = 0; j < 4; ++j) { sa += (va[j].x * va[j].x + va[j].y * va[j].y) + (va[j].z * va[j].z + va[j].w * va[j].w); sb += (vb[j].x * vb[j].x + vb[j].y * vb[j].y) + (vb[j].z * vb[j].z + vb[j].w * vb[j].w); }
    const float rsa = rsqrtf(wave_sum(sa) * (1.f / DMODEL) + EPS), rsb = rsqrtf(wave_sum(sb) * (1.f / DMODEL) + EPS);
    if (inva && lane == 0) { *inva = 1.f / rsa; *invb = 1.f / rsb; }
    unsigned long long* pa = (unsigned long long*)oa + lane; unsigned long long* pb = (unsigned long long*)ob + lane;
#pragma unroll
    for (int j = 0; j < 4; ++j) { const f32x4 g = gr[64 * j];
        pa[64 * j] = (unsigned long long)pk2(va[j].x * rsa * g.x, va[j].y * rsa * g.y) | ((unsigned long long)pk2(va[j].z * rsa * g.z, va[j].w * rsa * g.w) << 32);
        pb[64 * j] = (unsigned long long)pk2(vb[j].x * rsb * g.x, vb[j].y * rsb * g.y) | ((unsigned long long)pk2(vb[j].z * rsb * g.z, vb[j].w * rsb * g.w) << 32); }
}
__device__ __forceinline__ void rms_row_to_bf16(const float* xrow, const float* gain, bf16* orow, int lane, float* inv = nullptr) {
    const f32x4* xr = (const f32x4*)xrow + lane; const f32x4* gr = (const f32x4*)gain + lane;
    f32x4 v[4]; float s = 0.f;
#pragma unroll
    for (int j = 0; j < 4; ++j) { v[j] = xr[64 * j]; s += (v[j].x * v[j].x + v[j].y * v[j].y) + (v[j].z * v[j].z + v[j].w * v[j].w); }
    const float rs = rsqrtf(wave_sum(s) * (1.f / DMODEL) + EPS);
    if (inv && lane == 0) *inv = 1.f / rs;
    unsigned long long* o8 = (unsigned long long*)orow + lane;
#pragma unroll
    for (int j = 0; j < 4; ++j) { const f32x4 g = gr[64 * j]; o8[64 * j] = (unsigned long long)pk2(v[j].x * rs * g.x, v[j].y * rs * g.y) | ((unsigned long long)pk2(v[j].z * rs * g.z, v[j].w * rs * g.w) << 32); }
}
__device__ __forceinline__ void rms_row_to_f32(const float* xrow, const float* gain, float* orow, int lane) {
    const f32x4* xr = (const f32x4*)xrow + lane; const f32x4* gr = (const f32x4*)gain + lane;
    f32x4 v[4]; float s = 0.f;
#pragma unroll
    for (int j = 0; j < 4; ++j) { v[j] = xr[64 * j]; s += (v[j].x * v[j].x + v[j].y * v[j].y) + (v[j].z * v[j].z + v[j].w * v[j].w); }
    const float rs = rsqrtf(wave_sum(s) * (1.f / DMODEL) + EPS);
#pragma unroll
    for (int j = 0; j < 4; ++j) { const f32x4 g = gr[64 * j]; ((f32x4*)orow + lane)[64 * j] = (f32x4){v[j].x * rs * g.x, v[j].y * rs * g.y, v[j].z * rs * g.z, v[j].w * rs * g.w}; }
}

struct Args { const float* in[23]; float* out; unsigned char* ws; int ph_lo, ph_hi; };
static_assert(sizeof(Args) == 25 * 8 + 8, "Args has no padding");

__device__ __forceinline__ void fox_bias_build(const float* GATE, int b, int h, int NK, LAS v4u* biasF, LAS float* wtot, int tid) {
    const int lane = tid & 63, wave = tid >> 6;
    float v[4]; float run = 0.f;
#pragma unroll
    for (int i = 0; i < 4; ++i) { const int s = 4 * tid + i; const float x = (s < NK) ? GATE[(size_t)(b * SEQ + s) * 16 + h] : 0.f; run += x; v[i] = run; }
    float incl = run;
#pragma unroll
    for (int o = 1; o < 64; o <<= 1) { const float y = __shfl_up(incl, o); if (lane >= o) incl += y; }
    if (lane == 63) wtot[wave] = incl;
    __syncthreads();
    float off = incl - run;
    for (int w = 0; w < wave; ++w) off += wtot[w];
    float tot = 0.f;
    for (int w = 0; w < NWAVES; ++w) tot += wtot[w];
#pragma unroll
    for (int i = 0; i < 4; ++i) { unsigned bh_, bm_, bl_; attn_body::split3((tot - (v[i] + off)) * LOG2E, bh_, bm_, bl_);
        biasF[4 * tid + i] = (v4u){bh_ | (bm_ << 16), bl_ | 0xBF800000u, 0xBF80BF80u, 0u}; }
    __syncthreads();
}

constexpr int PR_X = 0, PR_XS = 784  , PR_RS = 260  ;
constexpr int PR_KB = 66560, PR_QB = PR_KB + 17408, PR_A = PR_QB + 17408, PR_T = PR_A + 17408, PR_TT = PR_T + 9216, PR_WC = PR_T + 18432, PR_GC = PR_WC + 6144, PR_BT = PR_GC + 256, PR_END = PR_BT + 256;
static_assert(67 * PR_XS <= PR_KB && 64 * PR_RS * 4 <= PR_KB && PR_END <= LDSCTL_OFF, "prep LDS");
struct PrepMap { int goff[7]; int loff[7]; int woff[3]; };
__device__ __forceinline__ PrepMap prep_map(int tid) {
    PrepMap M;
#pragma unroll
    for (int k = 0; k < 7; ++k) { const int p = tid + k * NTHR; M.goff[k] = 0; M.loff[k] = -1;
        if (p < 67 * 48) { const int rs = p >> 4, c16 = p & 15, row = rs / 3, sec = rs - row * 3; M.goff[k] = (row - 3) * NGQKV + sec * GW + c16 * 8; M.loff[k] = row * PR_XS + sec * 256 + c16 * 16; } }
#pragma unroll
    for (int k = 0; k < 3; ++k) { const int e = tid + k * NTHR, tap = e / 384, c = e % 384; M.woff[k] = tap * NGQKV + (c >> 7) * GW + (c & 127); }
    return M;
}
__device__ __forceinline__ void gdn_prep_unit(LAS unsigned char* lds, int ci, const bf16* GQKV, const float* GATE, const float* wconv, unsigned char* gdnbuf, float* GLb, int tid, const PrepMap& M) {
    const int lane = tid & 63, wave = __builtin_amdgcn_readfirstlane(tid >> 6), q4 = lane >> 4, l15 = lane & 15;
    const int bh = ci >> 5, n = ci & 31, b = bh >> 2, h = bh & 3;
    const int m0 = b * SEQ + n * 64;
    LAS float* R = (LAS float*)(lds + PR_X); LAS float* A = (LAS float*)(lds + PR_A); LAS bf16* Kb = (LAS bf16*)(lds + PR_KB); LAS bf16* Qb = (LAS bf16*)(lds + PR_QB);
    LAS bf16* KDTs = (LAS bf16*)(lds + PR_T); LAS float* TT = (LAS float*)(lds + PR_TT); LAS float* wL = (LAS float*)(lds + PR_WC);
    LAS float* gc = (LAS float*)(lds + PR_GC); LAS float* bt = (LAS float*)(lds + PR_BT);
    bf16* UTg = (bf16*)(gdnbuf + (size_t)ci * GDN_CH_BYTES); bf16* Wg = UTg + 8192; bf16* QDg = UTg + 16384; bf16* KDTg = UTg + 24576; bf16* QKg = UTg + 32768;
    if (wave == 0) {
        const float g = GATE[(size_t)(m0 + lane) * 16 + 8 + h], be = GATE[(size_t)(m0 + lane) * 16 + 12 + h];
        float incl = g;
#pragma unroll
        for (int o = 1; o < 64; o <<= 1) { const float y = __shfl_up(incl, o); if (lane >= o) incl += y; }
        gc[lane] = incl; bt[lane] = be;
        if (lane == 63) GLb[ci] = __expf(incl);
    }
    {
        v4u xv[7]; float wv[3];
        const bf16* gb = GQKV + (size_t)(b * SEQ + n * 64) * NGQKV + h * GD; const float* wb = wconv + h * GD;
#pragma unroll
        for (int k = 0; k < 7; ++k) { xv[k] = (v4u){0u, 0u, 0u, 0u};
            if (M.loff[k] >= 0 && (n > 0 || M.goff[k] >= 0)) xv[k] = *(const v4u*)(gb + M.goff[k]); }
#pragma unroll
        for (int k = 0; k < 3; ++k) wv[k] = wb[M.woff[k]];
#pragma unroll
        for (int k = 0; k < 7; ++k) if (M.loff[k] >= 0) *(LAS v4u*)(lds + PR_X + M.loff[k]) = xv[k];
#pragma unroll
        for (int k = 0; k < 3; ++k) wL[tid + k * NTHR] = wv[k];
    }
    __syncthreads();
    const int ci_ = tid >> 3, sub = tid & 7;
    const float gci = gc[ci_], bti = bt[ci_], eg = __expf(gci), egl = __expf(gc[63] - gci);
    float yv[16], yk[16];
#pragma unroll
    for (int sec = 0; sec < 3; ++sec) {
        f32x2v y2[8];
#pragma unroll
        for (int p = 0; p < 8; ++p) y2[p] = (f32x2v){0.f, 0.f};
#pragma unroll
        for (int tap = 0; tap < 4; ++tap) {
            const LAS unsigned char* xp = lds + PR_X + (ci_ + tap) * PR_XS + sec * 256 + sub * 32;
            const v4u x0 = *(const LAS v4u*)xp, x1 = *(const LAS v4u*)(xp + 16);
            const LAS float* wp = wL + tap * 384 + sec * 128 + sub * 16;
            const f32x4 wq[4] = {*(const LAS f32x4*)wp, *(const LAS f32x4*)(wp + 4), *(const LAS f32x4*)(wp + 8), *(const LAS f32x4*)(wp + 12)};
            const unsigned xw[8] = {x0.x, x0.y, x0.z, x0.w, x1.x, x1.y, x1.z, x1.w};
#pragma unroll
            for (int p = 0; p < 8; ++p) { const f32x2v xv = (f32x2v){bflo(xw[p]), bfhi(xw[p])}, wv = (f32x2v){wq[p >> 1][(p & 1) * 2], wq[p >> 1][(p & 1) * 2 + 1]}; y2[p] = wv * xv + y2[p]; }
        }
        float y[16]; float ss = 0.f;
        { f32x2v ss2 = (f32x2v){0.f, 0.f};
#pragma unroll
          for (int p = 0; p < 8; ++p) { const f32x2v en = y2[p] * (-LOG2E); f32x2v dn; dn[0] = __builtin_amdgcn_exp2f(en[0]); dn[1] = __builtin_amdgcn_exp2f(en[1]); dn = dn + 1.f;
              f32x2v rc; rc[0] = __builtin_amdgcn_rcpf(dn[0]); rc[1] = __builtin_amdgcn_rcpf(dn[1]); const f32x2v v = y2[p] * rc; ss2 = v * v + ss2; y[2 * p] = v[0]; y[2 * p + 1] = v[1]; }
          ss = ss2[0] + ss2[1]; }
        if (sec < 2) {
            ss += __shfl_xor(ss, 1); ss += __shfl_xor(ss, 2); ss += __shfl_xor(ss, 4);
            const float r = rsqrtf(ss + EPS) * (sec == 0 ? QSCALE : 1.f);
#pragma unroll
            for (int c = 0; c < 16; ++c) y[c] *= r;
        }
        if (sec == 0) {
            v4u a, bq, c0, c1;
            a.x = pk2(y[0], y[1]); a.y = pk2(y[2], y[3]); a.z = pk2(y[4], y[5]); a.w = pk2(y[6], y[7]); bq.x = pk2(y[8], y[9]); bq.y = pk2(y[10], y[11]); bq.z = pk2(y[12], y[13]); bq.w = pk2(y[14], y[15]);
            *(LAS v4u*)(Qb + ci_ * 136 + sub * 16) = a; *(LAS v4u*)(Qb + ci_ * 136 + sub * 16 + 8) = bq;
            c0.x = pk2(y[0] * eg, y[1] * eg); c0.y = pk2(y[2] * eg, y[3] * eg); c0.z = pk2(y[4] * eg, y[5] * eg); c0.w = pk2(y[6] * eg, y[7] * eg);
            c1.x = pk2(y[8] * eg, y[9] * eg); c1.y = pk2(y[10] * eg, y[11] * eg); c1.z = pk2(y[12] * eg, y[13] * eg); c1.w = pk2(y[14] * eg, y[15] * eg);
            *(v4u*)(QDg + ci_ * 128 + sub * 16) = c0; *(v4u*)(QDg + ci_ * 128 + sub * 16 + 8) = c1;
        } else if (sec == 1) {
            v4u a, bq;
            a.x = pk2(y[0], y[1]); a.y = pk2(y[2], y[3]); a.z = pk2(y[4], y[5]); a.w = pk2(y[6], y[7]); bq.x = pk2(y[8], y[9]); bq.y = pk2(y[10], y[11]); bq.z = pk2(y[12], y[13]); bq.w = pk2(y[14], y[15]);
            *(LAS v4u*)(Kb + ci_ * 136 + sub * 16) = a; *(LAS v4u*)(Kb + ci_ * 136 + sub * 16 + 8) = bq;
            const float wsc = bti * eg;
#pragma unroll
            for (int c = 0; c < 16; c += 2) { const unsigned pk_ = pk2(y[c] * egl, y[c + 1] * egl); KDTs[(sub * 16 + c) * 72 + ci_] = (bf16)(pk_ & 0xffffu); KDTs[(sub * 16 + c + 1) * 72 + ci_] = (bf16)(pk_ >> 16); yk[c] = y[c] * wsc; yk[c + 1] = y[c + 1] * wsc; }
        } else {
#pragma unroll
            for (int c = 0; c < 16; ++c) yv[c] = y[c] * bti;
        }
    }
    __syncthreads();
    {
        LAS float* rp = R + ci_ * PR_RS + sub * 16;
#pragma unroll
        for (int c4 = 0; c4 < 4; ++c4) { *(LAS f32x4*)(rp + 4 * c4) = (f32x4){yv[4 * c4], yv[4 * c4 + 1], yv[4 * c4 + 2], yv[4 * c4 + 3]};
            *(LAS f32x4*)(rp + 128 + 4 * c4) = (f32x4){yk[4 * c4], yk[4 * c4 + 1], yk[4 * c4 + 2], yk[4 * c4 + 3]}; }
#pragma unroll
        for (int k = 0; k < 2; ++k) { const int p = k * NTHR + tid, row = p >> 3, c16 = p & 7; *(v4u*)(KDTg + row * 64 + c16 * 8) = *(const LAS v4u*)(KDTs + row * 72 + c16 * 8); }
    }
    {
        const int mt = wave >> 1;
#pragma unroll
        for (int e = 0; e < 2; ++e) {
            const int nt = 2 * (wave & 1) + e;
            f32x4 akk = (f32x4){0.f, 0.f, 0.f, 0.f}, aqk = (f32x4){0.f, 0.f, 0.f, 0.f};
            if (nt <= mt) {
#pragma unroll
                for (int ks = 0; ks < 4; ++ks) {
                    const bf16x8 kj = *(const LAS bf16x8*)(Kb + (16 * nt + l15) * 136 + 32 * ks + 8 * q4);
                    const bf16x8 ki = *(const LAS bf16x8*)(Kb + (16 * mt + l15) * 136 + 32 * ks + 8 * q4), qi = *(const LAS bf16x8*)(Qb + (16 * mt + l15) * 136 + 32 * ks + 8 * q4);
                    akk = __builtin_amdgcn_mfma_f32_16x16x32_bf16(kj, ki, akk, 0, 0, 0); aqk = __builtin_amdgcn_mfma_f32_16x16x32_bf16(kj, qi, aqk, 0, 0, 0);
                }
            }
            const int i = 16 * mt + l15, j0 = 16 * nt + 4 * q4; const float gi = gc[i], bi = bt[i];
            f32x4 av; float qv[4];
#pragma unroll
            for (int r = 0; r < 4; ++r) { const int j = j0 + r; const float dec = (j <= i) ? __expf(gi - gc[j]) : 0.f; av[r] = (j < i) ? bi * akk[r] * dec : 0.f; qv[r] = aqk[r] * dec; }
            if (nt <= mt) *(LAS f32x4*)(A + i * 68 + j0) = av;
            v2u w; w.x = pk2(qv[0], qv[1]); w.y = pk2(qv[2], qv[3]);
            *(v2u*)(QKg + i * 64 + j0) = w;
        }
    }
    __syncthreads();
    if (wave == 0) {
        const int I = q4, c = l15; float t[16];
#pragma unroll
        for (int i = 0; i < 16; ++i) {
            float acc = (i == c) ? 1.f : 0.f;
            const LAS float* ar = A + (16 * I + i) * 68 + 16 * I;
#pragma unroll
            for (int j4 = 0; j4 < (i + 3) / 4; ++j4) { const f32x4 a = *(const LAS f32x4*)(ar + 4 * j4);
#pragma unroll
                for (int jj = 0; jj < 4; ++jj) if (4 * j4 + jj < i) acc -= a[jj] * t[4 * j4 + jj]; }
            t[i] = acc; TT[I * 320 + i * 20 + c] = acc;
        }
    }
    __syncthreads();
    f32x4 sol[4][2];
    {
#pragma unroll
        for (int I = 0; I < 4; ++I)
#pragma unroll
            for (int e = 0; e < 2; ++e)
#pragma unroll
                for (int r = 0; r < 4; ++r) sol[I][e][r] = R[(16 * I + 4 * q4 + r) * PR_RS + 32 * wave + 16 * e + l15];
#pragma unroll
        for (int I = 0; I < 4; ++I) {
#pragma unroll
            for (int J = 0; J < I; ++J) {
                const f32x4 a = *(const LAS f32x4*)(A + (16 * I + l15) * 68 + 16 * J + 4 * q4);
#pragma unroll
                for (int sstep = 0; sstep < 4; ++sstep)
#pragma unroll
                    for (int e = 0; e < 2; ++e) sol[I][e] = __builtin_amdgcn_mfma_f32_16x16x4f32(-a[sstep], sol[J][e][sstep], sol[I][e], 0, 0, 0);
            }
            const f32x4 tq = *(const LAS f32x4*)(TT + I * 320 + l15 * 20 + 4 * q4);
#pragma unroll
            for (int e = 0; e < 2; ++e) { f32x4 tmp = (f32x4){0.f, 0.f, 0.f, 0.f};
#pragma unroll
                for (int sstep = 0; sstep < 4; ++sstep) tmp = __builtin_amdgcn_mfma_f32_16x16x4f32(tq[sstep], sol[I][e][sstep], tmp, 0, 0, 0);
                sol[I][e] = tmp; }
        }
    }
    __syncthreads();
    {
        LAS bf16* UTs = (LAS bf16*)(lds + PR_X); LAS bf16* Ws = (LAS bf16*)(lds + PR_X + 18432);
#pragma unroll
        for (int I = 0; I < 4; ++I)
#pragma unroll
            for (int e = 0; e < 2; ++e) {
                const int col = 32 * wave + 16 * e + l15;
                const unsigned p01 = pk2(sol[I][e][0], sol[I][e][1]), p23 = pk2(sol[I][e][2], sol[I][e][3]);
                if (wave < 4) { v2u w; w.x = p01; w.y = p23; *(LAS v2u*)(UTs + col * 72 + 16 * I + 4 * q4) = w; }
                else { LAS bf16* wp = Ws + (16 * I + 4 * q4) * 136 + col - 128;
                    wp[0] = (bf16)(p01 & 0xffffu); wp[136] = (bf16)(p01 >> 16); wp[272] = (bf16)(p23 & 0xffffu); wp[408] = (bf16)(p23 >> 16); }
            }
    }
    __syncthreads();
    {
        const LAS bf16* UTs = (const LAS bf16*)(lds + PR_X); const LAS bf16* Ws = (const LAS bf16*)(lds + PR_X + 18432);
#pragma unroll
        for (int k = 0; k < 2; ++k) { const int p = k * NTHR + tid;
            { const int row = p >> 3, c16 = p & 7; *(v4u*)(UTg + row * 64 + c16 * 8) = *(const LAS v4u*)(UTs + row * 72 + c16 * 8); }
            { const int row = p >> 4, c16 = p & 15; *(v4u*)(Wg + row * 128 + c16 * 8) = *(const LAS v4u*)(Ws + row * 136 + c16 * 8); } }
    }
    __syncthreads();
}

constexpr int SC_W = 0, SC_QD = 17408, SC_U = 34816, SC_KDT = 53248, SC_QK = 71680, SC_O = 80896;
static_assert(SC_O + 2 * 64 * 132 * 4 + 512 <= LDSCTL_OFF, "scan LDS");
__device__ __forceinline__ bf16x8 pack8(const f32x4& a, const f32x4& b) {
    v4u w; w.x = pg8::cvt_pk_bf16(a[0], a[1]); w.y = pg8::cvt_pk_bf16(a[2], a[3]); w.z = pg8::cvt_pk_bf16(b[0], b[1]); w.w = pg8::cvt_pk_bf16(b[2], b[3]); return __builtin_bit_cast(bf16x8, w);
}
__device__ __forceinline__ bf16x8 afrag(const LAS bf16* rowp, int kbase, int q4) {
    const v2u lo = *(const LAS v2u*)(rowp + kbase + 4 * q4), hi = *(const LAS v2u*)(rowp + kbase + 16 + 4 * q4);
    v4u w; w.x = lo.x; w.y = lo.y; w.z = hi.x; w.w = hi.y; return __builtin_bit_cast(bf16x8, w);
}
__device__ __forceinline__ void gdn_scan_chain(LAS unsigned char* lds, int bh, const unsigned char* gdnbuf, const float* GLb, const bf16* GZ, const float* gnorm, bf16* MIX, float* out, int tid) {
    const int lane = tid & 63, wave = __builtin_amdgcn_readfirstlane(tid >> 6), q4 = lane >> 4, l15 = lane & 15;
    const int b = bh >> 2, h = bh & 3;
    LAS bf16* Wl = (LAS bf16*)(lds + SC_W); LAS bf16* QDl = (LAS bf16*)(lds + SC_QD); LAS bf16* UTl = (LAS bf16*)(lds + SC_U); LAS bf16* KDTl = (LAS bf16*)(lds + SC_KDT); LAS bf16* QKl = (LAS bf16*)(lds + SC_QK);
    LAS float* Ol = (LAS float*)(lds + SC_O);
    LAS float* gnL = (LAS float*)(lds + SC_O + 2 * 64 * 132 * 4);
    if (tid < GD) gnL[tid] = gnorm[tid];
    if (wave >= 4) {
        const int lt = tid - 256;
        v4u rA[18], rB[18];
        const __amdgpu_buffer_rsrc_t rs_ch = __builtin_amdgcn_make_buffer_rsrc((void*)(gdnbuf + (size_t)bh * NCHUNK * GDN_CH_BYTES), 0, NCHUNK * (int)GDN_CH_BYTES, 0x00020000);
        const int voff = lt * 16;
#define SCL_LOAD(RG, nn) do { _Pragma("unroll") for (int k_ = 0; k_ < 18; ++k_) RG[k_] = __builtin_bit_cast(v4u, __builtin_amdgcn_raw_buffer_load_b128(rs_ch, voff, (nn) * (int)GDN_CH_BYTES + k_ * 4096, 0)); } while (0)
#define SCL_STAGE(RG) do { _Pragma("unroll") for (int k_ = 0; k_ < 18; ++k_) { const int p_ = k_ * 256 + lt; \
            if (k_ < 4) { const int row = p_ >> 3, c16 = p_ & 7; *(LAS v4u*)(UTl + row * 72 + c16 * 8) = RG[k_]; } \
            else if (k_ < 12) { const int pp = p_ & 1023, row = pp >> 4, c16 = pp & 15; LAS bf16* base = (k_ < 8) ? Wl : QDl; *(LAS v4u*)(base + row * 136 + c16 * 8) = RG[k_]; } \
            else if (k_ < 16) { const int pp = p_ - 3072, row = pp >> 3, c16 = pp & 7; *(LAS v4u*)(KDTl + row * 72 + c16 * 8) = RG[k_]; } \
            else { const int pp = p_ - 4096, row = pp >> 3, c16 = pp & 7; *(LAS v4u*)(QKl + row * 72 + c16 * 8) = RG[k_]; } } } while (0)
        const int zi = lt >> 2, zsub = lt & 3;
        const bf16* zbase = GZ + ((size_t)b * SEQ + zi) * GW + h * GD + zsub * 32;
        v4u zp[4];
#pragma unroll
        for (int j = 0; j < 4; ++j) zp[j] = *(const v4u*)(zbase + 8 * j);
        SCL_LOAD(rA, 0); SCL_LOAD(rB, 1);
#define SCL_NORM(nn) do { const size_t m_ = (size_t)b * SEQ + (nn) * 64 + zi; const LAS float* op_ = Ol + ((nn) & 1) * (64 * 132) + zi * 132 + zsub * 32; float ss_ = 0.f; \
        _Pragma("unroll") for (int c = 0; c < 8; ++c) { const f32x4 t_ = *(const LAS f32x4*)(op_ + 4 * c); ss_ += (t_[0] * t_[0] + t_[1] * t_[1]) + (t_[2] * t_[2] + t_[3] * t_[3]); } \
        ss_ += __shfl_xor(ss_, 1); ss_ += __shfl_xor(ss_, 2); \
        const float rs_ = rsqrtf(ss_ * (1.f / GD) + EPS); const LAS float* gn_ = gnL + zsub * 32; \
        _Pragma("unroll") for (int j = 0; j < 4; ++j) { const unsigned zz_[4] = {zp[j].x, zp[j].y, zp[j].z, zp[j].w}; v4u o_; unsigned ow_[4]; \
            const f32x4 ya_ = *(const LAS f32x4*)(op_ + 8 * j), yb_ = *(const LAS f32x4*)(op_ + 8 * j + 4); const f32x4 ga_ = *(const LAS f32x4*)(gn_ + 8 * j), gb_ = *(const LAS f32x4*)(gn_ + 8 * j + 4); \
            ow_[0] = pk2(ya_[0] * rs_ * ga_[0] * siluf_(bflo(zz_[0])), ya_[1] * rs_ * ga_[1] * siluf_(bfhi(zz_[0]))); ow_[1] = pk2(ya_[2] * rs_ * ga_[2] * siluf_(bflo(zz_[1])), ya_[3] * rs_ * ga_[3] * siluf_(bfhi(zz_[1]))); \
            ow_[2] = pk2(yb_[0] * rs_ * gb_[0] * siluf_(bflo(zz_[2])), yb_[1] * rs_ * gb_[1] * siluf_(bfhi(zz_[2]))); ow_[3] = pk2(yb_[2] * rs_ * gb_[2] * siluf_(bflo(zz_[3])), yb_[3] * rs_ * gb_[3] * siluf_(bfhi(zz_[3]))); \
            o_.x = ow_[0]; o_.y = ow_[1]; o_.z = ow_[2]; o_.w = ow_[3]; *(v4u*)(MIX + m_ * DMODEL + FW + h * GD + zsub * 32 + 8 * j) = o_; \
            asm volatile("" ::: "memory"); } } while (0)
#define SCL_BODY(RG, n) do { \
        __syncthreads();                            \
        SCL_STAGE(RG); \
        if ((n) + 2 < NCHUNK) SCL_LOAD(RG, (n) + 2); \
        __syncthreads();                            \
        if ((n) > 0) { SCL_NORM((n) - 1); _Pragma("unroll") for (int j = 0; j < 4; ++j) zp[j] = *(const v4u*)(zbase + (size_t)(n) * 64 * GW + 8 * j); } \
    } while (0)
#pragma unroll 1
        for (int n2 = 0; n2 < NCHUNK; n2 += 2) { SCL_BODY(rA, n2); SCL_BODY(rB, (n2 + 1)); }
        __syncthreads();
        SCL_NORM(NCHUNK - 1);
#undef SCL_BODY
#undef SCL_NORM
#undef SCL_STAGE
#undef SCL_LOAD
    } else {
        const float glv = GLb[bh * NCHUNK + (lane & 31)];
        f32x4 S[2][8];
#pragma unroll
        for (int e = 0; e < 2; ++e)
#pragma unroll
            for (int tt = 0; tt < 8; ++tt) S[e][tt] = (f32x4){0.f, 0.f, 0.f, 0.f};
#pragma unroll 1
        for (int n = 0; n < NCHUNK; ++n) {
            __syncthreads();
            const float gl = __builtin_bit_cast(float, __builtin_amdgcn_readlane(__builtin_bit_cast(int, glv), n));
            bf16x8 Sb[2][4];
#pragma unroll
            for (int e = 0; e < 2; ++e)
#pragma unroll
                for (int ks = 0; ks < 4; ++ks) Sb[e][ks] = pack8(S[e][2 * ks], S[e][2 * ks + 1]);
            __syncthreads();
            f32x4 vn[2][4], oo[2][4];
#pragma unroll
            for (int mt = 0; mt < 4; ++mt) {
                f32x4 acc[2], ao[2];
#pragma unroll
                for (int e = 0; e < 2; ++e) { acc[e] = (f32x4){0.f, 0.f, 0.f, 0.f}; ao[e] = (f32x4){0.f, 0.f, 0.f, 0.f}; }
#pragma unroll
                for (int ks = 0; ks < 4; ++ks) {
                    const bf16x8 aw = afrag(Wl + (16 * mt + l15) * 136, 32 * ks, q4), aq = afrag(QDl + (16 * mt + l15) * 136, 32 * ks, q4);
#pragma unroll
                    for (int e = 0; e < 2; ++e) { acc[e] = __builtin_amdgcn_mfma_f32_16x16x32_bf16(aw, Sb[e][ks], acc[e], 0, 0, 0); ao[e] = __builtin_amdgcn_mfma_f32_16x16x32_bf16(aq, Sb[e][ks], ao[e], 0, 0, 0); }
                }
#pragma unroll
                for (int e = 0; e < 2; ++e) { const v2u uu = *(const LAS v2u*)(UTl + (32 * wave + 16 * e + l15) * 72 + 16 * mt + 4 * q4);
                    vn[e][mt][0] = bflo(uu.x) - acc[e][0]; vn[e][mt][1] = bfhi(uu.x) - acc[e][1]; vn[e][mt][2] = bflo(uu.y) - acc[e][2]; vn[e][mt][3] = bfhi(uu.y) - acc[e][3]; oo[e][mt] = ao[e]; }
            }
            bf16x8 Vb[2][2];
#pragma unroll
            for (int e = 0; e < 2; ++e) { Vb[e][0] = pack8(vn[e][0], vn[e][1]); Vb[e][1] = pack8(vn[e][2], vn[e][3]); }
#pragma unroll
            for (int mt = 0; mt < 4; ++mt) {
#pragma unroll
                for (int k2 = 0; k2 < 2; ++k2) { const bf16x8 a = afrag(QKl + (16 * mt + l15) * 72, 32 * k2, q4);
#pragma unroll
                    for (int e = 0; e < 2; ++e) oo[e][mt] = __builtin_amdgcn_mfma_f32_16x16x32_bf16(a, Vb[e][k2], oo[e][mt], 0, 0, 0); }
#pragma unroll
                for (int e = 0; e < 2; ++e)
#pragma unroll
                    for (int r = 0; r < 4; ++r) Ol[(n & 1) * (64 * 132) + (16 * mt + 4 * q4 + r) * 132 + 32 * wave + 16 * e + l15] = oo[e][mt][r];
            }
#pragma unroll
            for (int tt = 0; tt < 8; ++tt) {
                f32x4 a2[2];
#pragma unroll
                for (int e = 0; e < 2; ++e) a2[e] = S[e][tt] * gl;
#pragma unroll
                for (int k2 = 0; k2 < 2; ++k2) { const bf16x8 a = afrag(KDTl + (16 * tt + l15) * 72, 32 * k2, q4);
#pragma unroll
                    for (int e = 0; e < 2; ++e) a2[e] = __builtin_amdgcn_mfma_f32_16x16x32_bf16(a, Vb[e][k2], a2[e], 0, 0, 0); }
#pragma unroll
                for (int e = 0; e < 2; ++e) S[e][tt] = a2[e];
            }
        }
        __syncthreads();
        float* so = out + OUT_GSP + (size_t)bh * GD * GD;
#pragma unroll
        for (int e = 0; e < 2; ++e)
#pragma unroll
            for (int tt = 0; tt < 8; ++tt)
#pragma unroll
                for (int r = 0; r < 4; ++r) so[(size_t)(16 * tt + 4 * q4 + r) * GD + 32 * wave + 16 * e + l15] = S[e][tt][r];
    }
    __syncthreads();
}

__device__ __forceinline__ void gdn_sample_unit(LAS unsigned char* lds, int u, const float* state, const float* ctx, const float* wconv, const float* GATE, const bf16* GZ, const float* gnorm, bf16* MIX, float* out, int tid) {
    const int lane = tid & 63, wave = tid >> 6;
    const int b = u >> 2, h = u & 3; const size_t m = MP + b;
    LAS float* qkv = (LAS float*)lds;
    LAS float* red = qkv + 384;
    LAS float* part = qkv + 512;
    LAS float* ov = part + 1024;
    if (tid < 384) {
        const int sec = tid >> 7, c = tid & 127, col = sec * GW + h * GD + c;
        float y = 0.f;
#pragma unroll
        for (int tap = 0; tap < 3; ++tap) y += wconv[tap * NGQKV + col] * ctx[(size_t)(b * 3 + tap) * NGQKV + col];
        y += wconv[3 * NGQKV + col] * out[OUT_GCS + (size_t)(b * 3 + 2) * NGQKV + col];
        qkv[tid] = siluf_(y);
    }
    __syncthreads();
    if (wave < 2) { const float a = qkv[wave * 128 + lane], c2 = qkv[wave * 128 + 64 + lane]; const float ss = wave_sum(a * a + c2 * c2); if (lane == 0) red[wave] = rsqrtf(ss + EPS) * (wave == 0 ? QSCALE : 1.f); }
    __syncthreads();
    if (tid < 256) qkv[tid] *= red[tid >> 7];
    __syncthreads();
    if (wave == 0) { const float a = qkv[lane] * qkv[128 + lane] + qkv[64 + lane] * qkv[192 + lane]; const float s = wave_sum(a); if (lane == 0) red[2] = s; }
    const float g = GATE[m * 16 + 8 + h], beta = GATE[m * 16 + 12 + h], eg = __expf(g);
    const int c = tid & 127, part_i = tid >> 7;
    const float* sp = state + ((size_t)(b * GH + h) * GD + part_i * 32) * GD + c;
    float sv[32]; float pk = 0.f, pq = 0.f;
#pragma unroll
    for (int d = 0; d < 32; ++d) { sv[d] = sp[(size_t)d * GD]; pk += qkv[128 + part_i * 32 + d] * sv[d]; pq += qkv[part_i * 32 + d] * sv[d]; }
    part[part_i * 128 + c] = pk; part[512 + part_i * 128 + c] = pq;
    __syncthreads();
    const float kS = (part[c] + part[128 + c]) + (part[256 + c] + part[384 + c]), qS = (part[512 + c] + part[640 + c]) + (part[768 + c] + part[896 + c]);
    const float vnew = beta * (qkv[256 + c] - eg * kS), o = eg * qS + red[2] * vnew;
    float* so = out + OUT_GSS + ((size_t)(b * GH + h) * GD + part_i * 32) * GD + c;
#pragma unroll
    for (int d = 0; d < 32; ++d) so[(size_t)d * GD] = sv[d] * eg + qkv[128 + part_i * 32 + d] * vnew;
    if (part_i == 0) ov[c] = o;
    __syncthreads();
    if (wave == 0) { const float a = ov[lane], c2 = ov[64 + lane]; const float ss = wave_sum(a * a + c2 * c2); if (lane == 0) red[3] = rsqrtf(ss * (1.f / GD) + EPS); }
    __syncthreads();
    if (tid < 128) { const float z = bf2f(GZ[m * GW + h * GD + tid]); MIX[m * DMODEL + FW + h * GD + tid] = (bf16)f2bf(ov[tid] * red[3] * gnorm[tid] * siluf_(z)); }
    __syncthreads();
}

constexpr float DEC_SKIP = 40.f;
constexpr int DEC_EARLY = 256;
#define DEC_B(u) ((u) & (DB - 1))
#define DEC_P(u) ((u) >> 7)
#define DEC_REC(u) (DEC_B(u) * NPAGES + DEC_P(u))
__device__ __forceinline__ void decode_combine(int b, const float* DPART, const float* CUM, const float* GATE, const bf16* QB, const float* out, bf16* MIX, int tid);
__device__ __forceinline__ void decode_loop(LAS unsigned char* lds, int ubase, int NU, int v2, int G2, const float* cache_k, const float* cache_v, const int* page_table, const float* CUM, const bf16* QB, float* DPART,
                                            gu32* ctl, const float* GATE, const float* out, bf16* MIX, int tid) {
    const int lane = tid & 63, wave = tid >> 6, hA = lane >> 4, hB = 4 + hA, l15 = lane & 15;
    LAS unsigned* pf = (LAS unsigned*)(lds + 2 * 16896);
    int pgv = 0; { const int ue = ubase + v2 + lane * G2; if (lane < 32 && ue < NU) pgv = page_table[DEC_REC(ue)]; }
    LAS float* mlbT = (LAS float*)(lds + 2 * 16896 + 64);
    for (int e2 = 0, u2 = ubase + v2; u2 < NU && e2 < 32; ++e2, u2 += G2) { const int b_ = DEC_B(u2);
        const float d_ = wave_sum(bf2f(QB[(size_t)(MP + b_) * FW + wave * FD + lane]) * out[OUT_KS + (size_t)b_ * FW + wave * FD + lane]);
        if (lane == 0) mlbT[e2 * 8 + wave] = d_ - (CUM[((size_t)b_ * (NPAGES * PAGE) + NPAGES * PAGE - 1) * FH + wave] + GATE[(size_t)(MP + b_) * 16 + wave] * LOG2E); }
    __syncthreads();
    f32x4 xA[16][2]; float cA[16][2]; v2u qa, qb;
#define DEC_ISSUE(uu, ee) do { const int b_ = DEC_B(uu), p_ = DEC_P(uu); const int page_ = __builtin_amdgcn_readlane(pgv, ee); \
        const float* Kp_ = cache_k + (size_t)page_ * (PAGE * FW) + (size_t)(wave * 16) * FW + lane * 4; const float* Cp_ = CUM + ((size_t)b_ * (NPAGES * PAGE) + p_ * PAGE + wave * 16) * FH + hA; \
        _Pragma("unroll") for (int i_ = 0; i_ < 16; ++i_) { xA[i_][0] = __builtin_nontemporal_load((const f32x4*)(Kp_ + (size_t)i_ * FW)); xA[i_][1] = __builtin_nontemporal_load((const f32x4*)(Kp_ + (size_t)i_ * FW + 256)); } \
        _Pragma("unroll") for (int i_ = 0; i_ < 16; ++i_) { cA[i_][0] = Cp_[i_ * FH]; cA[i_][1] = Cp_[i_ * FH + 4]; } \
        qa = *(const v2u*)(QB + (size_t)(MP + b_) * FW + lane * 4); qb = *(const v2u*)(QB + (size_t)(MP + b_) * FW + 256 + lane * 4); \
        } while (0)
#define RED16(d) do { d += dppf<0xB1>(d); d += dppf<0x4E>(d); d += dppf<0x141>(d); d += dppf<0x128>(d); } while (0)
    int u = ubase + v2, e = 0; unsigned pend = 0u;
    if (u < NU) DEC_ISSUE(u, 0);
#pragma unroll 1
    for (; u < NU; u += G2, ++e) {
        const int page = __builtin_amdgcn_readlane(pgv, e);
        const float* Vp = cache_v + (size_t)page * (PAGE * FW) + (size_t)(wave * 16) * FW + lane * 4;
        LAS float* mL = (LAS float*)(lds + (e & 1) * 16896); LAS float* lL = mL + 64; LAS float* accL = lL + 64;
        const float qA0 = bflo(qa.x), qA1 = bfhi(qa.x), qA2 = bflo(qa.y), qA3 = bfhi(qa.y), qB0 = bflo(qb.x), qB1 = bfhi(qb.x), qB2 = bflo(qb.y), qB3 = bfhi(qb.y);
        const float mlbA = mlbT[e * 8 + hA], mlbB = mlbT[e * 8 + hB];
        float scA[16], scB[16]; float mwA = -1e30f, mwB = -1e30f;
#pragma unroll
        for (int i = 0; i < 16; ++i) {
            const f32x4 k0 = xA[i][0], k1 = xA[i][1];
            float dA = qA0 * k0.x + qA1 * k0.y + qA2 * k0.z + qA3 * k0.w, dB = qB0 * k1.x + qB1 * k1.y + qB2 * k1.z + qB3 * k1.w;
            RED16(dA); RED16(dB);
            scA[i] = dA - cA[i][0]; scB[i] = dB - cA[i][1]; mwA = fmaxf(mwA, scA[i]); mwB = fmaxf(mwB, scB[i]);
        }
        float lwA = 0.f, lwB = 0.f; f32x4 aA = (f32x4){0.f, 0.f, 0.f, 0.f}, aB = (f32x4){0.f, 0.f, 0.f, 0.f};
        if (__any(fmaxf(mwA - mlbA, mwB - mlbB) > -DEC_SKIP)) {
#pragma unroll
            for (int i = 0; i < 16; ++i) { xA[i][0] = __builtin_nontemporal_load((const f32x4*)(Vp + (size_t)i * FW)); xA[i][1] = __builtin_nontemporal_load((const f32x4*)(Vp + (size_t)i * FW + 256)); }
#pragma unroll
            for (int i = 0; i < 16; ++i) { const float pA = exp2f(scA[i] - mwA), pB = exp2f(scB[i] - mwB); lwA += pA; lwB += pB; aA += xA[i][0] * pA; aB += xA[i][1] * pB; }
        } else { mwA = -1e30f; mwB = -1e30f; }
        { const int un = u + G2; if (un < NU) DEC_ISSUE(un, e + 1); }
        if (l15 == 0) { mL[wave * 8 + hA] = mwA; lL[wave * 8 + hA] = lwA; mL[wave * 8 + hB] = mwB; lL[wave * 8 + hB] = lwB; }
        *(LAS f32x4*)(accL + wave * 512 + lane * 4) = aA; *(LAS f32x4*)(accL + wave * 512 + 256 + lane * 4) = aB;
        __syncthreads();
        {
            const int h2 = tid >> 6, d = tid & 63;
            float M = mL[h2];
#pragma unroll
            for (int w = 1; w < 8; ++w) M = fmaxf(M, mL[w * 8 + h2]);
            float L = 0.f, O = 0.f;
#pragma unroll
            for (int w = 0; w < 8; ++w) { const float f = exp2f(mL[w * 8 + h2] - M); L += lL[w * 8 + h2] * f; O += accL[w * 512 + h2 * 64 + d] * f; }
            GAS float* dp = (GAS float*)DPART + (size_t)DEC_REC(u) * DP_UNIT + h2 * DP_HEAD;
            __hip_atomic_store(dp + 16 + d, O, RLX_AGENT); if (d == 0) { __hip_atomic_store(dp, M, RLX_AGENT); __hip_atomic_store(dp + 1, L, RLX_AGENT); }
        }
    }
#undef DEC_ISSUE
#undef RED16
    VM_WAIT(); __syncthreads();
    if (tid < 32) { unsigned bit = 0u; const int uu = ubase + v2 + tid * G2;
        if (tid < e && uu < NU) { const unsigned o = __hip_atomic_fetch_add(ctl + CW_DEC + 64 * DEC_B(uu), 1u, RLX_AGENT); bit = (o == NPAGES - 1) ? (1u << tid) : 0u; }
#pragma unroll
        for (int o2 = 1; o2 < 32; o2 <<= 1) bit |= (unsigned)__shfl_xor((int)bit, o2);
        if (tid == 0) *pf = bit; }
    __syncthreads(); pend = *pf;
    if (pend) { __builtin_amdgcn_fence(__ATOMIC_ACQUIRE, "agent"); VM_WAIT(); __syncthreads();
        e = 0; for (int uu = ubase + v2; uu < NU; uu += G2, ++e) if ((pend >> e) & 1u) decode_combine(DEC_B(uu), DPART, CUM, GATE, QB, out, MIX, tid); }
    __syncthreads();
}
__device__ __forceinline__ void decode_combine(int b, const float* DPART, const float* CUM, const float* GATE, const bf16* QB, const float* out, bf16* MIX, int tid) {
    const int h = tid >> 6, d = tid & 63; const size_t m = MP + b;
    float pm[NPAGES], pl[NPAGES], po[NPAGES];
#pragma unroll
    for (int p = 0; p < NPAGES; ++p) { const float* dp = DPART + (size_t)(b * NPAGES + p) * DP_UNIT + h * DP_HEAD; pm[p] = dp[0]; pl[p] = dp[1]; po[p] = dp[16 + d]; }
    const float cum2 = GATE[m * 16 + h] * LOG2E + CUM[((size_t)b * (NPAGES * PAGE) + NPAGES * PAGE - 1) * FH + h];
    const float q = bf2f(QB[m * FW + h * FD + d]), kn = out[OUT_KS + (size_t)b * FW + h * FD + d], vnw = out[OUT_VS + (size_t)b * FW + h * FD + d];
    const float sn = wave_sum(q * kn) - cum2;
    float M = sn;
#pragma unroll
    for (int p = 0; p < NPAGES; ++p) M = fmaxf(M, pm[p]);
    const float fn = exp2f(sn - M); float L = fn, O = fn * vnw;
#pragma unroll
    for (int p = 0; p < NPAGES; ++p) { const float f = exp2f(pm[p] - M); L += pl[p] * f; O += po[p] * f; }
    MIX[m * DMODEL + h * FD + d] = (bf16)f2bf(O / L);
}


template <int K, bool NORM, class Epi>
__device__ __forceinline__ void small_gemm_unit(LAS float* red, const bf16* A, const bf16* Bt, int su, const Epi& E, int tid) {
    const int lane = tid & 63, wave = tid >> 6, q4 = lane >> 4, l15 = lane & 15;
    const int m0 = (su & 3) * 32, n0 = (su >> 2) * 32;
    constexpr int KW = K / 8, NKS = KW / 32;
    const bf16* ap = A + (size_t)(m0 + l15) * K + wave * KW + 8 * q4;
    const bf16* bp = Bt + (size_t)(n0 + l15) * K + wave * KW + 8 * q4;
    f32x4 acc[2][2]; float ss0 = 0.f, ss1 = 0.f;
#pragma unroll
    for (int i = 0; i < 2; ++i)
#pragma unroll
        for (int j = 0; j < 2; ++j) acc[i][j] = (f32x4){0.f, 0.f, 0.f, 0.f};
#pragma unroll
    for (int b0 = 0; b0 < NKS; b0 += 4) {
        bf16x8 a0[4], a1[4], w0[4], w1[4];
#pragma unroll
        for (int j = 0; j < 4; ++j) if (b0 + j < NKS) { const int ko = 32 * (b0 + j);
            a0[j] = *(const bf16x8*)(ap + ko); a1[j] = *(const bf16x8*)(ap + (size_t)16 * K + ko); w0[j] = *(const bf16x8*)(bp + ko); w1[j] = *(const bf16x8*)(bp + (size_t)16 * K + ko); }
#pragma unroll
        for (int j = 0; j < 4; ++j) if (b0 + j < NKS) {
            acc[0][0] = __builtin_amdgcn_mfma_f32_16x16x32_bf16(a0[j], w0[j], acc[0][0], 0, 0, 0); acc[0][1] = __builtin_amdgcn_mfma_f32_16x16x32_bf16(a0[j], w1[j], acc[0][1], 0, 0, 0);
            acc[1][0] = __builtin_amdgcn_mfma_f32_16x16x32_bf16(a1[j], w0[j], acc[1][0], 0, 0, 0); acc[1][1] = __builtin_amdgcn_mfma_f32_16x16x32_bf16(a1[j], w1[j], acc[1][1], 0, 0, 0);
            if (NORM) {
#pragma unroll
                for (int q = 0; q < 8; ++q) { const float x0 = bf2f((unsigned short)a0[j][q]), x1 = bf2f((unsigned short)a1[j][q]); ss0 += x0 * x0; ss1 += x1 * x1; } } }
        __builtin_amdgcn_sched_barrier(0);
    }
#pragma unroll
    for (int t = 0; t < 4; ++t) *(LAS f32x4*)(red + ((wave * 4 + t) * 64 + lane) * 4) = acc[t >> 1][t & 1];
    if (NORM) { ss0 += __shfl_xor(ss0, 16); ss0 += __shfl_xor(ss0, 32); ss1 += __shfl_xor(ss1, 16); ss1 += __shfl_xor(ss1, 32);
        if (q4 == 0) { red[8192 + wave * 32 + l15] = ss0; red[8192 + wave * 32 + 16 + l15] = ss1; } }
    __syncthreads();
    {
        const int t = tid >> 7, ln = (tid & 127) >> 1, rr = (tid & 1) * 2;
        float s0 = 0.f, s1 = 0.f;
#pragma unroll
        for (int w = 0; w < 8; ++w) { const f32x2v v = *(const LAS f32x2v*)(red + ((w * 4 + t) * 64 + ln) * 4 + rr); s0 += v.x; s1 += v.y; }
        const int rl = 16 * (t >> 1) + 4 * (ln >> 4) + rr, row = m0 + rl, col = n0 + 16 * (t & 1) + (ln & 15);
        if (NORM) { float q0 = 0.f, q1 = 0.f;
#pragma unroll
            for (int w = 0; w < 8; ++w) { q0 += red[8192 + w * 32 + rl]; q1 += red[8192 + w * 32 + rl + 1]; }
            s0 *= rsqrtf(q0 * (1.f / K) + EPS); s1 *= rsqrtf(q1 * (1.f / K) + EPS); }
        E(row, col, s0); E(row + 1, col, s1);
    }
    __syncthreads();
}

__device__ __forceinline__ void small_up_unit(LAS float* red, const bf16* A, const bf16* Bt, int su, const float* wconv, const float* bconv, const float* ctx, bf16* ACT, float* out, int tid) {
    constexpr int K = DMODEL, KW = K / 8, NKS = KW / 32;
    const int lane = tid & 63, wave = tid >> 6, q4 = lane >> 4, l15 = lane & 15;
    const int m0 = (su & 3) * 32, c0 = (su >> 2) * 16, ng = 256 * (c0 >> 7) + (c0 & 127);
    const bf16* ap = A + (size_t)(m0 + l15) * K + wave * KW + 8 * q4;
    const bf16* bp = Bt + (size_t)(ng + l15) * K + wave * KW + 8 * q4;
    f32x4 acc[2][2]; float ss0 = 0.f, ss1 = 0.f;
#pragma unroll
    for (int i = 0; i < 2; ++i)
#pragma unroll
        for (int j = 0; j < 2; ++j) acc[i][j] = (f32x4){0.f, 0.f, 0.f, 0.f};
    bf16x8 a0[NKS], a1[NKS], w0[NKS], w1[NKS];
#pragma unroll
    for (int j = 0; j < NKS; ++j) { const int ko = 32 * j; a0[j] = *(const bf16x8*)(ap + ko); a1[j] = *(const bf16x8*)(ap + (size_t)16 * K + ko); w0[j] = *(const bf16x8*)(bp + ko); w1[j] = *(const bf16x8*)(bp + (size_t)128 * K + ko); }
#pragma unroll
    for (int j = 0; j < NKS; ++j) {
        acc[0][0] = __builtin_amdgcn_mfma_f32_16x16x32_bf16(a0[j], w0[j], acc[0][0], 0, 0, 0); acc[0][1] = __builtin_amdgcn_mfma_f32_16x16x32_bf16(a0[j], w1[j], acc[0][1], 0, 0, 0);
        acc[1][0] = __builtin_amdgcn_mfma_f32_16x16x32_bf16(a1[j], w0[j], acc[1][0], 0, 0, 0); acc[1][1] = __builtin_amdgcn_mfma_f32_16x16x32_bf16(a1[j], w1[j], acc[1][1], 0, 0, 0);
#pragma unroll
        for (int q = 0; q < 8; ++q) { const float x0 = bf2f((unsigned short)a0[j][q]), x1 = bf2f((unsigned short)a1[j][q]); ss0 += x0 * x0; ss1 += x1 * x1; } }
#pragma unroll
    for (int t = 0; t < 4; ++t) *(LAS f32x4*)(red + ((wave * 4 + t) * 64 + lane) * 4) = acc[t >> 1][t & 1];
    ss0 += __shfl_xor(ss0, 16); ss0 += __shfl_xor(ss0, 32); ss1 += __shfl_xor(ss1, 16); ss1 += __shfl_xor(ss1, 32);
    if (q4 == 0) { red[8192 + wave * 32 + l15] = ss0; red[8192 + wave * 32 + 16 + l15] = ss1; }
    __syncthreads();
    {
        const int mt = tid >> 8, ln = (tid >> 2) & 63, r = tid & 3;
        float g = 0.f, u = 0.f, q0 = 0.f;
        const int rl = 16 * mt + 4 * (ln >> 4) + r, row = m0 + rl, ch = c0 + (ln & 15);
#pragma unroll
        for (int w = 0; w < 8; ++w) { g += red[((w * 4 + 2 * mt) * 64 + ln) * 4 + r]; u += red[((w * 4 + 2 * mt + 1) * 64 + ln) * 4 + r]; q0 += red[8192 + w * 32 + rl]; }
        const float rs = rsqrtf(q0 * (1.f / K) + EPS); g *= rs; u *= rs;
        out[OUT_FCS + (size_t)(row * 2 + 1) * FFN + ch] = g;
        const float y = wconv[ch] * ctx[(size_t)(row * 2) * FFN + ch] + wconv[FFN + ch] * ctx[(size_t)(row * 2 + 1) * FFN + ch] + wconv[2 * FFN + ch] * g + bconv[ch];
        ACT[(size_t)(MP + row) * FFN + ch] = (bf16)f2bf(siluf_(y) * u);
    }
    __syncthreads();
}
struct SEpiInProj {
    bf16 *QB, *KB, *VB, *GQKV, *GZ; float* GATE; float* out; const float *b_forget, *a_log, *dt_bias;
    __device__ __forceinline__ void operator()(int row, int nd, float v) const {
        const size_t m = MP + row;
        if (nd < 512) QB[m * FW + nd] = (bf16)f2bf(v * attn_body::C2);
        else if (nd < 1024) { KB[m * FW + nd - 512] = (bf16)f2bf(v); out[OUT_KS + (size_t)row * FW + nd - 512] = v; }
        else if (nd < 1536) { VB[m * FW + nd - 1024] = (bf16)f2bf(v); out[OUT_VS + (size_t)row * FW + nd - 1024] = v; }
        else if (nd < 3072) { GQKV[m * NGQKV + nd - 1536] = (bf16)f2bf(v); out[OUT_GCS + (size_t)(row * 3 + 2) * NGQKV + nd - 1536] = v; }
        else if (nd < 3584) GZ[m * GW + nd - 3072] = (bf16)f2bf(v);
        else if (nd < 3592) { const int j = nd - 3584; const float lf = -softplusf_(-(v + b_forget[j])); GATE[m * 16 + j] = lf; out[OUT_LFS + (size_t)row * FH + j] = lf; }
        else if (nd < 3596) { const int j = nd - 3592; GATE[m * 16 + 8 + j] = -expf(a_log[j]) * softplusf_(v + dt_bias[j]); }
        else if (nd < 3600) { const int j = nd - 3596; GATE[m * 16 + 12 + j] = 1.f / (1.f + expf(-v)); }
    }
};
struct SEpiResid { const float* base; float* dst; bf16* XN;
    __device__ __forceinline__ void operator()(int row, int col, float v) const { const float r = base[(size_t)row * DMODEL + col] + v; dst[(size_t)(MP + row) * DMODEL + col] = r; if (XN) XN[(size_t)(MP + row) * DMODEL + col] = (bf16)f2bf(r); } };
struct SEpiResidWT { const float* base; float* dst;
    __device__ __forceinline__ void operator()(int row, int col, float v) const { __hip_atomic_store((GAS float*)dst + (size_t)(MP + row) * DMODEL + col, base[(size_t)row * DMODEL + col] + v, RLX_AGENT); } };
struct SEpiUp { bf16* GU; float* out;
    __device__ __forceinline__ void operator()(int row, int nd, float v) const {
        const int pn = nd >> 8, r = nd & 255;
        if (r < 128) { const int c = 128 * pn + r; GU[(size_t)(MP + row) * NUP + c] = (bf16)f2bf(v); out[OUT_FCS + (size_t)(row * 2 + 1) * FFN + c] = v; }
        else GU[(size_t)(MP + row) * NUP + FFN + 128 * pn + r - 128] = (bf16)f2bf(v);
    } };

__global__ void __launch_bounds__(NTHR, 2) fwd(Args args) {
    extern __shared__ __attribute__((aligned(16))) unsigned char lds_raw[];
    LAS unsigned char* lds = (LAS unsigned char*)lds_raw;
    volatile LAS unsigned* MISC = (volatile LAS unsigned*)(lds + MISC_OFF);
    const int tid = threadIdx.x, lane = tid & 63, wave = __builtin_amdgcn_readfirstlane(tid >> 6);
    const int G = gridDim.x; const int bx = blockIdx.x; const int vcu = (G % 8 == 0) ? (bx % 8) * (G / 8) + bx / 8 : bx;
    unsigned char* ws = args.ws; float* out = args.out;
    gu32* ctl = (gu32*)(ws + WS_CTL);
    const float* x_prompt = args.in[0]; const float* x_sample = args.in[1]; const float* cache_k = args.in[2]; const float* cache_v = args.in[3]; const float* cache_lf = args.in[4];
    const float* state_gdn = args.in[5]; const float* state_gconv = args.in[6]; const float* state_fconv = args.in[7]; const int* page_table = (const int*)args.in[8];
    const float* norm_mix = args.in[9]; const float* w_in = args.in[10]; const float* b_forget = args.in[11]; const float* a_log = args.in[12]; const float* dt_bias = args.in[13];
    const float* w_gconv = args.in[14]; const float* gnorm = args.in[15]; const float* w_out = args.in[16]; const float* norm_ffn = args.in[17]; const float* w_up = args.in[18];
    const float* w_fconv = args.in[19]; const float* b_fconv = args.in[20]; const float* w_down = args.in[21]; const float* norm_final = args.in[22];
    bf16* WinT = (bf16*)(ws + WS_WIN); bf16* WoutT = (bf16*)(ws + WS_WOUT); bf16* WupT = (bf16*)(ws + WS_WUP); bf16* WdnT = (bf16*)(ws + WS_WDN);
    float* GATE = (float*)(ws + WS_GATE); float* CUM = (float*)(ws + WS_CUM); float* DPART = (float*)(ws + WS_DPART);
    bf16* XN = (bf16*)(ws + WS_XN); bf16* QB = (bf16*)(ws + WS_QB); bf16* KB = (bf16*)(ws + WS_KB); bf16* VB = (bf16*)(ws + WS_VB); bf16* GQKV = (bf16*)(ws + WS_GQKV); bf16* GZ = (bf16*)(ws + WS_GZ);
    bf16* MIX = (bf16*)(ws + WS_MIX); float* X1 = (float*)(ws + WS_X1); bf16* GU = (bf16*)(ws + WS_GU); bf16* ACT = (bf16*)(ws + WS_ACT); float* X2 = (float*)(ws + WS_X2);
    unsigned char* gdnbuf = ws + WS_GDN; float* GLb = (float*)(ws + WS_GL); float* SSQ = (float*)(ws + WS_SSQ); float* INVRS = (float*)(ws + WS_INVRS);

    for (int u = tid; u < (LDS_BYTES - LDSCTL_OFF) / 4; u += NTHR) ((LAS unsigned*)(lds + LDSCTL_OFF))[u] = 0u;
    __syncthreads();
    const int lo = args.ph_lo, hi = args.ph_hi;
    const bool one_launch = (hi - lo) > 1;
    XcdBarrier bar; bar.bar = (unsigned*)(ctl + CW_BAR); bar.x = 0; bar.st = nullptr;
    if (one_launch) bar = xcd_barrier_post((unsigned*)(ctl + CW_BAR), MISC + 8);
#ifdef ONLY_PH
#define IN(k) ((k) == ONLY_PH && lo <= (k) && (k) < hi)
#else
#define IN(k) (lo <= (k) && (k) < hi)
#endif
#define SEAM(k) do { if (IN(k) && IN((k) + 1)) xcd_barrier(bar); } while (0)
    const int gw = vcu * NWAVES + wave, NGW = G * NWAVES;

    constexpr int I_IN = 16 * (NIN / 32), I_OUT = 16 * 32, I_UP = 16 * (NUP / 32), I_DN = (FFN / 64) * 32, NITEMS = I_IN + I_OUT + I_UP + I_DN;
    if (IN(0)) {
        LAS float* scr = (LAS float*)(lds + RING_OFF + wave * 16384);
        const int nit0 = (G == 256) ? I_IN + I_OUT + I_UP : NITEMS;
        for (int it = gw; it < nit0; it += NGW) {
            int r = it;
            if (r < I_IN) { transpose_item(w_in, DMODEL, 3600, WinT, scr, r / (NIN / 32), r % (NIN / 32), lane, SMapIn()); continue; } r -= I_IN;
            if (r < I_OUT) { transpose_item(w_out, DMODEL, DMODEL, WoutT, scr, r / 32, r % 32, lane, SMapId()); continue; } r -= I_OUT;
            if (r < I_UP) { transpose_item(w_up, DMODEL, NUP, WupT, scr, r / (NUP / 32), r % (NUP / 32), lane, SMapUp(), norm_ffn  ); continue; } r -= I_UP;
            transpose_item(w_down, FFN, DMODEL, WdnT, scr, r / 32, r % 32, lane, SMapId());
        }
        for (int m = gw; m < MT; m += 2 * NGW) {
            const int m2 = m + NGW;
            const float* xa = m < MP ? x_prompt + (size_t)m * DMODEL : x_sample + (size_t)(m - MP) * DMODEL;
            if (m2 < MT) { const float* xb = m2 < MP ? x_prompt + (size_t)m2 * DMODEL : x_sample + (size_t)(m2 - MP) * DMODEL;
                rms_rows2_to_bf16(xa, xb, norm_mix, XN + (size_t)m * DMODEL, XN + (size_t)m2 * DMODEL, lane, INVRS + m, INVRS + m2); }
            else rms_row_to_bf16(xa, norm_mix, XN + (size_t)m * DMODEL, lane, INVRS + m);
        }
        if (G != 256) { const int gt = vcu * NTHR + tid, NGT = G * NTHR;
          for (int e = gt; e < DB * 2 * NGQKV / 4; e += NGT) { const int bb = e / (2 * NGQKV / 4), r = e % (2 * NGQKV / 4);
              *((f32x4*)(out + OUT_GCS + (size_t)bb * 3 * NGQKV) + r) = *((const f32x4*)(state_gconv + (size_t)bb * 3 * NGQKV + NGQKV) + r); }
          for (int e = gt; e < DB * FFN / 4; e += NGT) { const int bb = e / (FFN / 4), r = e % (FFN / 4);
              *((f32x4*)(out + OUT_FCS + (size_t)bb * 2 * FFN) + r) = *((const f32x4*)(state_fconv + (size_t)bb * 2 * FFN + FFN) + r); } }
        if (G == 256) {
            LAS float* tot = (LAS float*)(lds + RING_OFF); LAS float* tot0 = tot + 512;
            __syncthreads();
            const int b = vcu >> 1, half = vcu & 1, hh = tid & 7, seg = tid >> 3;
            const int t0 = half * 1024 + seg * 16;
            const float* lp = cache_lf + (size_t)page_table[b * NPAGES + (t0 >> 7)] * (PAGE * FH) + (size_t)(t0 & 127) * FH + hh;
            float loc[16]; float run = 0.f, run0 = 0.f;
#pragma unroll
            for (int i = 0; i < 16; ++i) { run += lp[i * FH]; loc[i] = run; }
            if (half) { const int u0 = seg * 16; const float* lq = cache_lf + (size_t)page_table[b * NPAGES + (u0 >> 7)] * (PAGE * FH) + (size_t)(u0 & 127) * FH + hh;
#pragma unroll
                for (int i = 0; i < 16; ++i) run0 += lq[i * FH]; }
            tot[seg * 8 + hh] = run; tot0[seg * 8 + hh] = run0;
            __syncthreads();
            float off = 0.f;
            for (int s2 = 0; s2 < seg; ++s2) off += tot[s2 * 8 + hh];
            if (half) for (int s2 = 0; s2 < 64; ++s2) off += tot0[s2 * 8 + hh];
            float* cp = CUM + ((size_t)b * (NPAGES * PAGE) + t0) * FH + hh;
#pragma unroll
            for (int i = 0; i < 16; ++i) cp[i * FH] = (off + loc[i]) * LOG2E;
        } else
        for (int b = vcu; b < DB; b += G) {
            LAS float* tot = (LAS float*)(lds + RING_OFF);
            __syncthreads();
            const int hh = tid & 7, seg = tid >> 3;
            float loc[32]; float run = 0.f;
            const float* lp = cache_lf + (size_t)page_table[b * NPAGES + (seg >> 2)] * (PAGE * FH) + (size_t)((seg & 3) * 32) * FH + hh;
#pragma unroll
            for (int i = 0; i < 32; ++i) { run += lp[i * FH]; loc[i] = run; }
            tot[seg * 8 + hh] = run;
            __syncthreads();
            float off = 0.f;
            for (int s2 = 0; s2 < seg; ++s2) off += tot[s2 * 8 + hh];
            float* cp = CUM + ((size_t)b * (NPAGES * PAGE) + seg * 32) * FH + hh;
#pragma unroll
            for (int i = 0; i < 32; ++i) cp[i * FH] = (off + loc[i]) * LOG2E;
        }
        __syncthreads();
    }
    SEAM(0);
    if (IN(1)) {
        pg8::Gemm g{XN, WinT, MP, NIN, DMODEL}; pg8::StaticOrder S; S.init(MP, NIN, G, bx);
        EpiInProj E{QB, KB, VB, GQKV, GZ, GATE, out, b_forget, a_log, dt_bias};
        pg8::gemm_phase<EpiInProj, pg8::StaticOrder, true, true>(lds + RING_OFF, g, S, E);
        { const int nun = (MP / 256) * (NIN / 256), full = nun / G, rem = nun - full * G;
          const int nidle = G - rem, ir = bx - rem; SEpiInProj SE{QB, KB, VB, GQKV, GZ, GATE, out, b_forget, a_log, dt_bias};
          LAS float* red = (LAS float*)(lds + RING_OFF);
          if (nidle == G) { for (int su = bx; su < NIN / 8; su += G) small_gemm_unit<DMODEL, false>(red, XN + (size_t)MP * DMODEL, WinT, su, SE, tid); }
          else if (ir >= 0) { for (int su = ir; su < NIN / 8; su += nidle) small_gemm_unit<DMODEL, false>(red, XN + (size_t)MP * DMODEL, WinT, su, SE, tid); } }
    }
    SEAM(1);
    if (IN(2)) { }
    if (IN(3)) {
        if (vcu & 1) {
        decode_loop(lds + RING_OFF, 0, (G > 64) ? DEC_EARLY : 0, vcu, G, cache_k, cache_v, page_table, CUM, QB, DPART, ctl, GATE, out, MIX, tid);
        for (int u = vcu; u < (G == 256 ? 256 : DB * GH); u += G) { int tl = tid; asm volatile("" : "+v"(tl)); gdn_sample_unit(lds + RING_OFF, u, state_gdn, state_gconv, w_gconv, GATE, GZ, gnorm, MIX, out, tl); }
        { int tm = tid; asm volatile("" : "+v"(tm)); const PrepMap pmap = prep_map(tm);
        if (G == 256) { for (int t4 = 0; t4 < 4; ++t4) { const int ci = (((vcu >> 5) * 4 + t4) << 5) + (vcu & 31); int tl = tid; asm volatile("" : "+v"(tl)); gdn_prep_unit(lds + RING_OFF, ci, GQKV, GATE, w_gconv, gdnbuf, GLb, tl, pmap); } }
        else for (int ci = vcu; ci < NCH_TOT; ci += G) { int tl = tid; asm volatile("" : "+v"(tl)); gdn_prep_unit(lds + RING_OFF, ci, GQKV, GATE, w_gconv, gdnbuf, GLb, tl, pmap); }
        }
        } else {
        { int tm = tid; asm volatile("" : "+v"(tm)); const PrepMap pmap = prep_map(tm);
        if (G == 256) { for (int t4 = 0; t4 < 4; ++t4) { const int ci = (((vcu >> 5) * 4 + t4) << 5) + (vcu & 31); int tl = tid; asm volatile("" : "+v"(tl)); gdn_prep_unit(lds + RING_OFF, ci, GQKV, GATE, w_gconv, gdnbuf, GLb, tl, pmap); } }
        else for (int ci = vcu; ci < NCH_TOT; ci += G) { int tl = tid; asm volatile("" : "+v"(tl)); gdn_prep_unit(lds + RING_OFF, ci, GQKV, GATE, w_gconv, gdnbuf, GLb, tl, pmap); }
        }
        __syncthreads();
        decode_loop(lds + RING_OFF, 0, (G > 64) ? DEC_EARLY : 0, vcu, G, cache_k, cache_v, page_table, CUM, QB, DPART, ctl, GATE, out, MIX, tid);
        for (int u = vcu; u < (G == 256 ? 256 : DB * GH); u += G) { int tl = tid; asm volatile("" : "+v"(tl)); gdn_sample_unit(lds + RING_OFF, u, state_gdn, state_gconv, w_gconv, GATE, GZ, gnorm, MIX, out, tl); }
        }
    }
    SEAM(3);
    if (IN(4)) {
        const int NSC = (G > 64) ? NB * GH : 0;
        if (NSC == 0) { for (int u = vcu; u < NB * GH; u += G) gdn_scan_chain(lds + RING_OFF, u, gdnbuf, GLb, GZ, gnorm, MIX, out, tid); }
        const bool x256 = (G == 256);
        const bool is_scan = x256 ? ((vcu & 31) < 4) : (vcu < NSC);
        if (is_scan) { const int chain = x256 ? ((vcu >> 5) * 4 + (vcu & 31)) : vcu;
            gdn_scan_chain(lds + RING_OFF, chain, gdnbuf, GLb, GZ, gnorm, MIX, out, tid);
            if (x256) for (int u = 256 + chain; u < DB * GH; u += NB * GH) { int tl = tid; asm volatile("" : "+v"(tl)); gdn_sample_unit(lds + RING_OFF, u, state_gdn, state_gconv, w_gconv, GATE, GZ, gnorm, MIX, out, tl); }
 }
        else {
            const int v2 = x256 ? ((vcu >> 5) * 28 + (vcu & 31) - 4) : (vcu - NSC), G2 = G - NSC;
            if (v2 & 1) {
            decode_loop(lds + RING_OFF, (G > 64) ? DEC_EARLY : 0, DB * NPAGES, v2, G2, cache_k, cache_v, page_table, CUM, QB, DPART, ctl, GATE, out, MIX, tid);
            {
                LAS v4u* biasF = (LAS v4u*)(lds + BIAS_OFF); LAS float* wtot = (LAS float*)(lds + WTOT_OFF);
                for (int r = 0; r * G2 < 512; ++r) {
                    const int lo_ = r * G2, idx = (r & 1) ? lo_ + (G2 - 1 - v2) : lo_ + v2;
                    if (idx >= 512) continue;
                    const int qb = 7 - (idx >> 6), bh = idx & 63, b = bh >> 3, h = bh & 7;
                    int tl = tid; asm volatile("" : "+v"(tl));
                    fox_bias_build(GATE, b, h, (qb + 1) * 256, biasF, wtot, tl);
                    attn_body::attn_unit<8>(b, h, qb, (const attn_body::bf16*)QB, (const attn_body::bf16*)KB, (const attn_body::bf16*)VB, (attn_body::bf16*)MIX, (char*)lds_raw + RING_OFF, (const LAS char*)biasF);
                }
                __syncthreads();
            }
            } else {
            {
                LAS v4u* biasF = (LAS v4u*)(lds + BIAS_OFF); LAS float* wtot = (LAS float*)(lds + WTOT_OFF);
                for (int r = 0; r * G2 < 512; ++r) {
                    const int lo_ = r * G2, idx = (r & 1) ? lo_ + (G2 - 1 - v2) : lo_ + v2;
                    if (idx >= 512) continue;
                    const int qb = 7 - (idx >> 6), bh = idx & 63, b = bh >> 3, h = bh & 7;
                    int tl = tid; asm volatile("" : "+v"(tl));
                    fox_bias_build(GATE, b, h, (qb + 1) * 256, biasF, wtot, tl);
                    attn_body::attn_unit<8>(b, h, qb, (const attn_body::bf16*)QB, (const attn_body::bf16*)KB, (const attn_body::bf16*)VB, (attn_body::bf16*)MIX, (char*)lds_raw + RING_OFF, (const LAS char*)biasF);
                }
                __syncthreads();
            }
            decode_loop(lds + RING_OFF, (G > 64) ? DEC_EARLY : 0, DB * NPAGES, v2, G2, cache_k, cache_v, page_table, CUM, QB, DPART, ctl, GATE, out, MIX, tid);
            }
        }
        __syncthreads();
    }
    SEAM(4);
    if (IN(5)) { }
    if (IN(6)) { }
    if (IN(7)) {
        pg8::Gemm g{MIX, WoutT, MP, DMODEL, DMODEL}; pg8::StaticOrder S; S.init(MP, DMODEL, G, bx);
        if (G == 256) { pg8::Unit u0; if (S.next(0, u0) && !(u0.pm & 1)) { SEpiResid SE{x_sample, X1, XN}; small_gemm_unit<DMODEL, false>((LAS float*)(lds + RING_OFF), MIX + (size_t)MP * DMODEL, WoutT, (u0.pm >> 1) * 4 + u0.pn, SE, tid); } }
        if (G == 256) { EpiResidDrain E{INVRS, norm_mix, XN, SSQ};
            pg8::gemm_phase<EpiResidDrain, pg8::StaticOrder, false, true>(lds + RING_OFF, g, S, E); }
        else { EpiResid E{x_prompt, X1, XN, SSQ};
            pg8::gemm_phase<EpiResid, pg8::StaticOrder, true, true>(lds + RING_OFF, g, S, E); }
        if (G != 256) { SEpiResid SE{x_sample, X1, XN}; for (int su = bx; su < DMODEL / 8; su += G) small_gemm_unit<DMODEL, false>((LAS float*)(lds + RING_OFF), MIX + (size_t)MP * DMODEL, WoutT, su, SE, tid); }
    }
    SEAM(7);
    if (IN(8)) { }
    if (IN(9)) {
        pg8::Gemm g{XN, WupT, MP, NUP, DMODEL}; pg8::StaticOrder S; S.init(MP, NUP, G, bx);
        float* RS = SSQ + (size_t)MPAD * 16;
        {
          f32x4 pa[3][4]; int prow[3];
#pragma unroll
          for (int k = 0; k < 3; ++k) { pg8::Unit u0; prow[k] = -1;
#pragma unroll
              for (int j = 0; j < 4; ++j) pa[k][j] = (f32x4){1.f, 1.f, 1.f, 1.f};
              if (S.next(2 * k + (tid >> 8), u0)) { prow[k] = u0.pm * 256 + (tid & 255); const float* sp = SSQ + (size_t)prow[k] * 16;
#pragma unroll
                  for (int j = 0; j < 4; ++j) pa[k][j] = *(const f32x4*)(sp + 4 * j); } }
          float rs3[3];
#pragma unroll
          for (int k = 0; k < 3; ++k) {
              const float tot = ((pa[k][0][0] + pa[k][0][1]) + (pa[k][0][2] + pa[k][0][3])) + ((pa[k][1][0] + pa[k][1][1]) + (pa[k][1][2] + pa[k][1][3])) + ((pa[k][2][0] + pa[k][2][1]) + (pa[k][2][2] + pa[k][2][3])) + ((pa[k][3][0] + pa[k][3][1]) + (pa[k][3][2] + pa[k][3][3]));
              rs3[k] = rsqrtf(tot * (1.f / DMODEL) + EPS); }
#pragma unroll
          for (int k = 0; k < 3; ++k) if (prow[k] >= 0) RS[prow[k]] = rs3[k];
          { pg8::Unit u0; for (int i = 6; S.next(i, u0); ++i) for (int r = tid; r < 256; r += NTHR) { const int row = u0.pm * 256 + r; const float* sp = SSQ + (size_t)row * 16;
              const f32x4 a = *(const f32x4*)sp, b2 = *(const f32x4*)(sp + 4), c2 = *(const f32x4*)(sp + 8), d2 = *(const f32x4*)(sp + 12);
              RS[row] = rsqrtf((((a[0] + a[1]) + (a[2] + a[3])) + ((b2[0] + b2[1]) + (b2[2] + b2[3])) + ((c2[0] + c2[1]) + (c2[2] + c2[3])) + ((d2[0] + d2[1]) + (d2[2] + d2[3]))) * (1.f / DMODEL) + EPS); } }
          VM_WAIT(); __syncthreads(); }
        EpiUpAct E{GU, ACT, out, w_fconv, b_fconv, RS};
        pg8::gemm_phase<EpiUpAct, pg8::StaticOrder, true, true>(lds + RING_OFF, g, S, E);
        { const int nun = (MP / 256) * (NUP / 256), full = nun / G, rem = nun - full * G; const int nidle = G - rem, ir = bx - rem;
          LAS float* red = (LAS float*)(lds + RING_OFF);
          if (nidle == G) { for (int su = bx; su < 4 * (FFN / 16); su += G) small_up_unit(red, XN + (size_t)MP * DMODEL, WupT, su, w_fconv, b_fconv, state_fconv, ACT, out, tid); }
          else if (ir >= 0) { for (int su = ir; su < 4 * (FFN / 16); su += nidle) small_up_unit(red, XN + (size_t)MP * DMODEL, WupT, su, w_fconv, b_fconv, state_fconv, ACT, out, tid);
            if (G == 256) {
                LAS float* scr = (LAS float*)(lds + RING_OFF + wave * 16384);
                for (int it = ir * NWAVES + wave; it < I_DN; it += nidle * NWAVES) transpose_item(w_down, FFN, DMODEL, WdnT, scr, it / 32, it % 32, lane, SMapId());
                { const int gt = ir * NTHR + tid, NGT = nidle * NTHR;
                  for (int e = gt; e < DB * 2 * NGQKV / 4; e += NGT) { const int bb = e / (2 * NGQKV / 4), r = e % (2 * NGQKV / 4);
                      *((f32x4*)(out + OUT_GCS + (size_t)bb * 3 * NGQKV) + r) = *((const f32x4*)(state_gconv + (size_t)bb * 3 * NGQKV + NGQKV) + r); }
                  for (int e = gt; e < DB * FFN / 4; e += NGT) { const int bb = e / (FFN / 4), r = e % (FFN / 4);
                      *((f32x4*)(out + OUT_FCS + (size_t)bb * 2 * FFN) + r) = *((const f32x4*)(state_fconv + (size_t)bb * 2 * FFN + FFN) + r); } }
                __syncthreads(); } } }
    }
    SEAM(9);
    if (IN(10)) { }
    if (IN(11)) {
        pg8::Gemm g{ACT, WdnT, MP, DMODEL, FFN}; pg8::StaticOrder S; S.init(MP, DMODEL, G, bx);
        if (G == 256) {
            pg8::Unit u0;
            if (S.next(0, u0) && !(u0.pm & 1)) { const int su = (u0.pm >> 1) * 4 + u0.pn;
                SEpiResidWT SE{X1 + (size_t)MP * DMODEL, X2}; LAS unsigned* lf = (LAS unsigned*)(lds + RING_OFF + 40960);
                small_gemm_unit<FFN, false>((LAS float*)(lds + RING_OFF), ACT + (size_t)MP * FFN, WdnT, su, SE, tid);
                VM_WAIT(); __syncthreads();
                if (tid == 0) { const unsigned old = __hip_atomic_fetch_add(ctl + CW_SFIN + 64 * (su & 3), 1u, RLX_AGENT); *lf = (old == 31u) ? 1u : 0u; }
                __syncthreads();
                if (*lf) { __builtin_amdgcn_fence(__ATOMIC_ACQUIRE, "agent"); VM_WAIT(); __syncthreads();
                    for (int r = wave; r < 32; r += NWAVES) { const int row = (su & 3) * 32 + r; rms_row_to_f32(X2 + (size_t)(MP + row) * DMODEL, norm_final, out + OUT_YS + (size_t)row * DMODEL, lane); } }
                __syncthreads();
            }
        }
        { pg8::Unit u0; for (int i = 0; S.next(i, u0); ++i) { const int m = u0.pm * 256 + (wave >> 1) * 64 + (wave & 1);
            bf16* arow = ACT + (size_t)m * FFN;
            const int t = m & (SEQ - 1);
            constexpr int NSL = (FFN / 8 + 63) / 64;
            v4u ga[NSL], gb[NSL], g1[NSL], g2[NSL];
#pragma unroll
            for (int k = 0; k < NSL; ++k) { const int c8 = lane + 64 * k; ga[k] = gb[k] = g1[k] = g2[k] = (v4u){0u, 0u, 0u, 0u};
                if (c8 < FFN / 8) { const int c = c8 * 8;
                    ga[k] = *(const v4u*)(GU + (size_t)m * NUP + c); gb[k] = *(const v4u*)(GU + (size_t)m * NUP + FFN + c);
                    if (t >= 1) g1[k] = *(const v4u*)(GU + (size_t)(m - 1) * NUP + c);
                    if (t >= 2) g2[k] = *(const v4u*)(GU + (size_t)(m - 2) * NUP + c); } }
#pragma unroll
            for (int k = 0; k < NSL; ++k) { const int c8 = lane + 64 * k;
                if (c8 < FFN / 8) { const int c = c8 * 8;
                    const unsigned aw[4] = {ga[k].x, ga[k].y, ga[k].z, ga[k].w}, uw[4] = {gb[k].x, gb[k].y, gb[k].z, gb[k].w}, w1_[4] = {g1[k].x, g1[k].y, g1[k].z, g1[k].w}, w2_[4] = {g2[k].x, g2[k].y, g2[k].z, g2[k].w};
                    float r[8];
#pragma unroll
                    for (int j2 = 0; j2 < 8; ++j2) { const int q = j2 >> 1; const bool hi_ = j2 & 1;
                        const float g0 = hi_ ? bfhi(aw[q]) : bflo(aw[q]), up = hi_ ? bfhi(uw[q]) : bflo(uw[q]), gm1 = hi_ ? bfhi(w1_[q]) : bflo(w1_[q]), gm2 = hi_ ? bfhi(w2_[q]) : bflo(w2_[q]);
                        const float y = w_fconv[c + j2] * gm2 + w_fconv[FFN + c + j2] * gm1 + w_fconv[2 * FFN + c + j2] * g0 + b_fconv[c + j2]; r[j2] = siluf_(y) * up; }
                    ga[k].x = pk2(r[0], r[1]); ga[k].y = pk2(r[2], r[3]); ga[k].z = pk2(r[4], r[5]); ga[k].w = pk2(r[6], r[7]); } }
#pragma unroll
            for (int k = 0; k < NSL; ++k) { const int c8 = lane + 64 * k; if (c8 < FFN / 8) *(v4u*)(arow + c8 * 8) = ga[k]; }
        } }
        VM_WAIT(); __syncthreads();
        if (G == 256) { EpiFinal E{XN, out + OUT_YP, SSQ + (size_t)MPAD * 17, ctl + CW_FIN, norm_final};
            pg8::gemm_phase<EpiFinal, pg8::StaticOrder, false, true>(lds + RING_OFF, g, S, E); }
        else { EpiResid2 E{X1, X2};
            pg8::gemm_phase<EpiResid2, pg8::StaticOrder, true, true>(lds + RING_OFF, g, S, E); }
        if (G != 256) { SEpiResid SE{X1 + (size_t)MP * DMODEL, X2, nullptr}; for (int su = bx; su < DMODEL / 8; su += G) small_gemm_unit<FFN, false>((LAS float*)(lds + RING_OFF), ACT + (size_t)MP * FFN, WdnT, su, SE, tid); }
    }
    if (G != 256) SEAM(11);
    if (IN(12)) {
        if (G != 256) for (int m = gw; m < MT; m += NGW) rms_row_to_f32(X2 + (size_t)m * DMODEL, norm_final, out + (m < MP ? OUT_YP + (size_t)m * DMODEL : OUT_YS + (size_t)(m - MP) * DMODEL), lane);
    }
#undef IN
#undef SEAM
}

#ifndef MK_ONE_LAUNCH
#define MK_ONE_LAUNCH 1
#endif
extern "C" void kernel_launch(void* const* d_in, const int* in_sizes, int n_in, void* d_out, int out_size, void* d_ws, size_t ws_size, hipStream_t stream) {
    static int grid = 0;
    if (grid == 0) {
        if (n_in != 23 || out_size != (int)OUT_END || ws_size < WS_END) { fprintf(stderr, "kernel_launch: unexpected sizes n_in %d out %d ws %zu\n", n_in, out_size, ws_size); grid = -1; return; }
        int dev = 0, cus = 0, per_cu = 0;
        if (hipGetDevice(&dev) != hipSuccess || hipDeviceGetAttribute(&cus, hipDeviceAttributeMultiprocessorCount, dev) != hipSuccess) { grid = -1; return; }
        if (hipFuncSetAttribute((const void*)fwd, hipFuncAttributeMaxDynamicSharedMemorySize, LDS_BYTES) != hipSuccess) { fprintf(stderr, "kernel_launch: hipFuncSetAttribute failed\n"); grid = -1; return; }
        if (hipOccupancyMaxActiveBlocksPerMultiprocessor(&per_cu, (const void*)fwd, NTHR, LDS_BYTES) != hipSuccess || per_cu < 1) { fprintf(stderr, "kernel_launch: occupancy query says %d\n", per_cu); }
        (void)hipGetLastError();
        grid = cus;
    }
    if (grid < 0) return;
    (void)hipMemsetAsync((char*)d_ws + WS_CTL, 0, CTL_ZERO_BYTES, stream);
    Args a{};
    for (int i = 0; i < 23; ++i) a.in[i] = (const float*)d_in[i];
    a.out = (float*)d_out; a.ws = (unsigned char*)d_ws;
#if MK_ONE_LAUNCH
    a.ph_lo = 0; a.ph_hi = NPH;
    hipLaunchKernelGGL(fwd, dim3(grid), dim3(NTHR), LDS_BYTES, stream, a);
#else
    for (int ph = 0; ph < NPH; ++ph) for (int rep = 0; rep < (ph == PROBE_DUP ? 2 : 1); ++rep) { a.ph_lo = ph; a.ph_hi = ph + 1; hipLaunchKernelGGL(fwd, dim3(grid), dim3(NTHR), LDS_BYTES, stream, a); }
#endif
}
```
